# Optimizing an MI355X kernel written in HIP

```python
import jax, jax.numpy as jnp
from jax import lax
import numpy as np

D_MODEL = 2048
BATCH = 1
SEQ = 8192
DEPTH = 2
DEC_BATCH = 4
DEC_SEQ = 8192
PAST_LEN = 128

MIX_WIDTH = D_MODEL
HEAD_DIM = 128
ATTN_WIDTH = MIX_WIDTH // 2
N_Q_HEADS = ATTN_WIDTH // HEAD_DIM
N_KV_HEADS = 2
Q_PER_KV = N_Q_HEADS // N_KV_HEADS
KV_WIDTH = N_KV_HEADS * HEAD_DIM
FOURIER_WIDTH = MIX_WIDTH - ATTN_WIDTH
N_FOURIER_GROUPS = 8
FOURIER_GROUP_DIM = FOURIER_WIDTH // N_FOURIER_GROUPS
IN_PROJ_WIDTH = ATTN_WIDTH + 2 * KV_WIDTH + FOURIER_WIDTH
WINDOW = 128
BLOCK = 128
ROPE_THETA = 10000.0
D_FF = 5632
N_SUBLAYERS = 3
N_MOD = 3
RMS_EPS = 1e-6
MOD_SCALE = 0.1
NEG_INF = -1e30

kernel_name = "hymba_style_fnet_swa_macaron_encoder"


def rms_norm(x, g):
    xf = x.astype(jnp.float32)
    y = xf * lax.rsqrt(jnp.mean(xf * xf, axis=-1, keepdims=True) + RMS_EPS)
    return (y * g.astype(jnp.float32)).astype(x.dtype)


def rope_tables(seq_len):
    inv_freq = ROPE_THETA ** (-jnp.arange(0, HEAD_DIM, 2, dtype=jnp.float32) / HEAD_DIM)
    ang = jnp.arange(seq_len, dtype=jnp.float32)[:, None] * inv_freq[None, :]
    return jnp.cos(ang), jnp.sin(ang)


def apply_rope(t, cos, sin):
    tf = t.astype(jnp.float32)
    t1, t2 = tf[..., : HEAD_DIM // 2], tf[..., HEAD_DIM // 2:]
    c = cos[None, :, None, :]
    s = sin[None, :, None, :]
    return jnp.concatenate([t1 * c - t2 * s, t1 * s + t2 * c], axis=-1).astype(t.dtype)


def band_mask(seq_len):
    nb = seq_len // BLOCK
    n = jnp.arange(nb)[:, None, None]
    i = jnp.arange(BLOCK)[None, :, None]
    j = jnp.arange(3 * BLOCK)[None, None, :]
    qpos = n * BLOCK + i
    kpos = (n - 1) * BLOCK + j
    return (jnp.abs(qpos - kpos) <= WINDOW) & (kpos >= 0) & (kpos < seq_len)


def windowed_gqa_attention(q, k, v, sink, cos, sin, mask):
    B, S, _ = q.shape
    nb = S // BLOCK
    q = apply_rope(q.reshape(B, S, N_Q_HEADS, HEAD_DIM), cos, sin)
    k = apply_rope(k.reshape(B, S, N_KV_HEADS, HEAD_DIM), cos, sin)
    v = v.reshape(B, S, N_KV_HEADS, HEAD_DIM)
    qb = q.reshape(B, nb, BLOCK, N_KV_HEADS, Q_PER_KV, HEAD_DIM)

    def band(t):
        tp = jnp.pad(t, ((0, 0), (BLOCK, BLOCK), (0, 0), (0, 0)))
        tp = tp.reshape(B, nb + 2, BLOCK, N_KV_HEADS, HEAD_DIM)
        return jnp.concatenate([tp[:, :-2], tp[:, 1:-1], tp[:, 2:]], axis=2)

    kb, vb = band(k), band(v)
    scores = jnp.einsum('bnqhgd,bnkhd->bnhgqk', qb, kb,
                        preferred_element_type=jnp.float32) * (HEAD_DIM ** -0.5)
    scores = jnp.where(mask[None, :, None, None], scores, NEG_INF)
    sink_l = sink.astype(jnp.float32).reshape(1, 1, N_KV_HEADS, Q_PER_KV, 1, 1)
    m = jnp.maximum(jnp.max(scores, axis=-1, keepdims=True), sink_l)
    p = jnp.exp(scores - m)
    probs = p / (jnp.sum(p, axis=-1, keepdims=True) + jnp.exp(sink_l - m))
    out = jnp.einsum('bnhgqk,bnkhd->bnqhgd', probs.astype(v.dtype), vb)
    return out.reshape(B, S, ATTN_WIDTH)


def fourier_mix(u, w_lin):
    B, S, _ = u.shape
    ug = u.reshape(B, S, N_FOURIER_GROUPS, FOURIER_GROUP_DIM).astype(jnp.float32)
    f = jnp.fft.fft2(ug, axes=(1, 3), norm='ortho').real.astype(u.dtype)
    out = jnp.einsum('bsgc,gce->bsge', f, w_lin)
    return out.reshape(B, S, FOURIER_WIDTH)


def swiglu(h, w_gate, w_up, w_down):
    return (jax.nn.silu(h @ w_gate) * (h @ w_up)) @ w_down


def encoder_trunk(x, c, w_mod, b_mod, pre_g, post_g, ffn_w_gate, ffn_w_up, ffn_w_down,
                  w_in, attn_sink, fourier_w, branch_g, w_out):
    B, S, D = x.shape
    cos, sin = rope_tables(S)
    mask = band_mask(S)
    c_act = jax.nn.silu(c)
    for l in range(DEPTH):
        mod = (c_act @ w_mod[l] + b_mod[l]).reshape(B, N_SUBLAYERS, N_MOD, D)

        def pre(xx, j):
            shift = mod[:, j, 0][:, None, :]
            scale = mod[:, j, 1][:, None, :]
            return rms_norm(xx, pre_g[l, j]) * (1.0 + scale) + shift

        def post(xx, y, j, weight):
            gate = mod[:, j, 2][:, None, :]
            return xx + weight * (1.0 + gate) * rms_norm(y, post_g[l, j])

        h = pre(x, 0)
        x = post(x, swiglu(h, ffn_w_gate[l, 0], ffn_w_up[l, 0], ffn_w_down[l, 0]), 0, 0.5)

        h = pre(x, 1)
        proj = h @ w_in[l]
        q = proj[..., :ATTN_WIDTH]
        k = proj[..., ATTN_WIDTH:ATTN_WIDTH + KV_WIDTH]
        v = proj[..., ATTN_WIDTH + KV_WIDTH:ATTN_WIDTH + 2 * KV_WIDTH]
        u = proj[..., ATTN_WIDTH + 2 * KV_WIDTH:]
        a_out = rms_norm(windowed_gqa_attention(q, k, v, attn_sink[l], cos, sin, mask), branch_g[l, 0])
        f_out = rms_norm(fourier_mix(u, fourier_w[l]), branch_g[l, 1])
        y = jnp.concatenate([a_out, f_out], axis=-1) @ w_out[l]
        x = post(x, y, 1, 1.0)

        h = pre(x, 2)
        x = post(x, swiglu(h, ffn_w_gate[l, 1], ffn_w_up[l, 1], ffn_w_down[l, 1]), 2, 0.5)
    return x


def setup_inputs(seed: int = 0) -> dict:
    key = jax.random.key(seed)
    ks = jax.random.split(key, 18)
    f32 = jnp.float32

    def nrm(k, shape, scale):
        return jax.random.normal(k, shape, f32) * scale

    return {
        "x_prompt": nrm(ks[0], (BATCH, SEQ, D_MODEL), 1.0),
        "x_sample": nrm(ks[1], (DEC_BATCH, DEC_SEQ, D_MODEL), 1.0),
        "c_prompt": nrm(ks[2], (BATCH, D_MODEL), 1.0),
        "c_sample": nrm(ks[3], (DEC_BATCH, D_MODEL), 1.0),
        "w_mod": nrm(ks[4], (DEPTH, D_MODEL, N_SUBLAYERS * N_MOD * D_MODEL), MOD_SCALE * D_MODEL ** -0.5),
        "b_mod": nrm(ks[5], (DEPTH, N_SUBLAYERS * N_MOD * D_MODEL), 0.01),
        "pre_g": 1.0 + nrm(ks[6], (DEPTH, N_SUBLAYERS, D_MODEL), 0.05),
        "post_g": 1.0 + nrm(ks[7], (DEPTH, N_SUBLAYERS, D_MODEL), 0.05),
        "ffn_w_gate": nrm(ks[8], (DEPTH, 2, D_MODEL, D_FF), D_MODEL ** -0.5),
        "ffn_w_up": nrm(ks[9], (DEPTH, 2, D_MODEL, D_FF), D_MODEL ** -0.5),
        "ffn_w_down": nrm(ks[10], (DEPTH, 2, D_FF, D_MODEL), D_FF ** -0.5),
        "w_in": nrm(ks[11], (DEPTH, D_MODEL, IN_PROJ_WIDTH), D_MODEL ** -0.5),
        "attn_sink": nrm(ks[12], (DEPTH, N_Q_HEADS), 0.5),
        "fourier_w": nrm(ks[13], (DEPTH, N_FOURIER_GROUPS, FOURIER_GROUP_DIM, FOURIER_GROUP_DIM), FOURIER_GROUP_DIM ** -0.5),
        "branch_g": 1.0 + nrm(ks[14], (DEPTH, 2, ATTN_WIDTH), 0.05),
        "w_out": nrm(ks[15], (DEPTH, MIX_WIDTH, D_MODEL), MIX_WIDTH ** -0.5),
    }


def reference(x_prompt, x_sample, c_prompt, c_sample, w_mod, b_mod, pre_g, post_g,
              ffn_w_gate, ffn_w_up, ffn_w_down, w_in, attn_sink, fourier_w, branch_g, w_out):
    y_prompt = encoder_trunk(x_prompt, c_prompt, w_mod, b_mod, pre_g, post_g, ffn_w_gate, ffn_w_up,
                             ffn_w_down, w_in, attn_sink, fourier_w, branch_g, w_out)
    y_sample = encoder_trunk(x_sample, c_sample, w_mod, b_mod, pre_g, post_g, ffn_w_gate, ffn_w_up,
                             ffn_w_down, w_in, attn_sink, fourier_w, branch_g, w_out)
    return (y_prompt, y_sample)
```

```cpp
#include <hip/hip_runtime.h>
#include <cstdio>
#include <cstdint>

#define LAS __attribute__((address_space(3)))
#define GAS __attribute__((address_space(1)))
typedef unsigned short bf16;
typedef short bf16x8 __attribute__((ext_vector_type(8)));
typedef float f32x4 __attribute__((ext_vector_type(4)));
typedef float f32x2 __attribute__((ext_vector_type(2)));
typedef unsigned u32x4 __attribute__((ext_vector_type(4)));
typedef int i32x4 __attribute__((ext_vector_type(4)));
typedef unsigned u32x2 __attribute__((ext_vector_type(2)));
typedef GAS unsigned gu32;

constexpr int DM = 2048, SEQ = 8192, NSEQ = 5, M = NSEQ * SEQ, DFF = 5632, DEPTH = 2;
constexpr int NQ = 1024, NKV = 256, NIN = 2560, NMOD = 18432;
constexpr float RMS_EPS = 1e-6f;
constexpr float QSCALE = 0.08838834764831845f * 1.4426950408889634f;
constexpr float LOG2E = 1.4426950408889634f;
constexpr int NWAVES = 8, NTHREADS = 512;

constexpr size_t MiB = 1u << 20;
constexpr size_t WS_CTL = 0, CTL_ZERO_BYTES = 1 * MiB;
constexpr size_t WS_AMAX = 262144;
constexpr size_t WS_COEF = 1 * MiB;
constexpr size_t WS_SA = WS_COEF + 768 * 1024;
constexpr size_t WS_ROPE = 2 * MiB;
constexpr size_t WS_D1 = 6 * MiB;
constexpr size_t WS_D2 = 6 * MiB + 65536;
constexpr size_t WS_WCS = 7 * MiB;
constexpr size_t WS_W = 9 * MiB;
constexpr size_t W_GU = 0;
constexpr size_t W_D = W_GU + (size_t)2 * 11264 * 2048 * 2;
constexpr size_t W_QK = W_D + (size_t)2 * 2048 * 5632 * 2;
constexpr size_t W_V = W_QK + (size_t)2304 * 2048 * 2;
constexpr size_t W_Z = W_V + (size_t)256 * 2048 * 2;
constexpr size_t W_O = W_Z + (size_t)1024 * 2048 * 2;
constexpr size_t W_LAYER = W_O + (size_t)2048 * 2048 * 2;
static_assert(W_LAYER == 154 * MiB, "weights per layer");
constexpr size_t WS_X = WS_W + 2 * W_LAYER;
constexpr size_t WS_Y = WS_X + 160 * MiB;
constexpr size_t WS_BIG = WS_Y + 160 * MiB;
constexpr size_t WS_Q = WS_BIG, WS_KB = WS_BIG + 80 * MiB, WS_VT = WS_BIG + 100 * MiB, WS_Z1 = WS_BIG + 120 * MiB, WS_Y2 = WS_BIG + 280 * MiB, WS_U = WS_Y2;
constexpr size_t WS_END = WS_BIG + 440 * MiB;
static_assert((size_t)M * DFF * 2 == 440 * MiB && (size_t)M * DM * 2 == 160 * MiB, "sizes");

constexpr int RING_BYTES = 131072;
constexpr int LDSCTL_OFF = 147456, MISC_OFF = LDSCTL_OFF + 320, SSQ_OFF = LDSCTL_OFF + 512;
constexpr int LDS_BYTES = 147456 + 2048;

#define LDS_WAIT() asm volatile("s_waitcnt lgkmcnt(0)" ::: "memory")
#define VM_WAIT() asm volatile("s_waitcnt vmcnt(0)" ::: "memory")
__device__ __forceinline__ unsigned f2bf(float f) { unsigned u = __builtin_bit_cast(unsigned, f); return (u + 0x7fffu + ((u >> 16) & 1u)) >> 16; }
__device__ __forceinline__ unsigned pk2(float lo, float hi) { return f2bf(lo) | (f2bf(hi) << 16); }
__device__ __forceinline__ float bflo(unsigned w) { return __builtin_bit_cast(float, w << 16); }
__device__ __forceinline__ float bfhi(unsigned w) { return __builtin_bit_cast(float, w & 0xffff0000u); }
__device__ __forceinline__ unsigned cvt_pk_bf16(float lo, float hi) { unsigned r; asm volatile("v_cvt_pk_bf16_f32 %0, %1, %2" : "=v"(r) : "v"(lo), "v"(hi)); return r; }

__device__ __forceinline__ int lane_fresh() { int l; asm volatile("v_mbcnt_lo_u32_b32 %0, -1, 0\n\tv_mbcnt_hi_u32_b32 %0, -1, %0" : "=v"(l)); return l; }
__device__ __forceinline__ size_t opaque_zero() { size_t z = 0; asm volatile("" : "+s"(z)); return z; }
namespace pg8 {
constexpr int BM = 256, BK = 64, HALF = 128, HTB = HALF * BK * 2, STAGE_BYTES = 8 * HTB, NXCD = 8, WGM = 4;
__host__ __device__ __forceinline__ int lds_byte(int r, int c) { const int st = (r >> 4) * 2 + (c >> 5), rr = r & 15, cc = c & 31, ob = rr * 64 + cc * 2; return st * 1024 + (ob ^ (((ob >> 9) & 1) << 5)); }
__host__ __device__ __forceinline__ void stage_rc(int b, int& R, int& C) { const int st = b / 1024, sb = b % 1024, swz = sb ^ (((sb >> 9) & 1) << 5); R = (st >> 1) * 16 + swz / 64; C = (st & 1) * 32 + (swz % 64) / 2; }
__host__ __device__ __forceinline__ int perm32(int rho) { const int n = rho >> 4, i = rho & 15; return 8 * (i >> 2) + 4 * n + (i & 3); }

struct Unit { int pm, pn; };
struct StaticOrder {
    int nM, nN, nwg, G, c;
    __device__ void init(int Mr, int Nc, int G_, int c_) { nM = Mr / BM; nN = Nc / BM; nwg = nM * nN; G = G_; c = c_; }
    __device__ bool next(int i, Unit& u) const {
        const long L = (long)i * G + c; if (L >= nwg) return false;
        int wgid = (int)L; { const int q = nwg / NXCD, r = nwg % NXCD, xcd = wgid % NXCD, off = wgid / NXCD; wgid = (xcd < r ? xcd * (q + 1) : r * (q + 1) + (xcd - r) * q) + off; }
        const int nig = WGM * nN, gid = wgid / nig, fm = gid * WGM, gsz = (nM - fm) < WGM ? (nM - fm) : WGM;
        u.pm = fm + ((wgid % nig) % gsz); u.pn = (wgid % nig) / gsz; return true;
    }
};

struct GeoPlain {
    const char* A; const char* B; int K;
    __device__ __forceinline__ int nt() const { return K / BK; }
    __device__ __forceinline__ const char* a_base(const Unit& u) const { return A + (size_t)u.pm * BM * K * 2; }
    __device__ __forceinline__ const char* b_base(const Unit& u) const { return B + (size_t)u.pn * BM * K * 2; }
    __device__ __forceinline__ unsigned a_off(int R, int C) const { return (unsigned)(R * K + C) * 2u; }
    __device__ __forceinline__ unsigned b_off(int R, int C) const { return (unsigned)(R * K + C) * 2u; }
    __device__ __forceinline__ size_t a_hstep() const { return (size_t)HALF * K * 2; }
    __device__ __forceinline__ size_t b_hstep() const { return (size_t)HALF * K * 2; }
    __device__ __forceinline__ size_t a_kstep() const { return BK * 2; }
    __device__ __forceinline__ size_t b_kstep() const { return BK * 2; }
};
struct GeoP1 {
    const char* A; const char* B;
    __device__ __forceinline__ int nt() const { return 2; }
    __device__ __forceinline__ const char* a_base(const Unit& u) const { return A + (size_t)u.pm * 256 * 128 * 2; }
    __device__ __forceinline__ const char* b_base(const Unit& u) const { return B + ((size_t)(u.pn >> 5) * SEQ + 4 * (u.pn & 31)) * 1024 * 2 + (size_t)u.pm * 128 * 2; }
    __device__ __forceinline__ unsigned a_off(int R, int C) const { return (unsigned)(R * 128 + C) * 2u; }
    __device__ __forceinline__ unsigned b_off(int R, int C) const { return (unsigned)((128 * (R & 63) + (R >> 6)) * 1024 + C) * 2u; }
    __device__ __forceinline__ size_t a_hstep() const { return (size_t)HALF * 128 * 2; }
    __device__ __forceinline__ size_t b_hstep() const { return (size_t)2 * 1024 * 2; }
    __device__ __forceinline__ size_t a_kstep() const { return BK * 2; }
    __device__ __forceinline__ size_t b_kstep() const { return BK * 2; }
};
struct GeoP2 {
    const char* A; const char* B;
    __device__ __forceinline__ int nt() const { return 2; }
    __device__ __forceinline__ const char* a_base(const Unit&) const { return A + opaque_zero(); }
    __device__ __forceinline__ const char* b_base(const Unit& u) const { const int ep = u.pn & 63, g = (u.pn >> 6) & 7, b = u.pn >> 9; return B + ((size_t)(g * 256 + 2 * ep) * M + (size_t)b * SEQ) * 2; }
    __device__ __forceinline__ unsigned a_off(int R, int C) const { return (unsigned)(R * 128 + C) * 2u; }
    __device__ __forceinline__ unsigned b_off(int R, int C) const { return (unsigned)(R * 64 + C) * 2u; }
    __device__ __forceinline__ size_t a_hstep() const { return (size_t)HALF * 128 * 2; }
    __device__ __forceinline__ size_t b_hstep() const { return (size_t)M * 2; }
    __device__ __forceinline__ size_t a_kstep() const { return BK * 2; }
    __device__ __forceinline__ size_t b_kstep() const { return (size_t)128 * M * 2; }
};

struct EpiSwiGLU8;
template <class E> struct AccT { using T = f32x4; static constexpr bool I8 = false; };
template <> struct AccT<EpiSwiGLU8> { using T = i32x4; static constexpr bool I8 = true; };
template <class Epi, class Geo>
__device__ __forceinline__ void gemm_phase(LAS unsigned char* lds, const int wid_in, const Geo geo, const StaticOrder& S, const Epi& E) {
    int wid = wid_in; asm volatile("" : "+s"(wid));
    const int lane = lane_fresh(), tid = wid * 64 + lane, wr = wid >> 2, wc = wid & 3, fr = lane & 15, fq = lane >> 4;
    const int nt = geo.nt();
    unsigned voffA[2], voffB[2];
#pragma unroll
    for (int i = 0; i < 2; ++i) { int R, C; stage_rc(tid * 16 + i * 8192, R, C); const int Rb = (R & ~31) + perm32(R & 31);
        voffA[i] = geo.a_off(R, C); voffB[i] = geo.b_off(Rb, C); }
    const size_t kstepA = geo.a_kstep(), kstepB = geo.b_kstep(), hstepA = geo.a_hstep(), hstepB = geo.b_hstep();
    const unsigned ldsw = (unsigned)wid * 1024u;
    const int aoff = lds_byte(wr * 64 + fr, fq * 8), boff = lds_byte(wc * 32 + fr, fq * 8);
#define PG8_SA(b, h) (((b) * 2 + (h)) * HTB)
#define PG8_SB(b, h) ((4 + (b) * 2 + (h)) * HTB)
#define PG8_STAGE(bufoff, gbase, voff) do { _Pragma("unroll") for (int _i = 0; _i < 2; ++_i) \
        __builtin_amdgcn_global_load_lds((const unsigned*)((const char*)(gbase) + (voff)[_i]), (LAS unsigned*)(lds + (bufoff) + ldsw + _i * 8192), 16, 0, 0); } while (0)
#define PG8_LDA(dst, b, h) do { _Pragma("unroll") for (int m = 0; m < 4; ++m) _Pragma("unroll") for (int k = 0; k < 2; ++k) dst[m][k] = *(const LAS bf16x8*)(lds + PG8_SA(b, h) + aoff + m * 2048 + k * 1024); } while (0)
#define PG8_LDB(dst, b, h) do { _Pragma("unroll") for (int n = 0; n < 2; ++n) _Pragma("unroll") for (int k = 0; k < 2; ++k) dst[n][k] = *(const LAS bf16x8*)(lds + PG8_SB(b, h) + boff + n * 2048 + k * 1024); } while (0)
#define PG8_MMA(ai, bj, At, Bt) do { if constexpr ((ai) == 1 && Epi::SKIP_AI1) break; __builtin_amdgcn_s_setprio(1); _Pragma("unroll") for (int m = 0; m < 4; ++m) _Pragma("unroll") for (int n = 0; n < 2; ++n) _Pragma("unroll") for (int k = 0; k < 2; ++k) \
        { if constexpr (AccT<Epi>::I8) acc[ai][bj][m][n] = __builtin_amdgcn_mfma_i32_16x16x64_i8(__builtin_bit_cast(i32x4, Bt[n][k]), __builtin_bit_cast(i32x4, At[m][k]), acc[ai][bj][m][n], 0, 0, 0); \
          else acc[ai][bj][m][n] = __builtin_amdgcn_mfma_f32_16x16x32_bf16(Bt[n][k], At[m][k], acc[ai][bj][m][n], 0, 0, 0); } __builtin_amdgcn_s_setprio(0); } while (0)
#define PG8_WAIT_V(n) asm volatile("s_waitcnt vmcnt(" #n ")" ::: "memory")
#define PG8_WAIT_L(n) asm volatile("s_waitcnt lgkmcnt(" #n ")" ::: "memory")
#define PG8_BAR __builtin_amdgcn_s_barrier()
#define PG8_SCHED __builtin_amdgcn_sched_barrier(0)
    Unit cur, nxt; int ui = 0;
    if (!S.next(0, cur)) return;
    typedef typename AccT<Epi>::T acc_t;
    acc_t acc[2][2][4][2];
#pragma unroll
    for (int a = 0; a < 2; ++a)
#pragma unroll
        for (int b = 0; b < 2; ++b)
#pragma unroll
            for (int m = 0; m < 4; ++m)
#pragma unroll
                for (int n = 0; n < 2; ++n) acc[a][b][m][n] = (acc_t){0, 0, 0, 0};
    bf16x8 At[4][2], B0[2][2], B1[2][2];
    const char* cA = geo.a_base(cur); const char* cB = geo.b_base(cur);
    PG8_STAGE(PG8_SB(0, 0), cB, voffB); PG8_STAGE(PG8_SB(0, 1), cB + hstepB, voffB); PG8_STAGE(PG8_SA(0, 0), cA, voffA); PG8_STAGE(PG8_SA(0, 1), cA + hstepA, voffA);
    if (wr == 1) PG8_BAR;
    PG8_WAIT_V(2); PG8_BAR;
    PG8_STAGE(PG8_SB(1, 0), cB + kstepB, voffB); PG8_STAGE(PG8_SA(1, 0), cA + kstepA, voffA); PG8_STAGE(PG8_SB(1, 1), cB + hstepB + kstepB, voffB);
    PG8_WAIT_V(6); PG8_BAR;
    for (;;) {
        const bool has_next = S.next(ui + 1, nxt);
        const char* nA = has_next ? geo.a_base(nxt) : cA; const char* nB = has_next ? geo.b_base(nxt) : cB;
        for (int t = 0; t < nt; t += 2) {
            const bool last = (t == nt - 2);
            if constexpr (AccT<Epi>::I8) { if (t == 0) E.stage(lds + RING_BYTES + (ui & 1) * 2048 + wid * 256, cur, wid, lane_fresh()); }
            const char* a1 = cA + (size_t)(t + 1) * kstepA;
            const char* a2 = last ? nA : cA + (size_t)(t + 2) * kstepA; const char* b2 = last ? nB : cB + (size_t)(t + 2) * kstepB;
            const char* a3 = a2 + kstepA; const char* b3 = b2 + kstepB;
            PG8_LDB(B0, 0, 0); PG8_LDB(B1, 0, 1); PG8_SCHED; PG8_LDA(At, 0, 0); PG8_STAGE(PG8_SA(1, 1), a1 + hstepA, voffA);
            PG8_WAIT_V(8); PG8_WAIT_L(0); PG8_BAR; PG8_MMA(0, 0, At, B0); PG8_MMA(0, 1, At, B1); PG8_BAR; PG8_SCHED;
            PG8_LDA(At, 0, 1); PG8_STAGE(PG8_SB(0, 0), b2, voffB); PG8_STAGE(PG8_SB(0, 1), b2 + hstepB, voffB); PG8_STAGE(PG8_SA(0, 0), a2, voffA);
            PG8_WAIT_V(8); PG8_WAIT_L(0); PG8_BAR; PG8_MMA(1, 0, At, B0); PG8_MMA(1, 1, At, B1); PG8_BAR; PG8_SCHED;
            PG8_LDB(B0, 1, 0); PG8_LDB(B1, 1, 1); PG8_SCHED; PG8_LDA(At, 1, 0); PG8_STAGE(PG8_SA(0, 1), a2 + hstepA, voffA);
            PG8_WAIT_V(8); PG8_WAIT_L(0); PG8_BAR; PG8_MMA(0, 0, At, B0); PG8_MMA(0, 1, At, B1); PG8_BAR; PG8_SCHED;
            PG8_LDA(At, 1, 1); PG8_STAGE(PG8_SB(1, 0), b3, voffB); PG8_STAGE(PG8_SB(1, 1), b3 + hstepB, voffB); PG8_STAGE(PG8_SA(1, 0), a3, voffA);
            PG8_WAIT_V(8); PG8_WAIT_L(0); PG8_BAR; PG8_MMA(1, 0, At, B0); PG8_MMA(1, 1, At, B1); PG8_BAR; PG8_SCHED;
        }
        if (wr == 0) PG8_BAR;
        { const int le = lane_fresh();
          if constexpr (AccT<Epi>::I8) E(acc, cur, wr, wc, le & 15, le >> 4, (const LAS float*)(lds + RING_BYTES + (ui & 1) * 2048));
          else E(acc, cur, wr, wc, le & 15, le >> 4); }
        if (!has_next) break;
#pragma unroll
        for (int a = 0; a < 2; ++a)
#pragma unroll
            for (int b = 0; b < 2; ++b)
#pragma unroll
                for (int m = 0; m < 4; ++m)
#pragma unroll
                    for (int n = 0; n < 2; ++n) acc[a][b][m][n] = (acc_t){0, 0, 0, 0};
        cur = nxt; cA = nA; cB = nB; ++ui;
        if (wr == 1) PG8_BAR;
    }
    PG8_WAIT_V(0);
    PG8_BAR;
#undef PG8_SA
#undef PG8_SB
#undef PG8_STAGE
#undef PG8_LDA
#undef PG8_LDB
#undef PG8_MMA
#undef PG8_WAIT_V
#undef PG8_WAIT_L
#undef PG8_BAR
#undef PG8_SCHED
}

struct EpiBf16 {
    static constexpr bool SKIP_AI1 = false;
    bf16* O; size_t ldc;
    __device__ __forceinline__ void operator()(const f32x4 (&acc)[2][2][4][2], const Unit& u, int wr, int wc, int fr, int fq) const {
        const int row0 = u.pm * BM + wr * 64 + fr, col0 = u.pn * BM + wc * 32 + 8 * fq;
#pragma unroll
        for (int ai = 0; ai < 2; ++ai)
#pragma unroll
            for (int m = 0; m < 4; ++m) { bf16* rowp = O + (size_t)(row0 + ai * HALF + m * 16) * ldc + col0;
#pragma unroll
                for (int bj = 0; bj < 2; ++bj) { const f32x4 v0 = acc[ai][bj][m][0], v1 = acc[ai][bj][m][1];
                    u32x4 w; w.x = cvt_pk_bf16(v0[0], v0[1]); w.y = cvt_pk_bf16(v0[2], v0[3]); w.z = cvt_pk_bf16(v1[0], v1[1]); w.w = cvt_pk_bf16(v1[2], v1[3]);
                    *(u32x4*)(rowp + bj * HALF) = w; } }
    }
};
__device__ __forceinline__ float silu_mul(float g, float u) { return g * u * __builtin_amdgcn_rcpf(1.0f + __expf(-g)); }
struct EpiSwiGLU {
    static constexpr bool SKIP_AI1 = false;
    bf16* O;
    __device__ __forceinline__ void operator()(const f32x4 (&acc)[2][2][4][2], const Unit& u, int wr, int wc, int fr, int fq) const {
        const int row0 = u.pm * BM + wr * 64 + fr, col0 = u.pn * HALF + wc * 32 + 8 * fq;
#pragma unroll
        for (int ai = 0; ai < 2; ++ai)
#pragma unroll
            for (int m = 0; m < 4; ++m) { bf16* rowp = O + (size_t)(row0 + ai * HALF + m * 16) * DFF + col0;
                const f32x4 g0 = acc[ai][0][m][0], g1 = acc[ai][0][m][1], u0 = acc[ai][1][m][0], u1 = acc[ai][1][m][1];
                u32x4 w; w.x = cvt_pk_bf16(silu_mul(g0[0], u0[0]), silu_mul(g0[1], u0[1])); w.y = cvt_pk_bf16(silu_mul(g0[2], u0[2]), silu_mul(g0[3], u0[3]));
                w.z = cvt_pk_bf16(silu_mul(g1[0], u1[0]), silu_mul(g1[1], u1[1])); w.w = cvt_pk_bf16(silu_mul(g1[2], u1[2]), silu_mul(g1[3], u1[3]));
                *(u32x4*)rowp = w; }
    }
};
struct EpiSwiGLU8 {
    static constexpr bool SKIP_AI1 = false;
    bf16* O; const float* SA; const unsigned* AM;
    __device__ __forceinline__ void stage(LAS unsigned char* dst, const Unit& u, int wid, int lane) const {
        const unsigned* g = (wid < 4) ? (const unsigned*)SA + u.pm * BM + wid * 64 + lane : AM + u.pn * BM + (wid - 4) * 64 + lane;
        __builtin_amdgcn_global_load_lds(g, (LAS unsigned*)dst, 4, 0, 0);
    }
    __device__ __forceinline__ void operator()(const i32x4 (&acc)[2][2][4][2], const Unit& u, int wr, int wc, int fr, int fq, const LAS float* sl) const {
        const int row0 = u.pm * BM + wr * 64 + fr, col0 = u.pn * HALF + wc * 32 + 8 * fq;
        f32x4 sg[2], su[2]; float sa[2][4];
#pragma unroll
        for (int n = 0; n < 2; ++n) { sg[n] = *(const LAS f32x4*)(sl + 256 + wc * 32 + 8 * fq + 4 * n); su[n] = *(const LAS f32x4*)(sl + 256 + HALF + wc * 32 + 8 * fq + 4 * n); }
#pragma unroll
        for (int ai = 0; ai < 2; ++ai)
#pragma unroll
            for (int m = 0; m < 4; ++m) sa[ai][m] = sl[wr * 64 + fr + ai * HALF + m * 16];
#pragma unroll
        for (int n = 0; n < 2; ++n) { sg[n] *= (1.0f / 127.0f); su[n] *= (1.0f / 127.0f); }
#pragma unroll
        for (int ai = 0; ai < 2; ++ai)
#pragma unroll
            for (int m = 0; m < 4; ++m) { bf16* rowp = O + (size_t)(row0 + ai * HALF + m * 16) * DFF + col0; const float s = sa[ai][m];
                const f32x4 g0 = __builtin_convertvector(acc[ai][0][m][0], f32x4) * (sg[0] * s), g1 = __builtin_convertvector(acc[ai][0][m][1], f32x4) * (sg[1] * s);
                const f32x4 u0 = __builtin_convertvector(acc[ai][1][m][0], f32x4) * (su[0] * s), u1 = __builtin_convertvector(acc[ai][1][m][1], f32x4) * (su[1] * s);
                u32x4 w; w.x = cvt_pk_bf16(silu_mul(g0[0], u0[0]), silu_mul(g0[1], u0[1])); w.y = cvt_pk_bf16(silu_mul(g0[2], u0[2]), silu_mul(g0[3], u0[3]));
                w.z = cvt_pk_bf16(silu_mul(g1[0], u1[0]), silu_mul(g1[1], u1[1])); w.w = cvt_pk_bf16(silu_mul(g1[2], u1[2]), silu_mul(g1[3], u1[3]));
                *(u32x4*)rowp = w; }
    }
};
struct EpiRope {
    static constexpr bool SKIP_AI1 = false;
    static constexpr bool HOOK = false;
    bf16* Q; bf16* KB; const float* COS; const float* SIN; bf16* U;
    __device__ __forceinline__ void operator()(const f32x4 (&acc)[2][2][4][2], const Unit& u, int wr, int wc, int fr, int fq) const {
        if (u.pn >= 5) {
            const int row0u = u.pm * BM + wr * 64 + fr, col0 = (u.pn - 5) * BM + wc * 32 + 8 * fq;
#pragma unroll
            for (int ai = 0; ai < 2; ++ai)
#pragma unroll
                for (int m = 0; m < 4; ++m) { bf16* rowp = U + (size_t)(row0u + ai * HALF + m * 16) * 1024 + col0;
#pragma unroll
                    for (int bj = 0; bj < 2; ++bj) { const f32x4 v0 = acc[ai][bj][m][0], v1 = acc[ai][bj][m][1];
                        u32x4 w; w.x = cvt_pk_bf16(v0[0], v0[1]); w.y = cvt_pk_bf16(v0[2], v0[3]); w.z = cvt_pk_bf16(v1[0], v1[1]); w.w = cvt_pk_bf16(v1[2], v1[3]);
                        *(u32x4*)(rowp + bj * HALF) = w; } }
            return;
        }
        const int row0 = u.pm * BM + wr * 64 + fr, hsel = wc >> 1, d0 = 32 * (wc & 1) + 8 * fq;
        const bool isq = u.pn < 4; const float sc = isq ? QSCALE : 1.0f;
        bf16* base = isq ? Q + (2 * u.pn + hsel) * 128 + d0 : KB + hsel * 128 + d0; const size_t ld = isq ? NQ : NKV;
#pragma unroll
        for (int ai = 0; ai < 2; ++ai) {
            f32x4 c0[4], c1[4], s0[4], s1[4];
#pragma unroll
            for (int m = 0; m < 4; ++m) { const int pos = (row0 + ai * HALF + m * 16) & (SEQ - 1);
                c0[m] = *(const f32x4*)(COS + pos * 64 + d0); c1[m] = *(const f32x4*)(COS + pos * 64 + d0 + 4); s0[m] = *(const f32x4*)(SIN + pos * 64 + d0); s1[m] = *(const f32x4*)(SIN + pos * 64 + d0 + 4); }
            u32x4 w1[4], w2[4];
#pragma unroll
            for (int m = 0; m < 4; ++m) {
                const f32x4 a0 = acc[ai][0][m][0], a1 = acc[ai][0][m][1], b0 = acc[ai][1][m][0], b1 = acc[ai][1][m][1];
                const f32x4 o10 = (a0 * c0[m] - b0 * s0[m]) * sc, o11 = (a1 * c1[m] - b1 * s1[m]) * sc, o20 = (a0 * s0[m] + b0 * c0[m]) * sc, o21 = (a1 * s1[m] + b1 * c1[m]) * sc;
                w1[m].x = cvt_pk_bf16(o10[0], o10[1]); w1[m].y = cvt_pk_bf16(o10[2], o10[3]); w1[m].z = cvt_pk_bf16(o11[0], o11[1]); w1[m].w = cvt_pk_bf16(o11[2], o11[3]);
                w2[m].x = cvt_pk_bf16(o20[0], o20[1]); w2[m].y = cvt_pk_bf16(o20[2], o20[3]); w2[m].z = cvt_pk_bf16(o21[0], o21[1]); w2[m].w = cvt_pk_bf16(o21[2], o21[3]); }
#pragma unroll
            for (int m = 0; m < 4; ++m) { bf16* rp = base + (size_t)(row0 + ai * HALF + m * 16) * ld; *(u32x4*)rp = w1[m]; *(u32x4*)(rp + 64) = w2[m]; }
        }
    }
};
struct EpiTwiddle {
    static constexpr bool SKIP_AI1 = false;
    bf16* Y2;
    __device__ __forceinline__ void operator()(const f32x4 (&acc)[2][2][4][2], const Unit& u, int wr, int wc, int fr, int fq) const {
        if (wr != 0) return;
        int zz = 0; asm volatile("" : "+v"(zz));
        const int ep = u.pn & 63, g = (u.pn >> 6) & 7, b = u.pn >> 9, s20 = wc * 32 + 8 * fq + zz;
#pragma unroll
        for (int m = 0; m < 4; ++m) { const int k1 = 16 * m + fr;
#pragma unroll
            for (int bj = 0; bj < 2; ++bj) { const int e = 2 * ep + bj; bf16* rp = Y2 + ((size_t)((b * 64 + k1) * 8 + g) * 128 + e) * 256 + s20;
                float re[8], im[8];
#pragma unroll
                for (int n = 0; n < 2; ++n)
#pragma unroll
                    for (int i = 0; i < 4; ++i) { const int s2 = s20 + 4 * n + i; const float fr_ = (float)((k1 * s2) & 8191) * (1.0f / 8192.0f);
                        const float ct = __builtin_amdgcn_cosf(fr_), st = __builtin_amdgcn_sinf(fr_); const float yr = acc[0][bj][m][n][i], yi = acc[1][bj][m][n][i];
                        re[4 * n + i] = yr * ct + yi * st; im[4 * n + i] = yi * ct - yr * st; }
                u32x4 w1, w2; w1.x = cvt_pk_bf16(re[0], re[1]); w1.y = cvt_pk_bf16(re[2], re[3]); w1.z = cvt_pk_bf16(re[4], re[5]); w1.w = cvt_pk_bf16(re[6], re[7]);
                w2.x = cvt_pk_bf16(im[0], im[1]); w2.y = cvt_pk_bf16(im[2], im[3]); w2.z = cvt_pk_bf16(im[4], im[5]); w2.w = cvt_pk_bf16(im[6], im[7]);
                *(u32x4*)rp = w1; *(u32x4*)(rp + 128) = w2; } }
    }
};
struct EpiDftOut {
    static constexpr bool SKIP_AI1 = true;
    bf16* MIX;
    __device__ __forceinline__ void operator()(const f32x4 (&acc)[2][2][4][2], const Unit& u, int wr, int wc, int fr, int fq) const {
        const int gp = u.pn & 3, k1 = (u.pn >> 2) & 63, b = u.pn >> 8;
#pragma unroll
        for (int m = 0; m < 4; ++m) { const int k2 = 64 * wr + 16 * m + fr; bf16* rp = MIX + (size_t)(b * SEQ + k1 + 64 * k2) * DM + 1024 + gp * 256 + wc * 32 + 8 * fq;
#pragma unroll
            for (int bj = 0; bj < 2; ++bj) { const f32x4 v0 = acc[0][bj][m][0], v1 = acc[0][bj][m][1];
                u32x4 w; w.x = cvt_pk_bf16(v0[0], v0[1]); w.y = cvt_pk_bf16(v0[2], v0[3]); w.z = cvt_pk_bf16(v1[0], v1[1]); w.w = cvt_pk_bf16(v1[2], v1[3]);
                *(u32x4*)(rp + bj * 128) = w; } }
    }
};
}

#define XB_TMO      128
#define XB_XCNT(j)  (256  + 64 * (j))
#define XB_XSUB(j)  (1280 + 64 * (j))
#define XB_XGEN(j)  (2304 + 64 * (j))
#define XB_TOP      3328
#define XB_TOPGEN   3392
#define XCD_BAR_WORDS 3456
#define XB_SPIN_CAP (1u << 18)
__device__ __forceinline__ unsigned xb_ld(unsigned* p)              { return __hip_atomic_load(p, __ATOMIC_RELAXED, __HIP_MEMORY_SCOPE_AGENT); }
__device__ __forceinline__ unsigned xb_add(unsigned* p, unsigned v) { return __hip_atomic_fetch_add(p, v, __ATOMIC_RELAXED, __HIP_MEMORY_SCOPE_AGENT); }
__device__ __forceinline__ unsigned xb_xcc_id() { return (unsigned)__builtin_amdgcn_s_getreg((3 << 11) | 20) & 0xFu; }
#define XB_SPIN(cond, bar) do { unsigned _sp = 0; while (cond) { __builtin_amdgcn_s_sleep(1); \
    if ((++_sp & 255u) == 0u) { if (xb_ld(&(bar)[XB_TMO])) break; if (_sp > XB_SPIN_CAP) { atomicAdd(&(bar)[XB_TMO], 1u); break; } } } } while (0)
struct XcdBarrier { unsigned* bar; unsigned x; volatile LAS unsigned* st; };
__device__ __forceinline__ XcdBarrier xcd_barrier_post(unsigned* bar, volatile LAS unsigned* st) {
    XcdBarrier b; b.bar = bar; b.x = xb_xcc_id(); b.st = st;
    if (threadIdx.x == 0) (void)xb_add(&bar[XB_XCNT(b.x)], 1u);
    return b;
}
__device__ __forceinline__ void xcd_barrier_complete(unsigned* bar, unsigned x, unsigned& nloc, unsigned& nx) {
    const unsigned G = gridDim.x * gridDim.y * gridDim.z;
    unsigned sum, cnt, mine, sp = 0u;
    for (;;) {
        sum = 0u; cnt = 0u; mine = 0u;
#pragma unroll
        for (unsigned j = 0; j < 16; ++j) { const unsigned c = xb_ld(&bar[XB_XCNT(j)]); sum += c; cnt += (c > 0u) ? 1u : 0u; mine = (j == x) ? c : mine; }
        if (sum == G) break;
        __builtin_amdgcn_s_sleep(1);
        if ((++sp & 255u) == 0u) { if (xb_ld(&bar[XB_TMO])) break; if (sp > XB_SPIN_CAP) { atomicAdd(&bar[XB_TMO], 1u); break; } }
    }
    nloc = mine > 0u ? mine : 1u; nx = cnt > 0u ? cnt : 1u;
}
__device__ __forceinline__ void xcd_barrier(const XcdBarrier& b, const bool leader) {
    asm volatile("s_waitcnt vmcnt(0)" ::: "memory");
    __syncthreads();
    if (leader) {
        unsigned* bar = b.bar;
        __builtin_amdgcn_s_waitcnt(0);
        unsigned nloc = b.st[0], nx = b.st[1];
        if (nloc == 0u) { xcd_barrier_complete(bar, b.x, nloc, nx); b.st[0] = nloc; b.st[1] = nx; }
        const unsigned old = xb_add(&bar[XB_XSUB(b.x)], 1u);
        const unsigned gen = old / nloc;
        if (old + 1u == (gen + 1u) * nloc) {
            __builtin_amdgcn_fence(__ATOMIC_RELEASE, "agent");
            asm volatile("s_waitcnt vmcnt(0)" ::: "memory");
            const unsigned og = xb_add(&bar[XB_TOP], 1u);
            const unsigned tg = og / nx;
            if (og + 1u == (tg + 1u) * nx) xb_add(&bar[XB_TOPGEN], 1u);
            else XB_SPIN(xb_ld(&bar[XB_TOPGEN]) == tg, bar);
            __builtin_amdgcn_fence(__ATOMIC_ACQUIRE, "agent");
            xb_add(&bar[XB_XGEN(b.x)], 1u);
            asm volatile("s_waitcnt vmcnt(0)" ::: "memory");
        } else {
            XB_SPIN(xb_ld(&bar[XB_XGEN(b.x)]) == gen, bar);
            __builtin_amdgcn_fence(__ATOMIC_ACQUIRE, "agent");
            asm volatile("s_waitcnt vmcnt(0)" ::: "memory");
        }
    }
    __syncthreads();
}

struct Args { const float* in[16]; float* out; unsigned char* ws; };
struct Frame {
    LAS unsigned char* lds; int tid, lane, wave, G, bid;
    const float *x_prompt, *x_sample, *c_prompt, *c_sample, *w_mod, *b_mod, *pre_g, *post_g, *w_gate, *w_up, *w_down, *w_in, *sink, *four_w, *branch_g, *w_out;
    bf16* XB; bf16* HB; float* OUT; unsigned char* ws;
};
__device__ __forceinline__ float shfl_xor_l(float v, int mask, int lane) { return __builtin_bit_cast(float, __builtin_amdgcn_ds_bpermute((lane ^ mask) << 2, __builtin_bit_cast(int, v))); }
__device__ __forceinline__ float wave_sum(float v, int lane) {
#pragma unroll
    for (int o = 1; o < 64; o <<= 1) v += shfl_xor_l(v, o, lane);
    return v;
}

__device__ __forceinline__ float wave_max(float v, int lane) {
#pragma unroll
    for (int o = 1; o < 64; o <<= 1) v = fmaxf(v, shfl_xor_l(v, o, lane));
    return v;
}
__device__ __forceinline__ unsigned q8_pack(float a, float b, float c, float d, float inv) {
    const unsigned ua = __float_as_uint(fmaf(a, inv, 12582912.0f)), ub = __float_as_uint(fmaf(b, inv, 12582912.0f)), uc = __float_as_uint(fmaf(c, inv, 12582912.0f)), ud = __float_as_uint(fmaf(d, inv, 12582912.0f));
    return __builtin_amdgcn_perm(__builtin_amdgcn_perm(ud, uc, 0x0c0c0400u), __builtin_amdgcn_perm(ub, ua, 0x0c0c0400u), 0x05040100u);
}

__device__ __forceinline__ void transpose_item(const float* W, size_t ldw, int K, bf16* WT, int dest_row0, int k0, int n0, LAS float* scr, int lane) {
#pragma unroll 8
    for (int i = 0; i < 32; ++i) { const int kk = 2 * i + (lane >> 5); scr[kk * 33 + (lane & 31)] = W[(size_t)(k0 + kk) * ldw + n0 + (lane & 31)]; }
    LDS_WAIT(); asm volatile("" ::: "memory");
    const int c = lane & 7;
#pragma unroll
    for (int j = 0; j < 4; ++j) { const int n = (lane >> 3) + 8 * j; const LAS float* s = scr + (8 * c) * 33 + n;
        u32x4 o; o.x = pk2(s[0 * 33], s[1 * 33]); o.y = pk2(s[2 * 33], s[3 * 33]); o.z = pk2(s[4 * 33], s[5 * 33]); o.w = pk2(s[6 * 33], s[7 * 33]);
        *(GAS u32x4*)(WT + (size_t)(dest_row0 + n) * K + k0 + 8 * c) = o; }
    LDS_WAIT(); asm volatile("" ::: "memory");
}
__device__ __forceinline__ void quant_item(const float* W, const unsigned* AM, unsigned char* W8T, int dest_row0, int k0, int n0, LAS float* scr, int lane) {
#pragma unroll 8
    for (int i = 0; i < 32; ++i) { const int kk = 2 * i + (lane >> 5); scr[kk * 33 + (lane & 31)] = W[(size_t)(k0 + kk) * DFF + n0 + (lane & 31)]; }
    const int n = lane >> 1, hf = lane & 1;
    const float am = __uint_as_float(AM[dest_row0 + n]), inv = am > 0.f ? 127.0f / am : 0.f;
    LDS_WAIT(); asm volatile("" ::: "memory");
    const LAS float* t = scr + (32 * hf) * 33 + n;
    u32x4 o0, o1;
    o0.x = q8_pack(t[0 * 33], t[1 * 33], t[2 * 33], t[3 * 33], inv);     o0.y = q8_pack(t[4 * 33], t[5 * 33], t[6 * 33], t[7 * 33], inv);
    o0.z = q8_pack(t[8 * 33], t[9 * 33], t[10 * 33], t[11 * 33], inv);   o0.w = q8_pack(t[12 * 33], t[13 * 33], t[14 * 33], t[15 * 33], inv);
    o1.x = q8_pack(t[16 * 33], t[17 * 33], t[18 * 33], t[19 * 33], inv); o1.y = q8_pack(t[20 * 33], t[21 * 33], t[22 * 33], t[23 * 33], inv);
    o1.z = q8_pack(t[24 * 33], t[25 * 33], t[26 * 33], t[27 * 33], inv); o1.w = q8_pack(t[28 * 33], t[29 * 33], t[30 * 33], t[31 * 33], inv);
    GAS unsigned char* dst = (GAS unsigned char*)(W8T + (size_t)(dest_row0 + n) * DM + k0 + 32 * hf);
    *(GAS u32x4*)dst = o0; *(GAS u32x4*)(dst + 16) = o1;
    LDS_WAIT(); asm volatile("" ::: "memory");
}
__device__ __forceinline__ bf16* wptr(Frame& F, int l, size_t off) { return (bf16*)(F.ws + WS_W + (size_t)l * W_LAYER + off); }

__device__ __forceinline__ void p0a(Frame& F) {
    {
        LAS float* sc = (LAS float*)F.lds;
        LAS float* red = (LAS float*)(F.lds + 40960);
        bool have_c = false;
        for (int it = F.bid; it < 144; it += F.G) {
            if (!have_c) {
                for (int i = F.tid; i < 5 * 2048; i += NTHREADS) { const int b = i >> 11, k = i & 2047; const float c = (b == 0) ? F.c_prompt[k] : F.c_sample[(b - 1) * 2048 + k]; sc[i] = c / (1.0f + __expf(-c)); }
                __syncthreads(); have_c = true;
            }
            const int l = it / 72, chunk = it % 72, col = chunk * 256 + 4 * F.lane;
            const float* wp = F.w_mod + (size_t)l * DM * NMOD + col;
            f32x4 a[5];
#pragma unroll
            for (int b = 0; b < 5; ++b) a[b] = (f32x4){0.f, 0.f, 0.f, 0.f};
            const int kbeg = F.wave * 256;
#pragma unroll 8
            for (int k = kbeg; k < kbeg + 256; ++k) { const f32x4 w = *(const f32x4*)(wp + (size_t)k * NMOD);
#pragma unroll
                for (int b = 0; b < 5; ++b) a[b] += w * sc[b * 2048 + k]; }
#pragma unroll
            for (int b = 0; b < 5; ++b) *(LAS f32x4*)(red + (F.wave * 5 + b) * 256 + 4 * F.lane) = a[b];
            __syncthreads();
            for (int o = F.tid; o < 5 * 256; o += NTHREADS) { const int b = o >> 8, cc = o & 255; float v = 0.f;
#pragma unroll
                for (int w = 0; w < 8; ++w) v += red[(w * 5 + b) * 256 + cc];
                const int jg = chunk * 256 + cc; v += F.b_mod[l * NMOD + jg];
                const int jj = jg / 6144, t = (jg % 6144) / 2048, cl = jg & 2047;
                float r;
                if (t == 0) r = v; else if (t == 1) r = F.pre_g[(l * 3 + jj) * DM + cl] * (1.0f + v); else r = ((jj == 1) ? 1.0f : 0.5f) * (1.0f + v) * F.post_g[(l * 3 + jj) * DM + cl];
                ((float*)(F.ws + WS_COEF))[((size_t)((l * 3 + jj) * 3 + t) * 5 + b) * DM + cl] = r; }
            __syncthreads();
        }
        __syncthreads();
    }
    {
        LAS float* red = (LAS float*)F.lds;
        unsigned* AM = (unsigned*)(F.ws + WS_AMAX);
        for (int it = (F.bid + F.G - 144 % F.G) % F.G; it < 704; it += F.G) {
            const int mat = it / 88, q = it % 88, chunk = q >> 2, kq = q & 3, up = mat & 1, lf = mat >> 1;
            const float* wp = (up ? F.w_up : F.w_gate) + (size_t)lf * DM * DFF + (size_t)(kq * 512 + F.wave * 64) * DFF + chunk * 256 + 4 * F.lane;
            f32x4 mx = (f32x4){0.f, 0.f, 0.f, 0.f};
#pragma unroll 8
            for (int k = 0; k < 64; ++k) { const f32x4 w = *(const f32x4*)(wp + (size_t)k * DFF);
                mx[0] = fmaxf(mx[0], fabsf(w[0])); mx[1] = fmaxf(mx[1], fabsf(w[1])); mx[2] = fmaxf(mx[2], fabsf(w[2])); mx[3] = fmaxf(mx[3], fabsf(w[3])); }
            *(LAS f32x4*)(red + F.wave * 256 + 4 * F.lane) = mx;
            __syncthreads();
            if (F.tid < 256) { float v = red[F.tid];
#pragma unroll
                for (int w = 1; w < 8; ++w) v = fmaxf(v, red[w * 256 + F.tid]);
                const int n = chunk * 256 + F.tid;
                atomicMax(AM + (size_t)lf * 11264 + 256 * (n >> 7) + (up ? 128 : 0) + (n & 127), __float_as_uint(v)); }
            __syncthreads();
        }
    }
    const int gt = F.bid * NTHREADS + F.tid, NGT = F.G * NTHREADS;
    for (int i = gt; i < SEQ * 64; i += NGT) { const int pos = i >> 6, k = i & 63; const float inv = (float)pow(10000.0, -(double)(2 * k) / 128.0); const float ang = (float)pos * inv;
        double sd, cd; sincos((double)ang, &sd, &cd); ((float*)(F.ws + WS_ROPE))[i] = (float)cd; ((float*)(F.ws + WS_ROPE + 2 * MiB))[i] = (float)sd; }
    for (int i = gt; i < 256 * 128; i += NGT) { const int R = i >> 7, c = i & 127, pp = R >> 7, kk = R & 127, part = c >> 6, s1 = c & 63; float v = 0.f;
        if (kk < 64) { const float fr = (float)((kk * s1) & 63) * (2.0f / 64.0f); const float cv = cospif(fr), sv = sinpif(fr); v = (pp == part) ? cv : (pp == 0 ? sv : -sv); v *= 0.125f; }
        ((bf16*)(F.ws + WS_D1))[i] = (bf16)f2bf(v); }
    for (int i = gt; i < 256 * 256; i += NGT) { const int R = i >> 8, c = i & 255, pp = c >> 7, s2 = c & 127; float v = 0.f;
        if (R < 128) { const float fr = (float)((R * s2) & 127) * (2.0f / 128.0f); v = (pp == 0 ? cospif(fr) : sinpif(fr)) * 0.08838834764831845f; }
        ((bf16*)(F.ws + WS_D2))[i] = (bf16)f2bf(v); }
    {
        LAS float* tab = (LAS float*)F.lds;
        if (F.tid < 128) { const float fr = (float)F.tid * (2.0f / 128.0f); tab[F.tid] = cospif(fr); tab[128 + F.tid] = sinpif(fr); }
        __syncthreads();
        for (int i = gt; i < 2 * 8 * 128 * 256; i += NGT) { const int e2 = i & 255, c = (i >> 8) & 127, lg = i >> 15; const int e = e2 & 127; const bool im = e2 >= 128;
            const float* wl = F.four_w + (size_t)lg * 128 * 128 + e; float s = 0.f;
#pragma unroll 8
            for (int m = 0; m < 128; ++m) s += tab[(im ? 128 : 0) + ((m * c) & 127)] * wl[m * 128];
            ((bf16*)(F.ws + WS_WCS))[((size_t)lg * 256 + e2) * 128 + c] = (bf16)f2bf((im ? -s : s) * 0.08838834764831845f); }
        __syncthreads();
    }
    {
        LAS float* scr = (LAS float*)(F.lds + F.wave * 16384);
        const int gw = F.bid * NWAVES + F.wave, NGW = F.G * NWAVES;
        constexpr int I_D = 2 * 88 * 64, I_QK = 32 * 72, I_V = 32 * 8, I_O = 32 * 64;
        constexpr int I_L = I_D + I_QK + I_V + I_O;
        for (int it = gw; it < 2 * I_L; it += NGW) {
            const int l = it / I_L; int r = it % I_L;
            if (r < I_D) { const int fi = r / (88 * 64), q = r % (88 * 64), kb = q / 64, nb = q % 64;
                transpose_item(F.w_down + (size_t)(l * 2 + fi) * DFF * DM, DM, DFF, wptr(F, l, W_D) + (size_t)fi * 2048 * 5632, nb * 32, kb * 64, nb * 32, scr, F.lane); continue; }
            r -= I_D;
            if (r < I_QK) { const int kb = r / 72, nb = r % 72; int n0 = nb * 32; int dest;
                if (nb >= 40) { dest = n0; n0 += 256; }
                else if (n0 < 1024) { const int head = n0 >> 7, half = (n0 >> 6) & 1, x = n0 & 63; dest = 256 * (head >> 1) + 128 * half + 64 * (head & 1) + x; }
                else { const int q = n0 - 1024, hs = q >> 7, half = (q >> 6) & 1, x = q & 63; dest = 1024 + 128 * half + 64 * hs + x; }
                transpose_item(F.w_in + (size_t)l * DM * NIN, NIN, DM, wptr(F, l, W_QK), dest, kb * 64, n0, scr, F.lane); continue; }
            r -= I_QK;
            if (r < I_V) { const int kb = r / 8, nb = r % 8;
                transpose_item(F.w_in + (size_t)l * DM * NIN, NIN, DM, wptr(F, l, W_V), nb * 32, kb * 64, 1280 + nb * 32, scr, F.lane); continue; }
            r -= I_V;
            { const int kb = r / 64, nb = r % 64;
                transpose_item(F.w_out + (size_t)l * DM * DM, DM, DM, wptr(F, l, W_O), nb * 32, kb * 64, nb * 32, scr, F.lane); }
        }
    }
}

__device__ __forceinline__ void p0b_quant(Frame& F) {
    LAS float* scr = (LAS float*)(F.lds + 65536 + F.wave * 8704);
    const int gw = F.bid * NWAVES + F.wave, NGW = F.G * NWAVES;
    constexpr int I_M = 32 * 176;
    for (int it = gw; it < 8 * I_M; it += NGW) {
        const int mat = it / I_M, q = it % I_M, kb = q / 176, nb = q % 176, n0 = nb * 32, up = mat & 1, lf = mat >> 1, l = lf >> 1, fi = lf & 1;
        quant_item((up ? F.w_up : F.w_gate) + (size_t)lf * DM * DFF, (const unsigned*)(F.ws + WS_AMAX) + (size_t)lf * 11264,
                   (unsigned char*)wptr(F, l, W_GU) + (size_t)fi * 11264 * 2048, 256 * (n0 >> 7) + (up ? 128 : 0) + (n0 & 127), kb * 64, n0, scr, F.lane);
    }
}

struct NormRow { f32x4 x[8]; u32x2 y[8]; };
__device__ __forceinline__ void norm_load(Frame& F, NormRow& R, int row, bool first, bool do_post) {
    if (first) { const float* xr = ((row >> 13) == 0 ? F.x_prompt + (size_t)row * DM : F.x_sample + (size_t)(row - SEQ) * DM);
#pragma unroll
        for (int j = 0; j < 8; ++j) R.x[j] = *(const f32x4*)(xr + 4 * F.lane + 256 * j);
    } else { const bf16* xr = F.XB + (size_t)row * DM + 4 * F.lane;
#pragma unroll
        for (int j = 0; j < 8; ++j) { const u32x2 v = *(const u32x2*)(xr + 256 * j); R.x[j] = (f32x4){bflo(v.x), bfhi(v.x), bflo(v.y), bfhi(v.y)}; } }
    if (do_post) { const bf16* yr = (const bf16*)(F.ws + WS_Y) + (size_t)row * DM + 4 * F.lane;
#pragma unroll
        for (int j = 0; j < 8; ++j) R.y[j] = *(const u32x2*)(yr + 256 * j); }
}
__device__ __forceinline__ void norm_row(Frame& F, NormRow& R, int row, bool first, bool do_post, bool do_pre, bool q8, const LAS float* cf) {
    if (do_post) {
        float ss = 0.f;
#pragma unroll
        for (int j = 0; j < 8; ++j) { const float a = bflo(R.y[j].x), bb = bfhi(R.y[j].x), c = bflo(R.y[j].y), d = bfhi(R.y[j].y); ss += (a * a + bb * bb) + (c * c + d * d); }
        const float r = 1.0f / sqrtf(wave_sum(ss, F.lane) * (1.0f / DM) + RMS_EPS);
#pragma unroll
        for (int j = 0; j < 8; ++j) { const f32x4 y = (f32x4){bflo(R.y[j].x), bfhi(R.y[j].x), bflo(R.y[j].y), bfhi(R.y[j].y)}; R.x[j] += *(const LAS f32x4*)(cf + 4 * F.lane + 256 * j) * (y * r); }
    }
    if (!do_pre) {
        float* xo = F.OUT + (size_t)row * DM + 4 * F.lane;
#pragma unroll
        for (int j = 0; j < 8; ++j) *(f32x4*)(xo + 256 * j) = R.x[j];
    } else {
        bf16* xo = F.XB + (size_t)row * DM + 4 * F.lane;
#pragma unroll
        for (int j = 0; j < 8; ++j) { u32x2 w; w.x = pk2(R.x[j][0], R.x[j][1]); w.y = pk2(R.x[j][2], R.x[j][3]); *(u32x2*)(xo + 256 * j) = w; }
    }
    if (do_pre) {
        float ss = 0.f;
#pragma unroll
        for (int j = 0; j < 8; ++j) ss += (R.x[j][0] * R.x[j][0] + R.x[j][1] * R.x[j][1]) + (R.x[j][2] * R.x[j][2] + R.x[j][3] * R.x[j][3]);
        const float r = 1.0f / sqrtf(wave_sum(ss, F.lane) * (1.0f / DM) + RMS_EPS);
        if (!q8) {
            bf16* ho = F.HB + (size_t)row * DM + 4 * F.lane;
#pragma unroll
            for (int j = 0; j < 8; ++j) { const f32x4 hv = R.x[j] * r * *(const LAS f32x4*)(cf + 2048 + 4 * F.lane + 256 * j) + *(const LAS f32x4*)(cf + 4096 + 4 * F.lane + 256 * j);
                u32x2 w; w.x = pk2(hv[0], hv[1]); w.y = pk2(hv[2], hv[3]); *(u32x2*)(ho + 256 * j) = w; }
        } else {
            float mx = 0.f;
#pragma unroll
            for (int j = 0; j < 8; ++j) { const f32x4 hv = R.x[j] * r * *(const LAS f32x4*)(cf + 2048 + 4 * F.lane + 256 * j) + *(const LAS f32x4*)(cf + 4096 + 4 * F.lane + 256 * j);
                R.x[j] = hv; mx = fmaxf(fmaxf(mx, fmaxf(fabsf(hv[0]), fabsf(hv[1]))), fmaxf(fabsf(hv[2]), fabsf(hv[3]))); }
            mx = fmaxf(wave_max(mx, F.lane), 1e-30f);
            const float inv = 127.0f / mx;
            unsigned char* ho = (unsigned char*)F.HB + (size_t)row * DM + 4 * F.lane;
#pragma unroll
            for (int j = 0; j < 8; ++j) *(unsigned*)(ho + 256 * j) = q8_pack(R.x[j][0], R.x[j][1], R.x[j][2], R.x[j][3], inv);
            if (F.lane == 0) ((float*)(F.ws + WS_SA))[row] = mx * (1.0f / 127.0f);
        }
    }
}
__device__ __forceinline__ void norm_phase(Frame& F, bool first, bool do_post, int cpost, bool do_pre, int cpre, bool q8) {
    F.lane = lane_fresh(); F.tid = F.wave * 64 + F.lane;
    const int NGW = F.G * NWAVES, per = (M + NGW - 1) / NGW;
    const int blk0 = F.bid * NWAVES * per, rbeg = blk0 + F.wave * per, rend = (rbeg + per < M) ? rbeg + per : M;
    const int b_lo = (blk0 >> 13) > 4 ? 4 : (blk0 >> 13);
    LAS float* cfl = (LAS float*)F.lds;
    {
        const float* COEF = (const float*)(F.ws + WS_COEF);
        for (int i = F.tid; i < 2 * 3 * 2048 / 4; i += NTHREADS) { const int e = 4 * i, set = e / 6144, v = (e % 6144) >> 11, col = e & 2047; const int b = (b_lo + set > 4) ? 4 : b_lo + set;
            const int ci = (v == 0) ? (cpost * 3 + 2) : (v == 1 ? cpre * 3 + 1 : cpre * 3 + 0);
            *(LAS f32x4*)(cfl + e) = *(const f32x4*)(COEF + ((size_t)ci * 5 + b) * DM + col); }
        LDS_WAIT(); __syncthreads();
    }
    if (rbeg < rend) {
        NormRow Ra, Rb;
        norm_load(F, Ra, rbeg, first, do_post);
        for (int row = rbeg; row < rend; row += 2) {
            const bool has_b = row + 1 < rend;
            if (has_b) norm_load(F, Rb, row + 1, first, do_post);
            norm_row(F, Ra, row, first, do_post, do_pre, q8, cfl + (((row >> 13) - b_lo) & 1) * 6144);
            if (has_b) {
                if (row + 2 < rend) norm_load(F, Ra, row + 2, first, do_post);
                norm_row(F, Rb, row + 1, first, do_post, do_pre, q8, cfl + ((((row + 1) >> 13) - b_lo) & 1) * 6144);
            }
        }
    }
    __syncthreads();
}
__device__ __forceinline__ void mixnorm_phase(Frame& F, int l) {
    F.lane = lane_fresh(); F.tid = F.wave * 64 + F.lane;
    const int gw = F.bid * NWAVES + F.wave, NGW = F.G * NWAVES, per = (M + NGW - 1) / NGW, rbeg = gw * per, rend = (rbeg + per < M) ? rbeg + per : M;
    const float* gf = F.branch_g + (size_t)(l * 2 + 1) * 1024 + 8 * F.lane;
    f32x4 g[2][2];
#pragma unroll
    for (int j = 0; j < 2; ++j) { g[j][0] = *(const f32x4*)(gf + 512 * j); g[j][1] = *(const f32x4*)(gf + 512 * j + 4); }
    for (int row0 = rbeg; row0 < rend; row0 += 4) {
        u32x4 v[4][2];
#pragma unroll
        for (int r = 0; r < 4; ++r) { const int row = (row0 + r < rend) ? row0 + r : rend - 1; const bf16* p = F.HB + (size_t)row * DM + 1024 + 8 * F.lane;
#pragma unroll
            for (int j = 0; j < 2; ++j) v[r][j] = *(const u32x4*)(p + 512 * j); }
#pragma unroll
        for (int r = 0; r < 4; ++r) {
            float f[2][8]; float ss = 0.f;
#pragma unroll
            for (int j = 0; j < 2; ++j) { f[j][0] = bflo(v[r][j].x); f[j][1] = bfhi(v[r][j].x); f[j][2] = bflo(v[r][j].y); f[j][3] = bfhi(v[r][j].y); f[j][4] = bflo(v[r][j].z); f[j][5] = bfhi(v[r][j].z); f[j][6] = bflo(v[r][j].w); f[j][7] = bfhi(v[r][j].w);
#pragma unroll
                for (int i = 0; i < 8; ++i) ss += f[j][i] * f[j][i]; }
            const float rr = 1.0f / sqrtf(wave_sum(ss, F.lane) * (1.0f / 1024.0f) + RMS_EPS);
            if (row0 + r < rend) { bf16* p = F.HB + (size_t)(row0 + r) * DM + 1024 + 8 * F.lane;
#pragma unroll
                for (int j = 0; j < 2; ++j) { u32x4 w; w.x = pk2(f[j][0] * rr * g[j][0][0], f[j][1] * rr * g[j][0][1]); w.y = pk2(f[j][2] * rr * g[j][0][2], f[j][3] * rr * g[j][0][3]);
                    w.z = pk2(f[j][4] * rr * g[j][1][0], f[j][5] * rr * g[j][1][1]); w.w = pk2(f[j][6] * rr * g[j][1][2], f[j][7] * rr * g[j][1][3]); *(u32x4*)(p + 512 * j) = w; } }
        }
    }
}

constexpr int ATT_IMG = 147456;
__device__ __forceinline__ void attn_phase(Frame& F, int l) {
    F.lane = lane_fresh(); F.tid = F.wave * 64 + F.lane;
    const bf16* Q = (const bf16*)(F.ws + WS_Q); const bf16* KB = (const bf16*)(F.ws + WS_KB); const bf16* VT = (const bf16*)(F.ws + WS_VT); bf16* MIX = F.HB;
    const bf16* ZERO = (const bf16*)(F.ws + WS_CTL + 512 * 1024);
    LAS float* ssq = (LAS float*)(F.lds + SSQ_OFF);
    const int h = F.wave, hk = h >> 2;
    const float sinkl = F.sink[l * 8 + h] * LOG2E;
    for (int unit = F.bid; unit < NSEQ * 256; unit += F.G) {
        const int b = unit >> 8, q0 = (unit & 255) * 32, k0 = q0 - 128;
        const size_t tok0 = (size_t)b * SEQ;
        { const int ln = lane_fresh();
#pragma unroll 2
        for (int j = F.wave; j < 144; j += 8) {
            const int p = 64 * j + ln, hkk = p >= 4608 ? 1 : 0, pr = p - hkk * 4608, row = pr >> 4, slot = pr & 15;
            const int chunk = slot ^ ((((row >> 3) & 3) << 2) | (row & 3)); const int key = k0 + row; const bool ok = key >= 0 && key < SEQ;
            const bf16* src = ok ? KB + (tok0 + key) * NKV + hkk * 128 + chunk * 8 : ZERO;
            __builtin_amdgcn_global_load_lds((const unsigned*)src, (LAS unsigned*)(F.lds + 1024 * j), 16, 0, 0);
        } }
        bf16x8 qfs[2][4];
        { const int ln = lane_fresh(), c = ln & 15, q = ln >> 4;
#pragma unroll
          for (int qt = 0; qt < 2; ++qt)
#pragma unroll
            for (int ks = 0; ks < 4; ++ks) qfs[qt][ks] = *(const bf16x8*)(Q + (tok0 + q0 + 16 * qt + c) * NQ + h * 128 + 32 * ks + 8 * q); }
        VM_WAIT(); __syncthreads();
        bf16x8 pf[2][9]; float inv[2];
#pragma unroll
        for (int qt = 0; qt < 2; ++qt) {
            const int ln = lane_fresh(), c = ln & 15, q = ln >> 4;
            const LAS unsigned char* Kl = F.lds + hk * 73728 + (8 * (c >> 2) + (c & 3)) * 256;
            int xoff[4];
#pragma unroll
            for (int ks = 0; ks < 4; ++ks) xoff[ks] = ((4 * ks + q) ^ c) << 4;
            bf16x8 qf[4];
#pragma unroll
            for (int ks = 0; ks < 4; ++ks) qf[ks] = qfs[qt][ks];
            f32x4 s[9][2];
            bf16x8 kfa[4], kfb[4];
#define ATT_LDK(dst, T) do { _Pragma("unroll") for (int ks = 0; ks < 4; ++ks) dst[ks] = *(const LAS bf16x8*)(Kl + (32 * ((T) >> 1) + 4 * ((T) & 1)) * 256 + xoff[ks]); } while (0)
#define ATT_MMK(src, T) do { f32x4 a0 = (f32x4){0.f, 0.f, 0.f, 0.f}; _Pragma("unroll") for (int ks = 0; ks < 4; ++ks) a0 = __builtin_amdgcn_mfma_f32_16x16x32_bf16(src[ks], qf[ks], a0, 0, 0, 0); s[(T) >> 1][(T) & 1] = a0; } while (0)
            ATT_LDK(kfa, 0);
#pragma unroll
            for (int T = 0; T < 18; T += 2) {
                ATT_LDK(kfb, T + 1);
                __builtin_amdgcn_sched_barrier(0);
                ATT_MMK(kfa, T);
                if (T + 2 < 18) ATT_LDK(kfa, T + 2);
                __builtin_amdgcn_sched_barrier(0);
                ATT_MMK(kfb, T + 1);
            }
#undef ATT_LDK
#undef ATT_MMK
            const int qpos = q0 + 16 * qt + c; float mx = -1e30f;
            const bool edge = (k0 < 0) || (k0 + 288 > SEQ);
#pragma unroll
            for (int G = 0; G < 9; ++G) {
                if (G == 0 || G == 8 || edge) {
#pragma unroll
                    for (int tt = 0; tt < 2; ++tt)
#pragma unroll
                        for (int r = 0; r < 4; ++r) { const int kpos = k0 + 32 * G + 8 * q + 4 * tt + r; const int d = qpos - kpos;
                            const bool ok = (d <= 128) && (d >= -128) && (kpos >= 0) && (kpos < SEQ); const float v = ok ? s[G][tt][r] : -1e30f; s[G][tt][r] = v; mx = fmaxf(mx, v); }
                } else {
#pragma unroll
                    for (int tt = 0; tt < 2; ++tt)
#pragma unroll
                        for (int r = 0; r < 4; ++r) mx = fmaxf(mx, s[G][tt][r]);
                }
            }
            mx = fmaxf(mx, shfl_xor_l(mx, 16, ln)); mx = fmaxf(mx, shfl_xor_l(mx, 32, ln)); mx = fmaxf(mx, sinkl);
            float lsum = 0.f;
#pragma unroll
            for (int G = 0; G < 9; ++G) { float p[8];
#pragma unroll
                for (int tt = 0; tt < 2; ++tt)
#pragma unroll
                    for (int r = 0; r < 4; ++r) { p[4 * tt + r] = __builtin_amdgcn_exp2f(s[G][tt][r] - mx); lsum += p[4 * tt + r]; }
                u32x4 pw; pw.x = cvt_pk_bf16(p[0], p[1]); pw.y = cvt_pk_bf16(p[2], p[3]); pw.z = cvt_pk_bf16(p[4], p[5]); pw.w = cvt_pk_bf16(p[6], p[7]);
                pf[qt][G] = __builtin_bit_cast(bf16x8, pw); }
            lsum += shfl_xor_l(lsum, 16, ln); lsum += shfl_xor_l(lsum, 32, ln); lsum += __builtin_amdgcn_exp2f(sinkl - mx);
            inv[qt] = 1.0f / lsum;
        }
        __syncthreads();
        { const int ln = lane_fresh();
#pragma unroll 2
        for (int j = F.wave; j < 144; j += 8) {
            const int p = 64 * j + ln, hkk = p >= 4608 ? 1 : 0, pr = p - hkk * 4608, d = pr / 36, c1 = pr - d * 36;
            const int ch = c1 ^ ((d >> 2) & 3); const int tok = k0 + 8 * ch; const bool ok = tok >= 0 && tok < SEQ;
            const bf16* src = ok ? VT + (size_t)(hkk * 128 + d) * M + tok0 + tok : ZERO;
            __builtin_amdgcn_global_load_lds((const unsigned*)src, (LAS unsigned*)(F.lds + 1024 * j), 16, 0, 0);
        } }
        VM_WAIT(); __syncthreads();
        f32x4 o0[8], o1[8];
#pragma unroll
        for (int dt = 0; dt < 8; ++dt) { o0[dt] = (f32x4){0.f, 0.f, 0.f, 0.f}; o1[dt] = (f32x4){0.f, 0.f, 0.f, 0.f}; }
        {
            const int ln = lane_fresh(), c = ln & 15, q = ln >> 4;
            const LAS unsigned char* Vl = F.lds + hk * 73728 + c * 576 + ((q ^ (c >> 2)) << 4);
            bf16x8 vfa[4], vfb[4];
#define ATT_LDV(dst, H) do { _Pragma("unroll") for (int dd = 0; dd < 4; ++dd) dst[dd] = *(const LAS bf16x8*)(Vl + (4 * ((H) & 1) + dd) * 9216 + ((H) >> 1) * 64); } while (0)
#define ATT_MMV(src, H) do { _Pragma("unroll") for (int dd = 0; dd < 4; ++dd) { o0[4 * ((H) & 1) + dd] = __builtin_amdgcn_mfma_f32_16x16x32_bf16(src[dd], pf[0][(H) >> 1], o0[4 * ((H) & 1) + dd], 0, 0, 0); \
        o1[4 * ((H) & 1) + dd] = __builtin_amdgcn_mfma_f32_16x16x32_bf16(src[dd], pf[1][(H) >> 1], o1[4 * ((H) & 1) + dd], 0, 0, 0); } } while (0)
            ATT_LDV(vfa, 0);
#pragma unroll
            for (int H = 0; H < 18; H += 2) {
                ATT_LDV(vfb, H + 1);
                __builtin_amdgcn_sched_barrier(0);
                ATT_MMV(vfa, H);
                if (H + 2 < 18) ATT_LDV(vfa, H + 2);
                __builtin_amdgcn_sched_barrier(0);
                ATT_MMV(vfb, H + 1);
            }
#undef ATT_LDV
#undef ATT_MMV
        }
        const int ln = lane_fresh(), c = ln & 15, q = ln >> 4;
        const float* ga = F.branch_g + (size_t)(l * 2) * 1024 + h * 128 + 4 * q;
        float ss0 = 0.f, ss1 = 0.f;
#pragma unroll
        for (int dt = 0; dt < 8; ++dt) { o0[dt] = o0[dt] * inv[0]; o1[dt] = o1[dt] * inv[1];
            ss0 += (o0[dt][0] * o0[dt][0] + o0[dt][1] * o0[dt][1]) + (o0[dt][2] * o0[dt][2] + o0[dt][3] * o0[dt][3]);
            ss1 += (o1[dt][0] * o1[dt][0] + o1[dt][1] * o1[dt][1]) + (o1[dt][2] * o1[dt][2] + o1[dt][3] * o1[dt][3]); }
        ss0 += shfl_xor_l(ss0, 16, ln); ss0 += shfl_xor_l(ss0, 32, ln); ss1 += shfl_xor_l(ss1, 16, ln); ss1 += shfl_xor_l(ss1, 32, ln);
        if (q == 0) { ssq[h * 32 + c] = ss0; ssq[h * 32 + 16 + c] = ss1; }
        f32x4 gv[8];
#pragma unroll
        for (int dt = 0; dt < 8; ++dt) gv[dt] = *(const f32x4*)(ga + 16 * dt);
        LDS_WAIT(); __syncthreads();
        float t0 = 0.f, t1 = 0.f;
#pragma unroll
        for (int w = 0; w < 8; ++w) { t0 += ssq[w * 32 + c]; t1 += ssq[w * 32 + 16 + c]; }
        const float r0 = 1.0f / sqrtf(t0 * (1.0f / 1024.0f) + RMS_EPS), r1 = 1.0f / sqrtf(t1 * (1.0f / 1024.0f) + RMS_EPS);
        bf16* op = MIX + (tok0 + q0 + c) * DM + h * 128 + 4 * q;
#pragma unroll
        for (int dt = 0; dt < 8; ++dt) { const f32x4 g = gv[dt]; const f32x4 v0 = o0[dt] * r0 * g, v1 = o1[dt] * r1 * g;
            u32x2 w0, w1; w0.x = pk2(v0[0], v0[1]); w0.y = pk2(v0[2], v0[3]); w1.x = pk2(v1[0], v1[1]); w1.y = pk2(v1[2], v1[3]);
            *(u32x2*)(op + 16 * dt) = w0; *(u32x2*)(op + (size_t)16 * DM + 16 * dt) = w1; }
        LDS_WAIT();
    }
    VM_WAIT(); __syncthreads();
}

__global__ void __launch_bounds__(NTHREADS, 2) fwd_kernel(Args args) {
    extern __shared__ __attribute__((aligned(16))) unsigned char lds_raw[];
    Frame F;
    F.lds = (LAS unsigned char*)lds_raw;
    F.tid = threadIdx.x; F.lane = F.tid & 63; F.wave = __builtin_amdgcn_readfirstlane(F.tid >> 6); F.G = gridDim.x; F.bid = blockIdx.x;
    F.x_prompt = args.in[0]; F.x_sample = args.in[1]; F.c_prompt = args.in[2]; F.c_sample = args.in[3]; F.w_mod = args.in[4]; F.b_mod = args.in[5]; F.pre_g = args.in[6]; F.post_g = args.in[7];
    F.w_gate = args.in[8]; F.w_up = args.in[9]; F.w_down = args.in[10]; F.w_in = args.in[11]; F.sink = args.in[12]; F.four_w = args.in[13]; F.branch_g = args.in[14]; F.w_out = args.in[15];
    F.OUT = args.out; F.HB = (bf16*)args.out; F.ws = args.ws; F.XB = (bf16*)(args.ws + WS_X);
    volatile LAS unsigned* MISC = (volatile LAS unsigned*)(F.lds + MISC_OFF);
    for (int u = F.tid; u < (LDS_BYTES - LDSCTL_OFF) / 4; u += NTHREADS) ((LAS unsigned*)(F.lds + LDSCTL_OFF))[u] = 0u;
    __syncthreads();
    (void)xcd_barrier_post((unsigned*)(F.ws + WS_CTL) + 4096, MISC + 8);
#define GRID_BAR() do { XcdBarrier b2_; b2_.bar = (unsigned*)(args.ws + opaque_zero()) + 4096; b2_.x = xb_xcc_id(); b2_.st = (volatile LAS unsigned*)(F.lds + MISC_OFF) + 8; xcd_barrier(b2_, F.wave == 0 && lane_fresh() == 0); } while (0)

    p0a(F);
    GRID_BAR();
    p0b_quant(F);
    norm_phase(F, true, false, 0, true, 0, true);
    GRID_BAR();

    for (int hs = 0; hs < 2 * DEPTH; ++hs) {
        const int l = hs >> 1, fi = hs & 1;
        F.ws = args.ws + opaque_zero(); { int b_ = blockIdx.x, g_ = gridDim.x; asm volatile("" : "+s"(b_), "+s"(g_)); F.bid = b_; F.G = g_; }
        {
            pg8::GeoPlain geo{(const char*)F.HB, (const char*)wptr(F, l, W_GU) + (size_t)fi * 11264 * 2048, DM / 2};
            pg8::StaticOrder S; S.init(M, 11264, F.G, F.bid);
            pg8::EpiSwiGLU8 E{(bf16*)(F.ws + WS_BIG), (const float*)(F.ws + WS_SA), (const unsigned*)(F.ws + WS_AMAX) + (size_t)(l * 2 + fi) * 11264};
            pg8::gemm_phase(F.lds, F.wave, geo, S, E);
        }
        GRID_BAR();
        {
            pg8::GeoPlain geo{(const char*)(F.ws + WS_BIG), (const char*)(wptr(F, l, W_D) + (size_t)fi * 2048 * 5632), DFF};
            pg8::StaticOrder S; S.init(M, DM, F.G, F.bid);
            pg8::EpiBf16 E{(bf16*)(F.ws + WS_Y), (size_t)DM};
            pg8::gemm_phase(F.lds, F.wave, geo, S, E);
        }
        GRID_BAR();
        if (fi == 0) {
            norm_phase(F, false, true, l * 3 + 0, true, l * 3 + 1, false);
            GRID_BAR();
            {
                pg8::GeoPlain geo{(const char*)F.HB, (const char*)wptr(F, l, W_QK), DM};
                pg8::StaticOrder S; S.init(M, 2304, F.G, F.bid);
                pg8::EpiRope E{(bf16*)(F.ws + WS_Q), (bf16*)(F.ws + WS_KB), (const float*)(F.ws + WS_ROPE), (const float*)(F.ws + WS_ROPE + 2 * MiB), (bf16*)(F.ws + WS_U)};
                pg8::gemm_phase(F.lds, F.wave, geo, S, E);
            }
            {
                pg8::GeoPlain geo{(const char*)wptr(F, l, W_V), (const char*)F.HB, DM};
                pg8::StaticOrder S; S.init(256, M, F.G, (F.bid + 96) % F.G);
                pg8::EpiBf16 E{(bf16*)(F.ws + WS_VT), (size_t)M};
                pg8::gemm_phase(F.lds, F.wave, geo, S, E);
            }
            GRID_BAR();
            attn_phase(F, l);
            {
                pg8::GeoP1 geo{(const char*)(F.ws + WS_WCS) + (size_t)l * 8 * 256 * 128 * 2, (const char*)(F.ws + WS_U)};
                pg8::StaticOrder S; S.init(2048, M, F.G, F.bid);
                pg8::EpiBf16 E{(bf16*)(F.ws + WS_Z1), (size_t)M};
                pg8::gemm_phase(F.lds, F.wave, geo, S, E);
            }
            GRID_BAR();
            {
                pg8::GeoP2 geo{(const char*)(F.ws + WS_D1), (const char*)(F.ws + WS_Z1)};
                pg8::StaticOrder S; S.init(256, 2560 * 256, F.G, F.bid);
                pg8::EpiTwiddle E{(bf16*)(F.ws + WS_Y2)};
                pg8::gemm_phase(F.lds, F.wave, geo, S, E);
            }
            GRID_BAR();
            {
                pg8::GeoPlain geo{(const char*)(F.ws + WS_D2), (const char*)(F.ws + WS_Y2), 256};
                pg8::StaticOrder S; S.init(256, 1280 * 256, F.G, F.bid);
                pg8::EpiDftOut E{F.HB};
                pg8::gemm_phase(F.lds, F.wave, geo, S, E);
            }
            GRID_BAR();
            mixnorm_phase(F, l);
            GRID_BAR();
            {
                pg8::GeoPlain geo{(const char*)F.HB, (const char*)wptr(F, l, W_O), DM};
                pg8::StaticOrder S; S.init(M, DM, F.G, F.bid);
                pg8::EpiBf16 E{(bf16*)(F.ws + WS_Y), (size_t)DM};
                pg8::gemm_phase(F.lds, F.wave, geo, S, E);
            }
            GRID_BAR();
            norm_phase(F, false, true, l * 3 + 1, true, l * 3 + 2, true);
            GRID_BAR();
        } else {
            const bool lastl = (hs == 2 * DEPTH - 1);
            norm_phase(F, false, true, l * 3 + 2, !lastl, (l + 1) * 3 + 0, true);
            if (!lastl) GRID_BAR();
        }
    }
}

extern "C" void kernel_launch(void* const* d_in, const int* in_sizes, int n_in, void* d_out, int out_size, void* d_ws, size_t ws_size, hipStream_t stream) {
    static int grid = 0;
    if (grid == 0) {
        if (n_in != 16 || out_size != M * DM || ws_size < WS_END) { fprintf(stderr, "kernel_launch: unexpected problem (n_in %d, out %d, ws %zu < %zu)\n", n_in, out_size, ws_size, (size_t)WS_END); grid = -1; return; }
        int dev = 0, cus = 0, per_cu = 0;
        if (hipGetDevice(&dev) != hipSuccess || hipDeviceGetAttribute(&cus, hipDeviceAttributeMultiprocessorCount, dev) != hipSuccess) { grid = -1; return; }
        if (hipFuncSetAttribute((const void*)fwd_kernel, hipFuncAttributeMaxDynamicSharedMemorySize, LDS_BYTES) != hipSuccess) { fprintf(stderr, "kernel_launch: hipFuncSetAttribute failed\n"); grid = -1; return; }
        if (hipOccupancyMaxActiveBlocksPerMultiprocessor(&per_cu, (const void*)fwd_kernel, NTHREADS, LDS_BYTES) != hipSuccess || per_cu < 1) { fprintf(stderr, "kernel_launch: occupancy query reports %d\n", per_cu); }
        (void)hipGetLastError();
        grid = cus;
    }
    if (grid < 0) return;
    if (hipMemsetAsync((char*)d_ws + WS_CTL, 0, CTL_ZERO_BYTES, stream) != hipSuccess) return;
    Args a{};
    for (int i = 0; i < 16; ++i) a.in[i] = (const float*)d_in[i];
    a.out = (float*)d_out; a.ws = (unsigned char*)d_ws;
    hipLaunchKernelGGL(fwd_kernel, dim3(grid), dim3(NTHREADS), LDS_BYTES, stream, a);
}
```

```cpp
#include <hip/hip_runtime.h>
#include <cstdio>
#include <cstdint>

#define LAS __attribute__((address_space(3)))
#define GAS __attribute__((address_space(1)))
typedef unsigned short bf16;
typedef short bf16x8 __attribute__((ext_vector_type(8)));
typedef float f32x4 __attribute__((ext_vector_type(4)));
typedef float f32x2 __attribute__((ext_vector_type(2)));
typedef unsigned u32x4 __attribute__((ext_vector_type(4)));
typedef int i32x4 __attribute__((ext_vector_type(4)));
typedef unsigned u32x2 __attribute__((ext_vector_type(2)));
typedef GAS unsigned gu32;

constexpr int DM = 2048, SEQ = 8192, NSEQ = 5, M = NSEQ * SEQ, DFF = 5632, DEPTH = 2;
constexpr int NQ = 1024, NKV = 256, NIN = 2560, NMOD = 18432;
constexpr float RMS_EPS = 1e-6f;
constexpr float QSCALE = 0.08838834764831845f * 1.4426950408889634f;
constexpr float LOG2E = 1.4426950408889634f;
constexpr int NWAVES = 8, NTHREADS = 512;

constexpr size_t MiB = 1u << 20;
constexpr size_t WS_CTL = 0, CTL_ZERO_BYTES = 1 * MiB;
constexpr size_t WS_AMAX = 262144;
constexpr size_t WS_COEF = 1 * MiB;
constexpr size_t WS_SA = WS_COEF + 768 * 1024;
constexpr size_t WS_ROPE = 2 * MiB;
constexpr size_t WS_D1 = 6 * MiB;
constexpr size_t WS_D2 = 6 * MiB + 65536;
constexpr size_t WS_WCS = 7 * MiB;
constexpr size_t WS_W = 9 * MiB;
constexpr size_t W_GU = 0;
constexpr size_t W_D = W_GU + (size_t)2 * 11264 * 2048 * 2;
constexpr size_t W_QK = W_D + (size_t)2 * 2048 * 5632 * 2;
constexpr size_t W_V = W_QK + (size_t)2304 * 2048 * 2;
constexpr size_t W_Z = W_V + (size_t)256 * 2048 * 2;
constexpr size_t W_O = W_Z + (size_t)1024 * 2048 * 2;
constexpr size_t W_LAYER = W_O + (size_t)2048 * 2048 * 2;
static_assert(W_LAYER == 154 * MiB, "weights per layer");
constexpr size_t WS_X = WS_W + 2 * W_LAYER;
constexpr size_t WS_Y = WS_X + 160 * MiB;
constexpr size_t WS_BIG = WS_Y + 160 * MiB;
constexpr size_t WS_Q = WS_BIG, WS_KB = WS_BIG + 80 * MiB, WS_VT = WS_BIG + 100 * MiB, WS_Z1 = WS_BIG + 120 * MiB, WS_Y2 = WS_BIG + 280 * MiB, WS_U = WS_Y2;
constexpr size_t WS_END = WS_BIG + 440 * MiB;
static_assert((size_t)M * DFF * 2 == 440 * MiB && (size_t)M * DM * 2 == 160 * MiB, "sizes");

constexpr int RING_BYTES = 131072;
constexpr int LDSCTL_OFF = 147456, MISC_OFF = LDSCTL_OFF + 320, SSQ_OFF = LDSCTL_OFF + 512;
constexpr int LDS_BYTES = 147456 + 2048;

#define LDS_WAIT() asm volatile("s_waitcnt lgkmcnt(0)" ::: "memory")
#define VM_WAIT() asm volatile("s_waitcnt vmcnt(0)" ::: "memory")
__device__ __forceinline__ unsigned f2bf(float f) { unsigned u = __builtin_bit_cast(unsigned, f); return (u + 0x7fffu + ((u >> 16) & 1u)) >> 16; }
__device__ __forceinline__ unsigned pk2(float lo, float hi) { return f2bf(lo) | (f2bf(hi) << 16); }
__device__ __forceinline__ float bflo(unsigned w) { return __builtin_bit_cast(float, w << 16); }
__device__ __forceinline__ float bfhi(unsigned w) { return __builtin_bit_cast(float, w & 0xffff0000u); }
__device__ __forceinline__ unsigned cvt_pk_bf16(float lo, float hi) { unsigned r; asm volatile("v_cvt_pk_bf16_f32 %0, %1, %2" : "=v"(r) : "v"(lo), "v"(hi)); return r; }

__device__ __forceinline__ int lane_fresh() { int l; asm volatile("v_mbcnt_lo_u32_b32 %0, -1, 0\n\tv_mbcnt_hi_u32_b32 %0, -1, %0" : "=v"(l)); return l; }
__device__ __forceinline__ size_t opaque_zero() { size_t z = 0; asm volatile("" : "+s"(z)); return z; }
namespace pg8 {
constexpr int BM = 256, BK = 64, HALF = 128, HTB = HALF * BK * 2, STAGE_BYTES = 8 * HTB, NXCD = 8, WGM = 4;
__host__ __device__ __forceinline__ int lds_byte(int r, int c) { const int st = (r >> 4) * 2 + (c >> 5), rr = r & 15, cc = c & 31, ob = rr * 64 + cc * 2; return st * 1024 + (ob ^ (((ob >> 9) & 1) << 5)); }
__host__ __device__ __forceinline__ void stage_rc(int b, int& R, int& C) { const int st = b / 1024, sb = b % 1024, swz = sb ^ (((sb >> 9) & 1) << 5); R = (st >> 1) * 16 + swz / 64; C = (st & 1) * 32 + (swz % 64) / 2; }
__host__ __device__ __forceinline__ int perm32(int rho) { const int n = rho >> 4, i = rho & 15; return 8 * (i >> 2) + 4 * n + (i & 3); }

struct Unit { int pm, pn; };
struct StaticOrder {
    int nM, nN, nwg, G, c;
    __device__ void init(int Mr, int Nc, int G_, int c_) { nM = Mr / BM; nN = Nc / BM; nwg = nM * nN; G = G_; c = c_; }
    __device__ bool next(int i, Unit& u) const {
        const long L = (long)i * G + c; if (L >= nwg) return false;
        int wgid = (int)L; { const int q = nwg / NXCD, r = nwg % NXCD, xcd = wgid % NXCD, off = wgid / NXCD; wgid = (xcd < r ? xcd * (q + 1) : r * (q + 1) + (xcd - r) * q) + off; }
        const int nig = WGM * nN, gid = wgid / nig, fm = gid * WGM, gsz = (nM - fm) < WGM ? (nM - fm) : WGM;
        u.pm = fm + ((wgid % nig) % gsz); u.pn = (wgid % nig) / gsz; return true;
    }
};

struct XcdColsOrder {
    int G, c;
    __device__ void init(int G_, int c_) { G = G_; c = c_; }
    __device__ bool next(int i, Unit& u) const {
        const long L = (long)i * G + c; if (L >= 7040) return false;
        const int xcd = (int)L & 7, off = (int)L >> 3; int p, t;
        if ((xcd & 1) == 0) { if (off < 480) { p = off / 6; t = off % 6; } else { const int o = off - 480; p = 80 + o / 5; t = o % 5; } }
        else { if (off < 400) { p = off / 5; t = off % 5; } else { const int o = off - 400; p = 80 + o / 6; t = o % 6; } }
        u.pm = p; u.pn = (t < 5) ? xcd + 8 * t : 40 + (xcd >> 1); return true;
    }
};

struct GeoPlain {
    const char* A; const char* B; int K;
    __device__ __forceinline__ int nt() const { return K / BK; }
    __device__ __forceinline__ const char* a_base(const Unit& u) const { return A + (size_t)u.pm * BM * K * 2; }
    __device__ __forceinline__ const char* b_base(const Unit& u) const { return B + (size_t)u.pn * BM * K * 2; }
    __device__ __forceinline__ unsigned a_off(int R, int C) const { return (unsigned)(R * K + C) * 2u; }
    __device__ __forceinline__ unsigned b_off(int R, int C) const { return (unsigned)(R * K + C) * 2u; }
    __device__ __forceinline__ size_t a_hstep() const { return (size_t)HALF * K * 2; }
    __device__ __forceinline__ size_t b_hstep() const { return (size_t)HALF * K * 2; }
    __device__ __forceinline__ size_t a_kstep() const { return BK * 2; }
    __device__ __forceinline__ size_t b_kstep() const { return BK * 2; }
};
struct GeoP1 {
    const char* A; const char* B;
    __device__ __forceinline__ int nt() const { return 2; }
    __device__ __forceinline__ const char* a_base(const Unit& u) const { return A + (size_t)u.pm * 256 * 128 * 2; }
    __device__ __forceinline__ const char* b_base(const Unit& u) const { return B + ((size_t)(u.pn >> 5) * SEQ + 4 * (u.pn & 31)) * 1024 * 2 + (size_t)u.pm * 128 * 2; }
    __device__ __forceinline__ unsigned a_off(int R, int C) const { return (unsigned)(R * 128 + C) * 2u; }
    __device__ __forceinline__ unsigned b_off(int R, int C) const { return (unsigned)((128 * (R & 63) + (R >> 6)) * 1024 + C) * 2u; }
    __device__ __forceinline__ size_t a_hstep() const { return (size_t)HALF * 128 * 2; }
    __device__ __forceinline__ size_t b_hstep() const { return (size_t)2 * 1024 * 2; }
    __device__ __forceinline__ size_t a_kstep() const { return BK * 2; }
    __device__ __forceinline__ size_t b_kstep() const { return BK * 2; }
};
struct GeoP2 {
    const char* A; const char* B;
    __device__ __forceinline__ int nt() const { return 2; }
    __device__ __forceinline__ const char* a_base(const Unit&) const { return A + opaque_zero(); }
    __device__ __forceinline__ const char* b_base(const Unit& u) const { const int ep = u.pn & 63, g = (u.pn >> 6) & 7, b = u.pn >> 9; return B + ((size_t)(g * 256 + 2 * ep) * M + (size_t)b * SEQ) * 2; }
    __device__ __forceinline__ unsigned a_off(int R, int C) const { return (unsigned)(R * 128 + C) * 2u; }
    __device__ __forceinline__ unsigned b_off(int R, int C) const { return (unsigned)(R * 64 + C) * 2u; }
    __device__ __forceinline__ size_t a_hstep() const { return (size_t)HALF * 128 * 2; }
    __device__ __forceinline__ size_t b_hstep() const { return (size_t)M * 2; }
    __device__ __forceinline__ size_t a_kstep() const { return BK * 2; }
    __device__ __forceinline__ size_t b_kstep() const { return (size_t)128 * M * 2; }
};

struct EpiSwiGLU8;
template <class E> struct AccT { using T = f32x4; static constexpr bool I8 = false; };
template <> struct AccT<EpiSwiGLU8> { using T = i32x4; static constexpr bool I8 = true; };
template <class Epi, class Geo, class Ord>
__device__ __forceinline__ void gemm_phase(LAS unsigned char* lds, const int wid_in, const Geo geo, const Ord& S, const Epi& E) {
    int wid = wid_in; asm volatile("" : "+s"(wid));
    const int lane = lane_fresh(), tid = wid * 64 + lane, wr = wid >> 2, wc = wid & 3, fr = lane & 15, fq = lane >> 4;
    const int nt = geo.nt();
    unsigned voffA[2], voffB[2];
#pragma unroll
    for (int i = 0; i < 2; ++i) { int R, C; stage_rc(tid * 16 + i * 8192, R, C); const int Rb = (R & ~31) + perm32(R & 31);
        voffA[i] = geo.a_off(R, C); voffB[i] = geo.b_off(Rb, C); }
    const size_t kstepA = geo.a_kstep(), kstepB = geo.b_kstep(), hstepA = geo.a_hstep(), hstepB = geo.b_hstep();
    const unsigned ldsw = (unsigned)wid * 1024u;
    const int aoff = lds_byte(wr * 64 + fr, fq * 8), boff = lds_byte(wc * 32 + fr, fq * 8);
#define PG8_SA(b, h) (((b) * 2 + (h)) * HTB)
#define PG8_SB(b, h) ((4 + (b) * 2 + (h)) * HTB)
#define PG8_STAGE(bufoff, gbase, voff) do { _Pragma("unroll") for (int _i = 0; _i < 2; ++_i) \
        __builtin_amdgcn_global_load_lds((const unsigned*)((const char*)(gbase) + (voff)[_i]), (LAS unsigned*)(lds + (bufoff) + ldsw + _i * 8192), 16, 0, 0); } while (0)
#define PG8_LDA(dst, b, h) do { _Pragma("unroll") for (int m = 0; m < 4; ++m) _Pragma("unroll") for (int k = 0; k < 2; ++k) dst[m][k] = *(const LAS bf16x8*)(lds + PG8_SA(b, h) + aoff + m * 2048 + k * 1024); } while (0)
#define PG8_LDB(dst, b, h) do { _Pragma("unroll") for (int n = 0; n < 2; ++n) _Pragma("unroll") for (int k = 0; k < 2; ++k) dst[n][k] = *(const LAS bf16x8*)(lds + PG8_SB(b, h) + boff + n * 2048 + k * 1024); } while (0)
#define PG8_MMA(ai, bj, At, Bt) do { if constexpr ((ai) == 1 && Epi::SKIP_AI1) break; __builtin_amdgcn_s_setprio(1); _Pragma("unroll") for (int m = 0; m < 4; ++m) _Pragma("unroll") for (int n = 0; n < 2; ++n) _Pragma("unroll") for (int k = 0; k < 2; ++k) \
        { if constexpr (AccT<Epi>::I8) acc[ai][bj][m][n] = __builtin_amdgcn_mfma_i32_16x16x64_i8(__builtin_bit_cast(i32x4, Bt[n][k]), __builtin_bit_cast(i32x4, At[m][k]), acc[ai][bj][m][n], 0, 0, 0); \
          else acc[ai][bj][m][n] = __builtin_amdgcn_mfma_f32_16x16x32_bf16(Bt[n][k], At[m][k], acc[ai][bj][m][n], 0, 0, 0); } __builtin_amdgcn_s_setprio(0); } while (0)
#define PG8_WAIT_V(n) asm volatile("s_waitcnt vmcnt(" #n ")" ::: "memory")
#define PG8_WAIT_L(n) asm volatile("s_waitcnt lgkmcnt(" #n ")" ::: "memory")
#define PG8_BAR __builtin_amdgcn_s_barrier()
#define PG8_SCHED __builtin_amdgcn_sched_barrier(0)
    Unit cur, nxt; int ui = 0;
    if (!S.next(0, cur)) return;
    typedef typename AccT<Epi>::T acc_t;
    acc_t acc[2][2][4][2];
#pragma unroll
    for (int a = 0; a < 2; ++a)
#pragma unroll
        for (int b = 0; b < 2; ++b)
#pragma unroll
            for (int m = 0; m < 4; ++m)
#pragma unroll
                for (int n = 0; n < 2; ++n) acc[a][b][m][n] = (acc_t){0, 0, 0, 0};
    bf16x8 At[4][2], B0[2][2], B1[2][2];
    const char* cA = geo.a_base(cur); const char* cB = geo.b_base(cur);
    PG8_STAGE(PG8_SB(0, 0), cB, voffB); PG8_STAGE(PG8_SB(0, 1), cB + hstepB, voffB); PG8_STAGE(PG8_SA(0, 0), cA, voffA); PG8_STAGE(PG8_SA(0, 1), cA + hstepA, voffA);
    if (wr == 1) PG8_BAR;
    PG8_WAIT_V(2); PG8_BAR;
    PG8_STAGE(PG8_SB(1, 0), cB + kstepB, voffB); PG8_STAGE(PG8_SA(1, 0), cA + kstepA, voffA); PG8_STAGE(PG8_SB(1, 1), cB + hstepB + kstepB, voffB);
    PG8_WAIT_V(6); PG8_BAR;
    for (;;) {
        const bool has_next = S.next(ui + 1, nxt);
        const char* nA = has_next ? geo.a_base(nxt) : cA; const char* nB = has_next ? geo.b_base(nxt) : cB;
        for (int t = 0; t < nt; t += 2) {
            const bool last = (t == nt - 2);
            const char* a1 = cA + (size_t)(t + 1) * kstepA;
            const char* a2 = last ? nA : cA + (size_t)(t + 2) * kstepA; const char* b2 = last ? nB : cB + (size_t)(t + 2) * kstepB;
            const char* a3 = a2 + kstepA; const char* b3 = b2 + kstepB;
            PG8_LDB(B0, 0, 0); PG8_LDB(B1, 0, 1); PG8_SCHED; PG8_LDA(At, 0, 0); PG8_STAGE(PG8_SA(1, 1), a1 + hstepA, voffA);
            PG8_WAIT_V(8); PG8_WAIT_L(0); PG8_BAR; PG8_MMA(0, 0, At, B0); PG8_MMA(0, 1, At, B1); PG8_BAR; PG8_SCHED;
            PG8_LDA(At, 0, 1); PG8_STAGE(PG8_SB(0, 0), b2, voffB); PG8_STAGE(PG8_SB(0, 1), b2 + hstepB, voffB); PG8_STAGE(PG8_SA(0, 0), a2, voffA);
            PG8_WAIT_V(8); PG8_WAIT_L(0); PG8_BAR; PG8_MMA(1, 0, At, B0); PG8_MMA(1, 1, At, B1); PG8_BAR; PG8_SCHED;
            PG8_LDB(B0, 1, 0); PG8_LDB(B1, 1, 1); PG8_SCHED; PG8_LDA(At, 1, 0); PG8_STAGE(PG8_SA(0, 1), a2 + hstepA, voffA);
            PG8_WAIT_V(8); PG8_WAIT_L(0); PG8_BAR; PG8_MMA(0, 0, At, B0); PG8_MMA(0, 1, At, B1); PG8_BAR; PG8_SCHED;
            PG8_LDA(At, 1, 1); PG8_STAGE(PG8_SB(1, 0), b3, voffB); PG8_STAGE(PG8_SB(1, 1), b3 + hstepB, voffB); PG8_STAGE(PG8_SA(1, 0), a3, voffA);
            PG8_WAIT_V(8); PG8_WAIT_L(0); PG8_BAR; PG8_MMA(1, 0, At, B0); PG8_MMA(1, 1, At, B1); PG8_BAR; PG8_SCHED;
        }
        if (wr == 0) PG8_BAR;
        { const int le = lane_fresh(); E(acc, cur, wr, wc, le & 15, le >> 4); }
        if (!has_next) break;
#pragma unroll
        for (int a = 0; a < 2; ++a)
#pragma unroll
            for (int b = 0; b < 2; ++b)
#pragma unroll
                for (int m = 0; m < 4; ++m)
#pragma unroll
                    for (int n = 0; n < 2; ++n) acc[a][b][m][n] = (acc_t){0, 0, 0, 0};
        cur = nxt; cA = nA; cB = nB; ++ui;
        if (wr == 1) PG8_BAR;
    }
    PG8_WAIT_V(0);
    PG8_BAR;
#undef PG8_SA
#undef PG8_SB
#undef PG8_STAGE
#undef PG8_LDA
#undef PG8_LDB
#undef PG8_MMA
#undef PG8_WAIT_V
#undef PG8_WAIT_L
#undef PG8_BAR
#undef PG8_SCHED
}

struct EpiBf16 {
    static constexpr bool SKIP_AI1 = false;
    bf16* O; size_t ldc;
    __device__ __forceinline__ void operator()(const f32x4 (&acc)[2][2][4][2], const Unit& u, int wr, int wc, int fr, int fq) const {
        const int row0 = u.pm * BM + wr * 64 + fr, col0 = u.pn * BM + wc * 32 + 8 * fq;
#pragma unroll
        for (int ai = 0; ai < 2; ++ai)
#pragma unroll
            for (int m = 0; m < 4; ++m) { bf16* rowp = O + (size_t)(row0 + ai * HALF + m * 16) * ldc + col0;
#pragma unroll
                for (int bj = 0; bj < 2; ++bj) { const f32x4 v0 = acc[ai][bj][m][0], v1 = acc[ai][bj][m][1];
                    u32x4 w; w.x = cvt_pk_bf16(v0[0], v0[1]); w.y = cvt_pk_bf16(v0[2], v0[3]); w.z = cvt_pk_bf16(v1[0], v1[1]); w.w = cvt_pk_bf16(v1[2], v1[3]);
                    *(u32x4*)(rowp + bj * HALF) = w; } }
    }
};
__device__ __forceinline__ float silu_mul(float g, float u) { return g * u * __builtin_amdgcn_rcpf(1.0f + __expf(-g)); }
struct EpiSwiGLU {
    static constexpr bool SKIP_AI1 = false;
    bf16* O;
    __device__ __forceinline__ void operator()(const f32x4 (&acc)[2][2][4][2], const Unit& u, int wr, int wc, int fr, int fq) const {
        const int row0 = u.pm * BM + wr * 64 + fr, col0 = u.pn * HALF + wc * 32 + 8 * fq;
#pragma unroll
        for (int ai = 0; ai < 2; ++ai)
#pragma unroll
            for (int m = 0; m < 4; ++m) { bf16* rowp = O + (size_t)(row0 + ai * HALF + m * 16) * DFF + col0;
                const f32x4 g0 = acc[ai][0][m][0], g1 = acc[ai][0][m][1], u0 = acc[ai][1][m][0], u1 = acc[ai][1][m][1];
                u32x4 w; w.x = cvt_pk_bf16(silu_mul(g0[0], u0[0]), silu_mul(g0[1], u0[1])); w.y = cvt_pk_bf16(silu_mul(g0[2], u0[2]), silu_mul(g0[3], u0[3]));
                w.z = cvt_pk_bf16(silu_mul(g1[0], u1[0]), silu_mul(g1[1], u1[1])); w.w = cvt_pk_bf16(silu_mul(g1[2], u1[2]), silu_mul(g1[3], u1[3]));
                *(u32x4*)rowp = w; }
    }
};
struct EpiSwiGLU8 {
    static constexpr bool SKIP_AI1 = false;
    bf16* O; const float* SA; const unsigned* AM;
    __device__ __forceinline__ void operator()(const i32x4 (&acc)[2][2][4][2], const Unit& u, int wr, int wc, int fr, int fq) const {
        const int row0 = u.pm * BM + wr * 64 + fr, col0 = u.pn * HALF + wc * 32 + 8 * fq, cw = u.pn * BM + wc * 32 + 8 * fq;
        f32x4 sg[2], su[2]; float sa[2][4];
#pragma unroll
        for (int n = 0; n < 2; ++n) { sg[n] = __builtin_bit_cast(f32x4, *(const u32x4*)(AM + cw + 4 * n)); su[n] = __builtin_bit_cast(f32x4, *(const u32x4*)(AM + cw + HALF + 4 * n)); }
#pragma unroll
        for (int ai = 0; ai < 2; ++ai)
#pragma unroll
            for (int m = 0; m < 4; ++m) sa[ai][m] = SA[row0 + ai * HALF + m * 16];
#pragma unroll
        for (int n = 0; n < 2; ++n) { sg[n] *= (1.0f / 127.0f); su[n] *= (1.0f / 127.0f); }
#pragma unroll
        for (int ai = 0; ai < 2; ++ai)
#pragma unroll
            for (int m = 0; m < 4; ++m) { bf16* rowp = O + (size_t)(row0 + ai * HALF + m * 16) * DFF + col0; const float s = sa[ai][m];
                const f32x4 g0 = __builtin_convertvector(acc[ai][0][m][0], f32x4) * (sg[0] * s), g1 = __builtin_convertvector(acc[ai][0][m][1], f32x4) * (sg[1] * s);
                const f32x4 u0 = __builtin_convertvector(acc[ai][1][m][0], f32x4) * (su[0] * s), u1 = __builtin_convertvector(acc[ai][1][m][1], f32x4) * (su[1] * s);
                u32x4 w; w.x = cvt_pk_bf16(silu_mul(g0[0], u0[0]), silu_mul(g0[1], u0[1])); w.y = cvt_pk_bf16(silu_mul(g0[2], u0[2]), silu_mul(g0[3], u0[3]));
                w.z = cvt_pk_bf16(silu_mul(g1[0], u1[0]), silu_mul(g1[1], u1[1])); w.w = cvt_pk_bf16(silu_mul(g1[2], u1[2]), silu_mul(g1[3], u1[3]));
                *(u32x4*)rowp = w; }
    }
};
struct EpiRope {
    static constexpr bool SKIP_AI1 = false;
    static constexpr bool HOOK = false;
    bf16* Q; bf16* KB; const float* COS; const float* SIN; bf16* U;
    __device__ __forceinline__ void operator()(const f32x4 (&acc)[2][2][4][2], const Unit& u, int wr, int wc, int fr, int fq) const {
        if (u.pn >= 5) {
            const int row0u = u.pm * BM + wr * 64 + fr, col0 = (u.pn - 5) * BM + wc * 32 + 8 * fq;
#pragma unroll
            for (int ai = 0; ai < 2; ++ai)
#pragma unroll
                for (int m = 0; m < 4; ++m) { bf16* rowp = U + (size_t)(row0u + ai * HALF + m * 16) * 1024 + col0;
#pragma unroll
                    for (int bj = 0; bj < 2; ++bj) { const f32x4 v0 = acc[ai][bj][m][0], v1 = acc[ai][bj][m][1];
                        u32x4 w; w.x = cvt_pk_bf16(v0[0], v0[1]); w.y = cvt_pk_bf16(v0[2], v0[3]); w.z = cvt_pk_bf16(v1[0], v1[1]); w.w = cvt_pk_bf16(v1[2], v1[3]);
                        *(u32x4*)(rowp + bj * HALF) = w; } }
            return;
        }
        const int row0 = u.pm * BM + wr * 64 + fr, hsel = wc >> 1, d0 = 32 * (wc & 1) + 8 * fq;
        const bool isq = u.pn < 4; const float sc = isq ? QSCALE : 1.0f;
        bf16* base = isq ? Q + (2 * u.pn + hsel) * 128 + d0 : KB + hsel * 128 + d0; const size_t ld = isq ? NQ : NKV;
#pragma unroll
        for (int ai = 0; ai < 2; ++ai) {
            f32x4 c0[4], c1[4], s0[4], s1[4];
#pragma unroll
            for (int m = 0; m < 4; ++m) { const int pos = (row0 + ai * HALF + m * 16) & (SEQ - 1);
                c0[m] = *(const f32x4*)(COS + pos * 64 + d0); c1[m] = *(const f32x4*)(COS + pos * 64 + d0 + 4); s0[m] = *(const f32x4*)(SIN + pos * 64 + d0); s1[m] = *(const f32x4*)(SIN + pos * 64 + d0 + 4); }
            u32x4 w1[4], w2[4];
#pragma unroll
            for (int m = 0; m < 4; ++m) {
                const f32x4 a0 = acc[ai][0][m][0], a1 = acc[ai][0][m][1], b0 = acc[ai][1][m][0], b1 = acc[ai][1][m][1];
                const f32x4 o10 = (a0 * c0[m] - b0 * s0[m]) * sc, o11 = (a1 * c1[m] - b1 * s1[m]) * sc, o20 = (a0 * s0[m] + b0 * c0[m]) * sc, o21 = (a1 * s1[m] + b1 * c1[m]) * sc;
                w1[m].x = cvt_pk_bf16(o10[0], o10[1]); w1[m].y = cvt_pk_bf16(o10[2], o10[3]); w1[m].z = cvt_pk_bf16(o11[0], o11[1]); w1[m].w = cvt_pk_bf16(o11[2], o11[3]);
                w2[m].x = cvt_pk_bf16(o20[0], o20[1]); w2[m].y = cvt_pk_bf16(o20[2], o20[3]); w2[m].z = cvt_pk_bf16(o21[0], o21[1]); w2[m].w = cvt_pk_bf16(o21[2], o21[3]); }
#pragma unroll
            for (int m = 0; m < 4; ++m) { bf16* rp = base + (size_t)(row0 + ai * HALF + m * 16) * ld; *(u32x4*)rp = w1[m]; *(u32x4*)(rp + 64) = w2[m]; }
        }
    }
};
struct EpiTwiddle {
    static constexpr bool SKIP_AI1 = false;
    bf16* Y2;
    __device__ __forceinline__ void operator()(const f32x4 (&acc)[2][2][4][2], const Unit& u, int wr, int wc, int fr, int fq) const {
        if (wr != 0) return;
        int zz = 0; asm volatile("" : "+v"(zz));
        const int ep = u.pn & 63, g = (u.pn >> 6) & 7, b = u.pn >> 9, s20 = wc * 32 + 8 * fq + zz;
#pragma unroll
        for (int m = 0; m < 4; ++m) { const int k1 = 16 * m + fr;
#pragma unroll
            for (int bj = 0; bj < 2; ++bj) { const int e = 2 * ep + bj; bf16* rp = Y2 + ((size_t)((b * 64 + k1) * 8 + g) * 128 + e) * 256 + s20;
                float re[8], im[8];
#pragma unroll
                for (int n = 0; n < 2; ++n)
#pragma unroll
                    for (int i = 0; i < 4; ++i) { const int s2 = s20 + 4 * n + i; const float fr_ = (float)((k1 * s2) & 8191) * (1.0f / 8192.0f);
                        const float ct = __builtin_amdgcn_cosf(fr_), st = __builtin_amdgcn_sinf(fr_); const float yr = acc[0][bj][m][n][i], yi = acc[1][bj][m][n][i];
                        re[4 * n + i] = yr * ct + yi * st; im[4 * n + i] = yi * ct - yr * st; }
                u32x4 w1, w2; w1.x = cvt_pk_bf16(re[0], re[1]); w1.y = cvt_pk_bf16(re[2], re[3]); w1.z = cvt_pk_bf16(re[4], re[5]); w1.w = cvt_pk_bf16(re[6], re[7]);
                w2.x = cvt_pk_bf16(im[0], im[1]); w2.y = cvt_pk_bf16(im[2], im[3]); w2.z = cvt_pk_bf16(im[4], im[5]); w2.w = cvt_pk_bf16(im[6], im[7]);
                *(u32x4*)rp = w1; *(u32x4*)(rp + 128) = w2; } }
    }
};
struct EpiDftOut {
    static constexpr bool SKIP_AI1 = true;
    bf16* MIX;
    __device__ __forceinline__ void operator()(const f32x4 (&acc)[2][2][4][2], const Unit& u, int wr, int wc, int fr, int fq) const {
        const int gp = u.pn & 3, k1 = (u.pn >> 2) & 63, b = u.pn >> 8;
#pragma unroll
        for (int m = 0; m < 4; ++m) { const int k2 = 64 * wr + 16 * m + fr; bf16* rp = MIX + (size_t)(b * SEQ + k1 + 64 * k2) * DM + 1024 + gp * 256 + wc * 32 + 8 * fq;
#pragma unroll
            for (int bj = 0; bj < 2; ++bj) { const f32x4 v0 = acc[0][bj][m][0], v1 = acc[0][bj][m][1];
                u32x4 w; w.x = cvt_pk_bf16(v0[0], v0[1]); w.y = cvt_pk_bf16(v0[2], v0[3]); w.z = cvt_pk_bf16(v1[0], v1[1]); w.w = cvt_pk_bf16(v1[2], v1[3]);
                *(u32x4*)(rp + bj * 128) = w; } }
    }
};
}

#define XB_TMO      128
#define XB_XCNT(j)  (256  + 64 * (j))
#define XB_XSUB(j)  (1280 + 64 * (j))
#define XB_XGEN(j)  (2304 + 64 * (j))
#define XB_TOP      3328
#define XB_TOPGEN   3392
#define XCD_BAR_WORDS 3456
#define XB_SPIN_CAP (1u << 18)
__device__ __forceinline__ unsigned xb_ld(unsigned* p)              { return __hip_atomic_load(p, __ATOMIC_RELAXED, __HIP_MEMORY_SCOPE_AGENT); }
__device__ __forceinline__ unsigned xb_add(unsigned* p, unsigned v) { return __hip_atomic_fetch_add(p, v, __ATOMIC_RELAXED, __HIP_MEMORY_SCOPE_AGENT); }
__device__ __forceinline__ unsigned xb_xcc_id() { return (unsigned)__builtin_amdgcn_s_getreg((3 << 11) | 20) & 0xFu; }
#define XB_SPIN(cond, bar) do { unsigned _sp = 0; while (cond) { __builtin_amdgcn_s_sleep(1); \
    if ((++_sp & 255u) == 0u) { if (xb_ld(&(bar)[XB_TMO])) break; if (_sp > XB_SPIN_CAP) { atomicAdd(&(bar)[XB_TMO], 1u); break; } } } } while (0)
struct XcdBarrier { unsigned* bar; unsigned x; volatile LAS unsigned* st; };
__device__ __forceinline__ XcdBarrier xcd_barrier_post(unsigned* bar, volatile LAS unsigned* st) {
    XcdBarrier b; b.bar = bar; b.x = xb_xcc_id(); b.st = st;
    if (threadIdx.x == 0) (void)xb_add(&bar[XB_XCNT(b.x)], 1u);
    return b;
}
__device__ __forceinline__ void xcd_barrier_complete(unsigned* bar, unsigned x, unsigned& nloc, unsigned& nx) {
    const unsigned G = gridDim.x * gridDim.y * gridDim.z;
    unsigned sum, cnt, mine, sp = 0u;
    for (;;) {
        sum = 0u; cnt = 0u; mine = 0u;
#pragma unroll
        for (unsigned j = 0; j < 16; ++j) { const unsigned c = xb_ld(&bar[XB_XCNT(j)]); sum += c; cnt += (c > 0u) ? 1u : 0u; mine = (j == x) ? c : mine; }
        if (sum == G) break;
        __builtin_amdgcn_s_sleep(1);
        if ((++sp & 255u) == 0u) { if (xb_ld(&bar[XB_TMO])) break; if (sp > XB_SPIN_CAP) { atomicAdd(&bar[XB_TMO], 1u); break; } }
    }
    nloc = mine > 0u ? mine : 1u; nx = cnt > 0u ? cnt : 1u;
}
__device__ __forceinline__ void xcd_barrier(const XcdBarrier& b, const bool leader) {
    asm volatile("s_waitcnt vmcnt(0)" ::: "memory");
    __syncthreads();
    if (leader) {
        unsigned* bar = b.bar;
        __builtin_amdgcn_s_waitcnt(0);
        unsigned nloc = b.st[0], nx = b.st[1];
        if (nloc == 0u) { xcd_barrier_complete(bar, b.x, nloc, nx); b.st[0] = nloc; b.st[1] = nx; }
        const unsigned old = xb_add(&bar[XB_XSUB(b.x)], 1u);
        const unsigned gen = old / nloc;
        if (old + 1u == (gen + 1u) * nloc) {
            __builtin_amdgcn_fence(__ATOMIC_RELEASE, "agent");
            asm volatile("s_waitcnt vmcnt(0)" ::: "memory");
            const unsigned og = xb_add(&bar[XB_TOP], 1u);
            const unsigned tg = og / nx;
            if (og + 1u == (tg + 1u) * nx) xb_add(&bar[XB_TOPGEN], 1u);
            else XB_SPIN(xb_ld(&bar[XB_TOPGEN]) == tg, bar);
            __builtin_amdgcn_fence(__ATOMIC_ACQUIRE, "agent");
            xb_add(&bar[XB_XGEN(b.x)], 1u);
            asm volatile("s_waitcnt vmcnt(0)" ::: "memory");
        } else {
            XB_SPIN(xb_ld(&bar[XB_XGEN(b.x)]) == gen, bar);
            __builtin_amdgcn_fence(__ATOMIC_ACQUIRE, "agent");
            asm volatile("s_waitcnt vmcnt(0)" ::: "memory");
        }
    }
    __syncthreads();
}

struct Args { const float* in[16]; float* out; unsigned char* ws; };
struct Frame {
    LAS unsigned char* lds; int tid, lane, wave, G, bid;
    const float *x_prompt, *x_sample, *c_prompt, *c_sample, *w_mod, *b_mod, *pre_g, *post_g, *w_gate, *w_up, *w_down, *w_in, *sink, *four_w, *branch_g, *w_out;
    bf16* XB; bf16* HB; float* OUT; unsigned char* ws;
};
__device__ __forceinline__ float shfl_xor_l(float v, int mask, int lane) { return __builtin_bit_cast(float, __builtin_amdgcn_ds_bpermute((lane ^ mask) << 2, __builtin_bit_cast(int, v))); }
__device__ __forceinline__ float wave_sum(float v, int lane) {
#pragma unroll
    for (int o = 1; o < 64; o <<= 1) v += shfl_xor_l(v, o, lane);
    return v;
}

__device__ __forceinline__ float wave_max(float v, int lane) {
#pragma unroll
    for (int o = 1; o < 64; o <<= 1) v = fmaxf(v, shfl_xor_l(v, o, lane));
    return v;
}
__device__ __forceinline__ unsigned q8_pack(float a, float b, float c, float d, float inv) {
    const unsigned ua = __float_as_uint(fmaf(a, inv, 12582912.0f)), ub = __float_as_uint(fmaf(b, inv, 12582912.0f)), uc = __float_as_uint(fmaf(c, inv, 12582912.0f)), ud = __float_as_uint(fmaf(d, inv, 12582912.0f));
    return __builtin_amdgcn_perm(__builtin_amdgcn_perm(ud, uc, 0x0c0c0400u), __builtin_amdgcn_perm(ub, ua, 0x0c0c0400u), 0x05040100u);
}

__device__ __forceinline__ void transpose_item(const float* W, size_t ldw, int K, bf16* WT, int dest_row0, int k0, int n0, LAS float* scr, int lane) {
#pragma unroll 8
    for (int i = 0; i < 32; ++i) { const int kk = 2 * i + (lane >> 5); scr[kk * 33 + (lane & 31)] = W[(size_t)(k0 + kk) * ldw + n0 + (lane & 31)]; }
    LDS_WAIT(); asm volatile("" ::: "memory");
    const int c = lane & 7;
#pragma unroll
    for (int j = 0; j < 4; ++j) { const int n = (lane >> 3) + 8 * j; const LAS float* s = scr + (8 * c) * 33 + n;
        u32x4 o; o.x = pk2(s[0 * 33], s[1 * 33]); o.y = pk2(s[2 * 33], s[3 * 33]); o.z = pk2(s[4 * 33], s[5 * 33]); o.w = pk2(s[6 * 33], s[7 * 33]);
        *(GAS u32x4*)(WT + (size_t)(dest_row0 + n) * K + k0 + 8 * c) = o; }
    LDS_WAIT(); asm volatile("" ::: "memory");
}
__device__ __forceinline__ void quant_item(const float* W, const unsigned* AM, unsigned char* W8T, int dest_row0, int k0, int n0, LAS float* scr, int lane) {
#pragma unroll 8
    for (int i = 0; i < 32; ++i) { const int kk = 2 * i + (lane >> 5); scr[kk * 33 + (lane & 31)] = W[(size_t)(k0 + kk) * DFF + n0 + (lane & 31)]; }
    const int n = lane >> 1, hf = lane & 1;
    const float am = __uint_as_float(AM[dest_row0 + n]), inv = am > 0.f ? 127.0f / am : 0.f;
    LDS_WAIT(); asm volatile("" ::: "memory");
    const LAS float* t = scr + (32 * hf) * 33 + n;
    u32x4 o0, o1;
    o0.x = q8_pack(t[0 * 33], t[1 * 33], t[2 * 33], t[3 * 33], inv);     o0.y = q8_pack(t[4 * 33], t[5 * 33], t[6 * 33], t[7 * 33], inv);
    o0.z = q8_pack(t[8 * 33], t[9 * 33], t[10 * 33], t[11 * 33], inv);   o0.w = q8_pack(t[12 * 33], t[13 * 33], t[14 * 33], t[15 * 33], inv);
    o1.x = q8_pack(t[16 * 33], t[17 * 33], t[18 * 33], t[19 * 33], inv); o1.y = q8_pack(t[20 * 33], t[21 * 33], t[22 * 33], t[23 * 33], inv);
    o1.z = q8_pack(t[24 * 33], t[25 * 33], t[26 * 33], t[27 * 33], inv); o1.w = q8_pack(t[28 * 33], t[29 * 33], t[30 * 33], t[31 * 33], inv);
    GAS unsigned char* dst = (GAS unsigned char*)(W8T + (size_t)(dest_row0 + n) * DM + k0 + 32 * hf);
    *(GAS u32x4*)dst = o0; *(GAS u32x4*)(dst + 16) = o1;
    LDS_WAIT(); asm volatile("" ::: "memory");
}
__device__ __forceinline__ bf16* wptr(Frame& F, int l, size_t off) { return (bf16*)(F.ws + WS_W + (size_t)l * W_LAYER + off); }

__device__ __forceinline__ void p0a(Frame& F) {
    {
        LAS float* sc = (LAS float*)F.lds;
        LAS float* red = (LAS float*)(F.lds + 40960);
        bool have_c = false;
        for (int it = F.bid; it < 144; it += F.G) {
            if (!have_c) {
                for (int i = F.tid; i < 5 * 2048; i += NTHREADS) { const int b = i >> 11, k = i & 2047; const float c = (b == 0) ? F.c_prompt[k] : F.c_sample[(b - 1) * 2048 + k]; sc[i] = c / (1.0f + __expf(-c)); }
                __syncthreads(); have_c = true;
            }
            const int l = it / 72, chunk = it % 72, col = chunk * 256 + 4 * F.lane;
            const float* wp = F.w_mod + (size_t)l * DM * NMOD + col;
            f32x4 a[5];
#pragma unroll
            for (int b = 0; b < 5; ++b) a[b] = (f32x4){0.f, 0.f, 0.f, 0.f};
            const int kbeg = F.wave * 256;
#pragma unroll 8
            for (int k = kbeg; k < kbeg + 256; ++k) { const f32x4 w = *(const f32x4*)(wp + (size_t)k * NMOD);
#pragma unroll
                for (int b = 0; b < 5; ++b) a[b] += w * sc[b * 2048 + k]; }
#pragma unroll
            for (int b = 0; b < 5; ++b) *(LAS f32x4*)(red + (F.wave * 5 + b) * 256 + 4 * F.lane) = a[b];
            __syncthreads();
            for (int o = F.tid; o < 5 * 256; o += NTHREADS) { const int b = o >> 8, cc = o & 255; float v = 0.f;
#pragma unroll
                for (int w = 0; w < 8; ++w) v += red[(w * 5 + b) * 256 + cc];
                const int jg = chunk * 256 + cc; v += F.b_mod[l * NMOD + jg];
                const int jj = jg / 6144, t = (jg % 6144) / 2048, cl = jg & 2047;
                float r;
                if (t == 0) r = v; else if (t == 1) r = F.pre_g[(l * 3 + jj) * DM + cl] * (1.0f + v); else r = ((jj == 1) ? 1.0f : 0.5f) * (1.0f + v) * F.post_g[(l * 3 + jj) * DM + cl];
                ((float*)(F.ws + WS_COEF))[((size_t)((l * 3 + jj) * 3 + t) * 5 + b) * DM + cl] = r; }
            __syncthreads();
        }
        __syncthreads();
    }
    {
        LAS float* red = (LAS float*)F.lds;
        unsigned* AM = (unsigned*)(F.ws + WS_AMAX);
        for (int it = (F.bid + F.G - 144 % F.G) % F.G; it < 704; it += F.G) {
            const int mat = it / 88, q = it % 88, chunk = q >> 2, kq = q & 3, up = mat & 1, lf = mat >> 1;
            const float* wp = (up ? F.w_up : F.w_gate) + (size_t)lf * DM * DFF + (size_t)(kq * 512 + F.wave * 64) * DFF + chunk * 256 + 4 * F.lane;
            f32x4 mx = (f32x4){0.f, 0.f, 0.f, 0.f};
#pragma unroll 8
            for (int k = 0; k < 64; ++k) { const f32x4 w = *(const f32x4*)(wp + (size_t)k * DFF);
                mx[0] = fmaxf(mx[0], fabsf(w[0])); mx[1] = fmaxf(mx[1], fabsf(w[1])); mx[2] = fmaxf(mx[2], fabsf(w[2])); mx[3] = fmaxf(mx[3], fabsf(w[3])); }
            *(LAS f32x4*)(red + F.wave * 256 + 4 * F.lane) = mx;
            __syncthreads();
            if (F.tid < 256) { float v = red[F.tid];
#pragma unroll
                for (int w = 1; w < 8; ++w) v = fmaxf(v, red[w * 256 + F.tid]);
                const int n = chunk * 256 + F.tid;
                atomicMax(AM + (size_t)lf * 11264 + 256 * (n >> 7) + (up ? 128 : 0) + (n & 127), __float_as_uint(v)); }
            __syncthreads();
        }
    }
    const int gt = F.bid * NTHREADS + F.tid, NGT = F.G * NTHREADS;
    for (int i = gt; i < SEQ * 64; i += NGT) { const int pos = i >> 6, k = i & 63; const float inv = (float)pow(10000.0, -(double)(2 * k) / 128.0); const float ang = (float)pos * inv;
        double sd, cd; sincos((double)ang, &sd, &cd); ((float*)(F.ws + WS_ROPE))[i] = (float)cd; ((float*)(F.ws + WS_ROPE + 2 * MiB))[i] = (float)sd; }
    for (int i = gt; i < 256 * 128; i += NGT) { const int R = i >> 7, c = i & 127, pp = R >> 7, kk = R & 127, part = c >> 6, s1 = c & 63; float v = 0.f;
        if (kk < 64) { const float fr = (float)((kk * s1) & 63) * (2.0f / 64.0f); const float cv = cospif(fr), sv = sinpif(fr); v = (pp == part) ? cv : (pp == 0 ? sv : -sv); v *= 0.125f; }
        ((bf16*)(F.ws + WS_D1))[i] = (bf16)f2bf(v); }
    for (int i = gt; i < 256 * 256; i += NGT) { const int R = i >> 8, c = i & 255, pp = c >> 7, s2 = c & 127; float v = 0.f;
        if (R < 128) { const float fr = (float)((R * s2) & 127) * (2.0f / 128.0f); v = (pp == 0 ? cospif(fr) : sinpif(fr)) * 0.08838834764831845f; }
        ((bf16*)(F.ws + WS_D2))[i] = (bf16)f2bf(v); }
    {
        LAS float* tab = (LAS float*)F.lds;
        if (F.tid < 128) { const float fr = (float)F.tid * (2.0f / 128.0f); tab[F.tid] = cospif(fr); tab[128 + F.tid] = sinpif(fr); }
        __syncthreads();
        for (int i = gt; i < 2 * 8 * 128 * 256; i += NGT) { const int e2 = i & 255, c = (i >> 8) & 127, lg = i >> 15; const int e = e2 & 127; const bool im = e2 >= 128;
            const float* wl = F.four_w + (size_t)lg * 128 * 128 + e; float s = 0.f;
#pragma unroll 8
            for (int m = 0; m < 128; ++m) s += tab[(im ? 128 : 0) + ((m * c) & 127)] * wl[m * 128];
            ((bf16*)(F.ws + WS_WCS))[((size_t)lg * 256 + e2) * 128 + c] = (bf16)f2bf((im ? -s : s) * 0.08838834764831845f); }
        __syncthreads();
    }
    {
        LAS float* scr = (LAS float*)(F.lds + F.wave * 16384);
        const int gw = F.bid * NWAVES + F.wave, NGW = F.G * NWAVES;
        constexpr int I_D = 2 * 88 * 64, I_QK = 32 * 72, I_V = 32 * 8, I_O = 32 * 64;
        constexpr int I_L = I_D + I_QK + I_V + I_O;
        for (int it = gw; it < 2 * I_L; it += NGW) {
            const int l = it / I_L; int r = it % I_L;
            if (r < I_D) { const int fi = r / (88 * 64), q = r % (88 * 64), kb = q / 64, nb = q % 64;
                transpose_item(F.w_down + (size_t)(l * 2 + fi) * DFF * DM, DM, DFF, wptr(F, l, W_D) + (size_t)fi * 2048 * 5632, nb * 32, kb * 64, nb * 32, scr, F.lane); continue; }
            r -= I_D;
            if (r < I_QK) { const int kb = r / 72, nb = r % 72; int n0 = nb * 32; int dest;
                if (nb >= 40) { dest = n0; n0 += 256; }
                else if (n0 < 1024) { const int head = n0 >> 7, half = (n0 >> 6) & 1, x = n0 & 63; dest = 256 * (head >> 1) + 128 * half + 64 * (head & 1) + x; }
                else { const int q = n0 - 1024, hs = q >> 7, half = (q >> 6) & 1, x = q & 63; dest = 1024 + 128 * half + 64 * hs + x; }
                transpose_item(F.w_in + (size_t)l * DM * NIN, NIN, DM, wptr(F, l, W_QK), dest, kb * 64, n0, scr, F.lane); continue; }
            r -= I_QK;
            if (r < I_V) { const int kb = r / 8, nb = r % 8;
                transpose_item(F.w_in + (size_t)l * DM * NIN, NIN, DM, wptr(F, l, W_V), nb * 32, kb * 64, 1280 + nb * 32, scr, F.lane); continue; }
            r -= I_V;
            { const int kb = r / 64, nb = r % 64;
                transpose_item(F.w_out + (size_t)l * DM * DM, DM, DM, wptr(F, l, W_O), nb * 32, kb * 64, nb * 32, scr, F.lane); }
        }
    }
}

__device__ __forceinline__ void p0b_quant(Frame& F) {
    LAS float* scr = (LAS float*)(F.lds + 65536 + F.wave * 8704);
    const int gw = F.bid * NWAVES + F.wave, NGW = F.G * NWAVES;
    constexpr int I_M = 32 * 176;
    for (int it = gw; it < 8 * I_M; it += NGW) {
        const int mat = it / I_M, q = it % I_M, kb = q / 176, nb = q % 176, n0 = nb * 32, up = mat & 1, lf = mat >> 1, l = lf >> 1, fi = lf & 1;
        quant_item((up ? F.w_up : F.w_gate) + (size_t)lf * DM * DFF, (const unsigned*)(F.ws + WS_AMAX) + (size_t)lf * 11264,
                   (unsigned char*)wptr(F, l, W_GU) + (size_t)fi * 11264 * 2048, 256 * (n0 >> 7) + (up ? 128 : 0) + (n0 & 127), kb * 64, n0, scr, F.lane);
    }
}

struct NormRow { f32x4 x[8]; u32x2 y[8]; };
__device__ __forceinline__ void norm_load(Frame& F, NormRow& R, int row, bool first, bool do_post) {
    if (first) { const float* xr = ((row >> 13) == 0 ? F.x_prompt + (size_t)row * DM : F.x_sample + (size_t)(row - SEQ) * DM);
#pragma unroll
        for (int j = 0; j < 8; ++j) R.x[j] = *(const f32x4*)(xr + 4 * F.lane + 256 * j);
    } else { const bf16* xr = F.XB + (size_t)row * DM + 4 * F.lane;
#pragma unroll
        for (int j = 0; j < 8; ++j) { const u32x2 v = *(const u32x2*)(xr + 256 * j); R.x[j] = (f32x4){bflo(v.x), bfhi(v.x), bflo(v.y), bfhi(v.y)}; } }
    if (do_post) { const bf16* yr = (const bf16*)(F.ws + WS_Y) + (size_t)row * DM + 4 * F.lane;
#pragma unroll
        for (int j = 0; j < 8; ++j) R.y[j] = *(const u32x2*)(yr + 256 * j); }
}
__device__ __forceinline__ void norm_row(Frame& F, NormRow& R, int row, bool first, bool do_post, bool do_pre, bool q8, const LAS float* cf) {
    if (do_post) {
        float ss = 0.f;
#pragma unroll
        for (int j = 0; j < 8; ++j) { const float a = bflo(R.y[j].x), bb = bfhi(R.y[j].x), c = bflo(R.y[j].y), d = bfhi(R.y[j].y); ss += (a * a + bb * bb) + (c * c + d * d); }
        const float r = 1.0f / sqrtf(wave_sum(ss, F.lane) * (1.0f / DM) + RMS_EPS);
#pragma unroll
        for (int j = 0; j < 8; ++j) { const f32x4 y = (f32x4){bflo(R.y[j].x), bfhi(R.y[j].x), bflo(R.y[j].y), bfhi(R.y[j].y)}; R.x[j] += *(const LAS f32x4*)(cf + 4 * F.lane + 256 * j) * (y * r); }
    }
    if (!do_pre) {
        float* xo = F.OUT + (size_t)row * DM + 4 * F.lane;
#pragma unroll
        for (int j = 0; j < 8; ++j) *(f32x4*)(xo + 256 * j) = R.x[j];
    } else {
        bf16* xo = F.XB + (size_t)row * DM + 4 * F.lane;
#pragma unroll
        for (int j = 0; j < 8; ++j) { u32x2 w; w.x = pk2(R.x[j][0], R.x[j][1]); w.y = pk2(R.x[j][2], R.x[j][3]); *(u32x2*)(xo + 256 * j) = w; }
    }
    if (do_pre) {
        float ss = 0.f;
#pragma unroll
        for (int j = 0; j < 8; ++j) ss += (R.x[j][0] * R.x[j][0] + R.x[j][1] * R.x[j][1]) + (R.x[j][2] * R.x[j][2] + R.x[j][3] * R.x[j][3]);
        const float r = 1.0f / sqrtf(wave_sum(ss, F.lane) * (1.0f / DM) + RMS_EPS);
        if (!q8) {
            bf16* ho = F.HB + (size_t)row * DM + 4 * F.lane;
#pragma unroll
            for (int j = 0; j < 8; ++j) { const f32x4 hv = R.x[j] * r * *(const LAS f32x4*)(cf + 2048 + 4 * F.lane + 256 * j) + *(const LAS f32x4*)(cf + 4096 + 4 * F.lane + 256 * j);
                u32x2 w; w.x = pk2(hv[0], hv[1]); w.y = pk2(hv[2], hv[3]); *(u32x2*)(ho + 256 * j) = w; }
        } else {
            float mx = 0.f;
#pragma unroll
            for (int j = 0; j < 8; ++j) { const f32x4 hv = R.x[j] * r * *(const LAS f32x4*)(cf + 2048 + 4 * F.lane + 256 * j) + *(const LAS f32x4*)(cf + 4096 + 4 * F.lane + 256 * j);
                R.x[j] = hv; mx = fmaxf(fmaxf(mx, fmaxf(fabsf(hv[0]), fabsf(hv[1]))), fmaxf(fabsf(hv[2]), fabsf(hv[3]))); }
            mx = fmaxf(wave_max(mx, F.lane), 1e-30f);
            const float inv = 127.0f / mx;
            unsigned char* ho = (unsigned char*)F.HB + (size_t)row * DM + 4 * F.lane;
#pragma unroll
            for (int j = 0; j < 8; ++j) *(unsigned*)(ho + 256 * j) = q8_pack(R.x[j][0], R.x[j][1], R.x[j][2], R.x[j][3], inv);
            if (F.lane == 0) ((float*)(F.ws + WS_SA))[row] = mx * (1.0f / 127.0f);
        }
    }
}
__device__ __forceinline__ void norm_phase(Frame& F, bool first, bool do_post, int cpost, bool do_pre, int cpre, bool q8) {
    F.lane = lane_fresh(); F.tid = F.wave * 64 + F.lane;
    const int NGW = F.G * NWAVES, per = (M + NGW - 1) / NGW;
    const int blk0 = F.bid * NWAVES * per, rbeg = blk0 + F.wave * per, rend = (rbeg + per < M) ? rbeg + per : M;
    const int b_lo = (blk0 >> 13) > 4 ? 4 : (blk0 >> 13);
    LAS float* cfl = (LAS float*)F.lds;
    {
        const float* COEF = (const float*)(F.ws + WS_COEF);
        for (int i = F.tid; i < 2 * 3 * 2048 / 4; i += NTHREADS) { const int e = 4 * i, set = e / 6144, v = (e % 6144) >> 11, col = e & 2047; const int b = (b_lo + set > 4) ? 4 : b_lo + set;
            const int ci = (v == 0) ? (cpost * 3 + 2) : (v == 1 ? cpre * 3 + 1 : cpre * 3 + 0);
            *(LAS f32x4*)(cfl + e) = *(const f32x4*)(COEF + ((size_t)ci * 5 + b) * DM + col); }
        LDS_WAIT(); __syncthreads();
    }
    if (rbeg < rend) {
        NormRow Ra, Rb;
        norm_load(F, Ra, rbeg, first, do_post);
        for (int row = rbeg; row < rend; row += 2) {
            const bool has_b = row + 1 < rend;
            if (has_b) norm_load(F, Rb, row + 1, first, do_post);
            norm_row(F, Ra, row, first, do_post, do_pre, q8, cfl + (((row >> 13) - b_lo) & 1) * 6144);
            if (has_b) {
                if (row + 2 < rend) norm_load(F, Ra, row + 2, first, do_post);
                norm_row(F, Rb, row + 1, first, do_post, do_pre, q8, cfl + ((((row + 1) >> 13) - b_lo) & 1) * 6144);
            }
        }
    }
    __syncthreads();
}
__device__ __forceinline__ void mixnorm_phase(Frame& F, int l) {
    F.lane = lane_fresh(); F.tid = F.wave * 64 + F.lane;
    const int gw = F.bid * NWAVES + F.wave, NGW = F.G * NWAVES, per = (M + NGW - 1) / NGW, rbeg = gw * per, rend = (rbeg + per < M) ? rbeg + per : M;
    const float* gf = F.branch_g + (size_t)(l * 2 + 1) * 1024 + 8 * F.lane;
    f32x4 g[2][2];
#pragma unroll
    for (int j = 0; j < 2; ++j) { g[j][0] = *(const f32x4*)(gf + 512 * j); g[j][1] = *(const f32x4*)(gf + 512 * j + 4); }
    for (int row0 = rbeg; row0 < rend; row0 += 4) {
        u32x4 v[4][2];
#pragma unroll
        for (int r = 0; r < 4; ++r) { const int row = (row0 + r < rend) ? row0 + r : rend - 1; const bf16* p = F.HB + (size_t)row * DM + 1024 + 8 * F.lane;
#pragma unroll
            for (int j = 0; j < 2; ++j) v[r][j] = *(const u32x4*)(p + 512 * j); }
#pragma unroll
        for (int r = 0; r < 4; ++r) {
            float f[2][8]; float ss = 0.f;
#pragma unroll
            for (int j = 0; j < 2; ++j) { f[j][0] = bflo(v[r][j].x); f[j][1] = bfhi(v[r][j].x); f[j][2] = bflo(v[r][j].y); f[j][3] = bfhi(v[r][j].y); f[j][4] = bflo(v[r][j].z); f[j][5] = bfhi(v[r][j].z); f[j][6] = bflo(v[r][j].w); f[j][7] = bfhi(v[r][j].w);
#pragma unroll
                for (int i = 0; i < 8; ++i) ss += f[j][i] * f[j][i]; }
            const float rr = 1.0f / sqrtf(wave_sum(ss, F.lane) * (1.0f / 1024.0f) + RMS_EPS);
            if (row0 + r < rend) { bf16* p = F.HB + (size_t)(row0 + r) * DM + 1024 + 8 * F.lane;
#pragma unroll
                for (int j = 0; j < 2; ++j) { u32x4 w; w.x = pk2(f[j][0] * rr * g[j][0][0], f[j][1] * rr * g[j][0][1]); w.y = pk2(f[j][2] * rr * g[j][0][2], f[j][3] * rr * g[j][0][3]);
                    w.z = pk2(f[j][4] * rr * g[j][1][0], f[j][5] * rr * g[j][1][1]); w.w = pk2(f[j][6] * rr * g[j][1][2], f[j][7] * rr * g[j][1][3]); *(u32x4*)(p + 512 * j) = w; } }
        }
    }
}

constexpr int ATT_IMG = 147456;
__device__ __forceinline__ void attn_phase(Frame& F, int l) {
    F.lane = lane_fresh(); F.tid = F.wave * 64 + F.lane;
    const bf16* Q = (const bf16*)(F.ws + WS_Q); const bf16* KB = (const bf16*)(F.ws + WS_KB); const bf16* VT = (const bf16*)(F.ws + WS_VT); bf16* MIX = F.HB;
    const bf16* ZERO = (const bf16*)(F.ws + WS_CTL + 512 * 1024);
    LAS float* ssq = (LAS float*)(F.lds + SSQ_OFF);
    const int h = F.wave, hk = h >> 2;
    const float sinkl = F.sink[l * 8 + h] * LOG2E;
    for (int unit = F.bid; unit < NSEQ * 256; unit += F.G) {
        const int b = unit >> 8, q0 = (unit & 255) * 32, k0 = q0 - 128;
        const size_t tok0 = (size_t)b * SEQ;
        { const int ln = lane_fresh();
#pragma unroll 2
        for (int j = F.wave; j < 144; j += 8) {
            const int p = 64 * j + ln, hkk = p >= 4608 ? 1 : 0, pr = p - hkk * 4608, row = pr >> 4, slot = pr & 15;
            const int chunk = slot ^ ((((row >> 3) & 3) << 2) | (row & 3)); const int key = k0 + row; const bool ok = key >= 0 && key < SEQ;
            const bf16* src = ok ? KB + (tok0 + key) * NKV + hkk * 128 + chunk * 8 : ZERO;
            __builtin_amdgcn_global_load_lds((const unsigned*)src, (LAS unsigned*)(F.lds + 1024 * j), 16, 0, 0);
        } }
        bf16x8 qfs[2][4];
        { const int ln = lane_fresh(), c = ln & 15, q = ln >> 4;
#pragma unroll
          for (int qt = 0; qt < 2; ++qt)
#pragma unroll
            for (int ks = 0; ks < 4; ++ks) qfs[qt][ks] = *(const bf16x8*)(Q + (tok0 + q0 + 16 * qt + c) * NQ + h * 128 + 32 * ks + 8 * q); }
        VM_WAIT(); __syncthreads();
        bf16x8 pf[2][9]; float inv[2];
#pragma unroll
        for (int qt = 0; qt < 2; ++qt) {
            const int ln = lane_fresh(), c = ln & 15, q = ln >> 4;
            const LAS unsigned char* Kl = F.lds + hk * 73728 + (8 * (c >> 2) + (c & 3)) * 256;
            int xoff[4];
#pragma unroll
            for (int ks = 0; ks < 4; ++ks) xoff[ks] = ((4 * ks + q) ^ c) << 4;
            bf16x8 qf[4];
#pragma unroll
            for (int ks = 0; ks < 4; ++ks) qf[ks] = qfs[qt][ks];
            f32x4 s[9][2];
            bf16x8 kfa[4], kfb[4];
#define ATT_LDK(dst, T) do { _Pragma("unroll") for (int ks = 0; ks < 4; ++ks) dst[ks] = *(const LAS bf16x8*)(Kl + (32 * ((T) >> 1) + 4 * ((T) & 1)) * 256 + xoff[ks]); } while (0)
#define ATT_MMK(src, T) do { f32x4 a0 = (f32x4){0.f, 0.f, 0.f, 0.f}; _Pragma("unroll") for (int ks = 0; ks < 4; ++ks) a0 = __builtin_amdgcn_mfma_f32_16x16x32_bf16(src[ks], qf[ks], a0, 0, 0, 0); s[(T) >> 1][(T) & 1] = a0; } while (0)
            ATT_LDK(kfa, 0);
#pragma unroll
            for (int T = 0; T < 18; T += 2) {
                ATT_LDK(kfb, T + 1);
                __builtin_amdgcn_sched_barrier(0);
                ATT_MMK(kfa, T);
                if (T + 2 < 18) ATT_LDK(kfa, T + 2);
                __builtin_amdgcn_sched_barrier(0);
                ATT_MMK(kfb, T + 1);
            }
#undef ATT_LDK
#undef ATT_MMK
            const int qpos = q0 + 16 * qt + c; float mx = -1e30f;
            const bool edge = (k0 < 0) || (k0 + 288 > SEQ);
#pragma unroll
            for (int G = 0; G < 9; ++G) {
                if (G == 0 || G == 8 || edge) {
#pragma unroll
                    for (int tt = 0; tt < 2; ++tt)
#pragma unroll
                        for (int r = 0; r < 4; ++r) { const int kpos = k0 + 32 * G + 8 * q + 4 * tt + r; const int d = qpos - kpos;
                            const bool ok = (d <= 128) && (d >= -128) && (kpos >= 0) && (kpos < SEQ); const float v = ok ? s[G][tt][r] : -1e30f; s[G][tt][r] = v; mx = fmaxf(mx, v); }
                } else {
#pragma unroll
                    for (int tt = 0; tt < 2; ++tt)
#pragma unroll
                        for (int r = 0; r < 4; ++r) mx = fmaxf(mx, s[G][tt][r]);
                }
            }
            mx = fmaxf(mx, shfl_xor_l(mx, 16, ln)); mx = fmaxf(mx, shfl_xor_l(mx, 32, ln)); mx = fmaxf(mx, sinkl);
            float lsum = 0.f;
#pragma unroll
            for (int G = 0; G < 9; ++G) { float p[8];
#pragma unroll
                for (int tt = 0; tt < 2; ++tt)
#pragma unroll
                    for (int r = 0; r < 4; ++r) { p[4 * tt + r] = __builtin_amdgcn_exp2f(s[G][tt][r] - mx); lsum += p[4 * tt + r]; }
                u32x4 pw; pw.x = cvt_pk_bf16(p[0], p[1]); pw.y = cvt_pk_bf16(p[2], p[3]); pw.z = cvt_pk_bf16(p[4], p[5]); pw.w = cvt_pk_bf16(p[6], p[7]);
                pf[qt][G] = __builtin_bit_cast(bf16x8, pw); }
            lsum += shfl_xor_l(lsum, 16, ln); lsum += shfl_xor_l(lsum, 32, ln); lsum += __builtin_amdgcn_exp2f(sinkl - mx);
            inv[qt] = 1.0f / lsum;
        }
        __syncthreads();
        { const int ln = lane_fresh();
#pragma unroll 2
        for (int j = F.wave; j < 144; j += 8) {
            const int p = 64 * j + ln, hkk = p >= 4608 ? 1 : 0, pr = p - hkk * 4608, d = pr / 36, c1 = pr - d * 36;
            const int ch = c1 ^ ((d >> 2) & 3); const int tok = k0 + 8 * ch; const bool ok = tok >= 0 && tok < SEQ;
            const bf16* src = ok ? VT + (size_t)(hkk * 128 + d) * M + tok0 + tok : ZERO;
            __builtin_amdgcn_global_load_lds((const unsigned*)src, (LAS unsigned*)(F.lds + 1024 * j), 16, 0, 0);
        } }
        VM_WAIT(); __syncthreads();
        f32x4 o0[8], o1[8];
#pragma unroll
        for (int dt = 0; dt < 8; ++dt) { o0[dt] = (f32x4){0.f, 0.f, 0.f, 0.f}; o1[dt] = (f32x4){0.f, 0.f, 0.f, 0.f}; }
        {
            const int ln = lane_fresh(), c = ln & 15, q = ln >> 4;
            const LAS unsigned char* Vl = F.lds + hk * 73728 + c * 576 + ((q ^ (c >> 2)) << 4);
            bf16x8 vfa[4], vfb[4];
#define ATT_LDV(dst, H) do { _Pragma("unroll") for (int dd = 0; dd < 4; ++dd) dst[dd] = *(const LAS bf16x8*)(Vl + (4 * ((H) & 1) + dd) * 9216 + ((H) >> 1) * 64); } while (0)
#define ATT_MMV(src, H) do { _Pragma("unroll") for (int dd = 0; dd < 4; ++dd) { o0[4 * ((H) & 1) + dd] = __builtin_amdgcn_mfma_f32_16x16x32_bf16(src[dd], pf[0][(H) >> 1], o0[4 * ((H) & 1) + dd], 0, 0, 0); \
        o1[4 * ((H) & 1) + dd] = __builtin_amdgcn_mfma_f32_16x16x32_bf16(src[dd], pf[1][(H) >> 1], o1[4 * ((H) & 1) + dd], 0, 0, 0); } } while (0)
            ATT_LDV(vfa, 0);
#pragma unroll
            for (int H = 0; H < 18; H += 2) {
                ATT_LDV(vfb, H + 1);
                __builtin_amdgcn_sched_barrier(0);
                ATT_MMV(vfa, H);
                if (H + 2 < 18) ATT_LDV(vfa, H + 2);
                __builtin_amdgcn_sched_barrier(0);
                ATT_MMV(vfb, H + 1);
            }
#undef ATT_LDV
#undef ATT_MMV
        }
        const int ln = lane_fresh(), c = ln & 15, q = ln >> 4;
        const float* ga = F.branch_g + (size_t)(l * 2) * 1024 + h * 128 + 4 * q;
        float ss0 = 0.f, ss1 = 0.f;
#pragma unroll
        for (int dt = 0; dt < 8; ++dt) { o0[dt] = o0[dt] * inv[0]; o1[dt] = o1[dt] * inv[1];
            ss0 += (o0[dt][0] * o0[dt][0] + o0[dt][1] * o0[dt][1]) + (o0[dt][2] * o0[dt][2] + o0[dt][3] * o0[dt][3]);
            ss1 += (o1[dt][0] * o1[dt][0] + o1[dt][1] * o1[dt][1]) + (o1[dt][2] * o1[dt][2] + o1[dt][3] * o1[dt][3]); }
        ss0 += shfl_xor_l(ss0, 16, ln); ss0 += shfl_xor_l(ss0, 32, ln); ss1 += shfl_xor_l(ss1, 16, ln); ss1 += shfl_xor_l(ss1, 32, ln);
        if (q == 0) { ssq[h * 32 + c] = ss0; ssq[h * 32 + 16 + c] = ss1; }
        f32x4 gv[8];
#pragma unroll
        for (int dt = 0; dt < 8; ++dt) gv[dt] = *(const f32x4*)(ga + 16 * dt);
        LDS_WAIT(); __syncthreads();
        float t0 = 0.f, t1 = 0.f;
#pragma unroll
        for (int w = 0; w < 8; ++w) { t0 += ssq[w * 32 + c]; t1 += ssq[w * 32 + 16 + c]; }
        const float r0 = 1.0f / sqrtf(t0 * (1.0f / 1024.0f) + RMS_EPS), r1 = 1.0f / sqrtf(t1 * (1.0f / 1024.0f) + RMS_EPS);
        bf16* op = MIX + (tok0 + q0 + c) * DM + h * 128 + 4 * q;
#pragma unroll
        for (int dt = 0; dt < 8; ++dt) { const f32x4 g = gv[dt]; const f32x4 v0 = o0[dt] * r0 * g, v1 = o1[dt] * r1 * g;
            u32x2 w0, w1; w0.x = pk2(v0[0], v0[1]); w0.y = pk2(v0[2], v0[3]); w1.x = pk2(v1[0], v1[1]); w1.y = pk2(v1[2], v1[3]);
            *(u32x2*)(op + 16 * dt) = w0; *(u32x2*)(op + (size_t)16 * DM + 16 * dt) = w1; }
        LDS_WAIT();
    }
    VM_WAIT(); __syncthreads();
}

__global__ void __launch_bounds__(NTHREADS, 2) fwd_kernel(Args args) {
    extern __shared__ __attribute__((aligned(16))) unsigned char lds_raw[];
    Frame F;
    F.lds = (LAS unsigned char*)lds_raw;
    F.tid = threadIdx.x; F.lane = F.tid & 63; F.wave = __builtin_amdgcn_readfirstlane(F.tid >> 6); F.G = gridDim.x; F.bid = blockIdx.x;
    F.x_prompt = args.in[0]; F.x_sample = args.in[1]; F.c_prompt = args.in[2]; F.c_sample = args.in[3]; F.w_mod = args.in[4]; F.b_mod = args.in[5]; F.pre_g = args.in[6]; F.post_g = args.in[7];
    F.w_gate = args.in[8]; F.w_up = args.in[9]; F.w_down = args.in[10]; F.w_in = args.in[11]; F.sink = args.in[12]; F.four_w = args.in[13]; F.branch_g = args.in[14]; F.w_out = args.in[15];
    F.OUT = args.out; F.HB = (bf16*)args.out; F.ws = args.ws; F.XB = (bf16*)(args.ws + WS_X);
    volatile LAS unsigned* MISC = (volatile LAS unsigned*)(F.lds + MISC_OFF);
    for (int u = F.tid; u < (LDS_BYTES - LDSCTL_OFF) / 4; u += NTHREADS) ((LAS unsigned*)(F.lds + LDSCTL_OFF))[u] = 0u;
    __syncthreads();
    (void)xcd_barrier_post((unsigned*)(F.ws + WS_CTL) + 4096, MISC + 8);
#define GRID_BAR() do { XcdBarrier b2_; b2_.bar = (unsigned*)(args.ws + opaque_zero()) + 4096; b2_.x = xb_xcc_id(); b2_.st = (volatile LAS unsigned*)(F.lds + MISC_OFF) + 8; xcd_barrier(b2_, F.wave == 0 && lane_fresh() == 0); } while (0)

    p0a(F);
    GRID_BAR();
    p0b_quant(F);
    norm_phase(F, true, false, 0, true, 0, true);
    GRID_BAR();

    for (int hs = 0; hs < 2 * DEPTH; ++hs) {
        const int l = hs >> 1, fi = hs & 1;
        F.ws = args.ws + opaque_zero(); { int b_ = blockIdx.x, g_ = gridDim.x; asm volatile("" : "+s"(b_), "+s"(g_)); F.bid = b_; F.G = g_; }
        {
            pg8::GeoPlain geo{(const char*)F.HB, (const char*)wptr(F, l, W_GU) + (size_t)fi * 11264 * 2048, DM / 2};
            pg8::XcdColsOrder S; S.init(F.G, F.bid);
            pg8::EpiSwiGLU8 E{(bf16*)(F.ws + WS_BIG), (const float*)(F.ws + WS_SA), (const unsigned*)(F.ws + WS_AMAX) + (size_t)(l * 2 + fi) * 11264};
            pg8::gemm_phase(F.lds, F.wave, geo, S, E);
        }
        GRID_BAR();
        {
            pg8::GeoPlain geo{(const char*)(F.ws + WS_BIG), (const char*)(wptr(F, l, W_D) + (size_t)fi * 2048 * 5632), DFF};
            pg8::StaticOrder S; S.init(M, DM, F.G, F.bid);
            pg8::EpiBf16 E{(bf16*)(F.ws + WS_Y), (size_t)DM};
            pg8::gemm_phase(F.lds, F.wave, geo, S, E);
        }
        GRID_BAR();
        if (fi == 0) {
            norm_phase(F, false, true, l * 3 + 0, true, l * 3 + 1, false);
            GRID_BAR();
            {
                pg8::GeoPlain geo{(const char*)F.HB, (const char*)wptr(F, l, W_QK), DM};
                pg8::StaticOrder S; S.init(M, 2304, F.G, F.bid);
                pg8::EpiRope E{(bf16*)(F.ws + WS_Q), (bf16*)(F.ws + WS_KB), (const float*)(F.ws + WS_ROPE), (const float*)(F.ws + WS_ROPE + 2 * MiB), (bf16*)(F.ws + WS_U)};
                pg8::gemm_phase(F.lds, F.wave, geo, S, E);
            }
            {
                pg8::GeoPlain geo{(const char*)wptr(F, l, W_V), (const char*)F.HB, DM};
                pg8::StaticOrder S; S.init(256, M, F.G, (F.bid + 96) % F.G);
                pg8::EpiBf16 E{(bf16*)(F.ws + WS_VT), (size_t)M};
                pg8::gemm_phase(F.lds, F.wave, geo, S, E);
            }
            GRID_BAR();
            attn_phase(F, l);
            {
                pg8::GeoP1 geo{(const char*)(F.ws + WS_WCS) + (size_t)l * 8 * 256 * 128 * 2, (const char*)(F.ws + WS_U)};
                pg8::StaticOrder S; S.init(2048, M, F.G, F.bid);
                pg8::EpiBf16 E{(bf16*)(F.ws + WS_Z1), (size_t)M};
                pg8::gemm_phase(F.lds, F.wave, geo, S, E);
            }
            GRID_BAR();
            {
                pg8::GeoP2 geo{(const char*)(F.ws + WS_D1), (const char*)(F.ws + WS_Z1)};
                pg8::StaticOrder S; S.init(256, 2560 * 256, F.G, F.bid);
                pg8::EpiTwiddle E{(bf16*)(F.ws + WS_Y2)};
                pg8::gemm_phase(F.lds, F.wave, geo, S, E);
            }
            GRID_BAR();
            {
                pg8::GeoPlain geo{(const char*)(F.ws + WS_D2), (const char*)(F.ws + WS_Y2), 256};
                pg8::StaticOrder S; S.init(256, 1280 * 256, F.G, F.bid);
                pg8::EpiDftOut E{F.HB};
                pg8::gemm_phase(F.lds, F.wave, geo, S, E);
            }
            GRID_BAR();
            mixnorm_phase(F, l);
            GRID_BAR();
            {
                pg8::GeoPlain geo{(const char*)F.HB, (const char*)wptr(F, l, W_O), DM};
                pg8::StaticOrder S; S.init(M, DM, F.G, F.bid);
                pg8::EpiBf16 E{(bf16*)(F.ws + WS_Y), (size_t)DM};
                pg8::gemm_phase(F.lds, F.wave, geo, S, E);
            }
            GRID_BAR();
            norm_phase(F, false, true, l * 3 + 1, true, l * 3 + 2, true);
            GRID_BAR();
        } else {
            const bool lastl = (hs == 2 * DEPTH - 1);
            norm_phase(F, false, true, l * 3 + 2, !lastl, (l + 1) * 3 + 0, true);
            if (!lastl) GRID_BAR();
        }
    }
}

extern "C" void kernel_launch(void* const* d_in, const int* in_sizes, int n_in, void* d_out, int out_size, void* d_ws, size_t ws_size, hipStream_t stream) {
    static int grid = 0;
    if (grid == 0) {
        if (n_in != 16 || out_size != M * DM || ws_size < WS_END) { fprintf(stderr, "kernel_launch: unexpected problem (n_in %d, out %d, ws %zu < %zu)\n", n_in, out_size, ws_size, (size_t)WS_END); grid = -1; return; }
        int dev = 0, cus = 0, per_cu = 0;
        if (hipGetDevice(&dev) != hipSuccess || hipDeviceGetAttribute(&cus, hipDeviceAttributeMultiprocessorCount, dev) != hipSuccess) { grid = -1; return; }
        if (hipFuncSetAttribute((const void*)fwd_kernel, hipFuncAttributeMaxDynamicSharedMemorySize, LDS_BYTES) != hipSuccess) { fprintf(stderr, "kernel_launch: hipFuncSetAttribute failed\n"); grid = -1; return; }
        if (hipOccupancyMaxActiveBlocksPerMultiprocessor(&per_cu, (const void*)fwd_kernel, NTHREADS, LDS_BYTES) != hipSuccess || per_cu < 1) { fprintf(stderr, "kernel_launch: occupancy query reports %d\n", per_cu); }
        (void)hipGetLastError();
        grid = cus;
    }
    if (grid < 0) return;
    if (hipMemsetAsync((char*)d_ws + WS_CTL, 0, CTL_ZERO_BYTES, stream) != hipSuccess) return;
    Args a{};
    for (int i = 0; i < 16; ++i) a.in[i] = (const float*)d_in[i];
    a.out = (float*)d_out; a.ws = (unsigned char*)d_ws;
    hipLaunchKernelGGL(fwd_kernel, dim3(grid), dim3(NTHREADS), LDS_BYTES, stream, a);
}
```

```cpp
#include <hip/hip_runtime.h>
#include <cstdio>
#include <cstdint>

#define LAS __attribute__((address_space(3)))
#define GAS __attribute__((address_space(1)))
typedef unsigned short bf16;
typedef short bf16x8 __attribute__((ext_vector_type(8)));
typedef float f32x4 __attribute__((ext_vector_type(4)));
typedef float f32x2 __attribute__((ext_vector_type(2)));
typedef unsigned u32x4 __attribute__((ext_vector_type(4)));
typedef int i32x4 __attribute__((ext_vector_type(4)));
typedef unsigned u32x2 __attribute__((ext_vector_type(2)));
typedef GAS unsigned gu32;

constexpr int DM = 2048, SEQ = 8192, NSEQ = 5, M = NSEQ * SEQ, DFF = 5632, DEPTH = 2;
constexpr int NQ = 1024, NKV = 256, NIN = 2560, NMOD = 18432;
constexpr float RMS_EPS = 1e-6f;
constexpr float QSCALE = 0.08838834764831845f * 1.4426950408889634f;
constexpr float LOG2E = 1.4426950408889634f;
constexpr int NWAVES = 8, NTHREADS = 512;

constexpr size_t MiB = 1u << 20;
constexpr size_t WS_CTL = 0, CTL_ZERO_BYTES = 1 * MiB;
constexpr size_t WS_AMAX = 262144;
constexpr size_t WS_AMAXD = 458752;
constexpr size_t WS_COEF = 1 * MiB;
constexpr size_t WS_SA = WS_COEF + 768 * 1024;
constexpr size_t WS_ROPE = 2 * MiB;
constexpr size_t WS_D1 = 6 * MiB;
constexpr size_t WS_D2 = 6 * MiB + 65536;
constexpr size_t WS_S2 = 6 * MiB + 262144;
constexpr size_t WS_WCS = 7 * MiB;
constexpr size_t WS_W = 9 * MiB;
constexpr size_t W_GU = 0;
constexpr size_t W_D8 = W_GU + (size_t)2 * 11264 * 2048;
constexpr size_t W_D = W_GU + (size_t)2 * 11264 * 2048 * 2;
constexpr size_t W_QK = W_D + (size_t)2 * 2048 * 5632 * 2;
constexpr size_t W_V = W_QK + (size_t)2304 * 2048 * 2;
constexpr size_t W_Z = W_V + (size_t)256 * 2048 * 2;
constexpr size_t W_O = W_Z + (size_t)1024 * 2048 * 2;
constexpr size_t W_LAYER = W_O + (size_t)2048 * 2048 * 2;
static_assert(W_LAYER == 154 * MiB, "weights per layer");
constexpr size_t WS_X = WS_W + 2 * W_LAYER;
constexpr size_t WS_Y = WS_X + 160 * MiB;
constexpr size_t WS_BIG = WS_Y + 160 * MiB;
constexpr size_t WS_Q = WS_BIG, WS_KB = WS_BIG + 80 * MiB, WS_VT = WS_BIG + 100 * MiB, WS_Z1 = WS_BIG + 120 * MiB, WS_Y2 = WS_BIG + 280 * MiB, WS_U = WS_Y2;
constexpr size_t WS_END = WS_BIG + 440 * MiB;
static_assert((size_t)M * DFF * 2 == 440 * MiB && (size_t)M * DM * 2 == 160 * MiB, "sizes");

constexpr int RING_BYTES = 131072;
constexpr int LDSCTL_OFF = 147456, MISC_OFF = LDSCTL_OFF + 320, SSQ_OFF = LDSCTL_OFF + 512;
constexpr int LDS_BYTES = 147456 + 2048;

#define LDS_WAIT() asm volatile("s_waitcnt lgkmcnt(0)" ::: "memory")
#define VM_WAIT() asm volatile("s_waitcnt vmcnt(0)" ::: "memory")
__device__ __forceinline__ unsigned f2bf(float f) { unsigned u = __builtin_bit_cast(unsigned, f); return (u + 0x7fffu + ((u >> 16) & 1u)) >> 16; }
__device__ __forceinline__ unsigned pk2(float lo, float hi) { return f2bf(lo) | (f2bf(hi) << 16); }
__device__ __forceinline__ float bflo(unsigned w) { return __builtin_bit_cast(float, w << 16); }
__device__ __forceinline__ float bfhi(unsigned w) { return __builtin_bit_cast(float, w & 0xffff0000u); }
__device__ __forceinline__ unsigned cvt_pk_bf16(float lo, float hi) { unsigned r; asm volatile("v_cvt_pk_bf16_f32 %0, %1, %2" : "=v"(r) : "v"(lo), "v"(hi)); return r; }

__device__ __forceinline__ int lane_fresh() { int l; asm volatile("v_mbcnt_lo_u32_b32 %0, -1, 0\n\tv_mbcnt_hi_u32_b32 %0, -1, %0" : "=v"(l)); return l; }
__device__ __forceinline__ size_t opaque_zero() { size_t z = 0; asm volatile("" : "+s"(z)); return z; }
namespace pg8 {
constexpr int BM = 256, BK = 64, HALF = 128, HTB = HALF * BK * 2, STAGE_BYTES = 8 * HTB, NXCD = 8, WGM = 4;
__host__ __device__ __forceinline__ int lds_byte(int r, int c) { const int st = (r >> 4) * 2 + (c >> 5), rr = r & 15, cc = c & 31, ob = rr * 64 + cc * 2; return st * 1024 + (ob ^ (((ob >> 9) & 1) << 5)); }
__host__ __device__ __forceinline__ void stage_rc(int b, int& R, int& C) { const int st = b / 1024, sb = b % 1024, swz = sb ^ (((sb >> 9) & 1) << 5); R = (st >> 1) * 16 + swz / 64; C = (st & 1) * 32 + (swz % 64) / 2; }
__host__ __device__ __forceinline__ int perm32(int rho) { const int n = rho >> 4, i = rho & 15; return 8 * (i >> 2) + 4 * n + (i & 3); }

struct Unit { int pm, pn; };
struct StaticOrder {
    int nM, nN, nwg, G, c;
    __device__ void init(int Mr, int Nc, int G_, int c_) { nM = Mr / BM; nN = Nc / BM; nwg = nM * nN; G = G_; c = c_; }
    __device__ bool next(int i, Unit& u) const {
        const long L = (long)i * G + c; if (L >= nwg) return false;
        int wgid = (int)L; { const int q = nwg / NXCD, r = nwg % NXCD, xcd = wgid % NXCD, off = wgid / NXCD; wgid = (xcd < r ? xcd * (q + 1) : r * (q + 1) + (xcd - r) * q) + off; }
        const int nig = WGM * nN, gid = wgid / nig, fm = gid * WGM, gsz = (nM - fm) < WGM ? (nM - fm) : WGM;
        u.pm = fm + ((wgid % nig) % gsz); u.pn = (wgid % nig) / gsz; return true;
    }
};

struct Col0Order {
    int G, c;
    __device__ bool next(int i, Unit& u) const { const long L = (long)i * G + c; if (L >= 160) return false; u.pm = (int)L; u.pn = 0; return true; }
};
struct ShiftOrder {
    StaticOrder S;
    __device__ bool next(int i, Unit& u) const { if (!S.next(i, u)) return false; u.pn += 1; return true; }
};

struct GeoPlain {
    const char* A; const char* B; int K;
    __device__ __forceinline__ int nt() const { return K / BK; }
    __device__ __forceinline__ const char* a_base(const Unit& u) const { return A + (size_t)u.pm * BM * K * 2; }
    __device__ __forceinline__ const char* b_base(const Unit& u) const { return B + (size_t)u.pn * BM * K * 2; }
    __device__ __forceinline__ unsigned a_off(int R, int C) const { return (unsigned)(R * K + C) * 2u; }
    __device__ __forceinline__ unsigned b_off(int R, int C) const { return (unsigned)(R * K + C) * 2u; }
    __device__ __forceinline__ size_t a_hstep() const { return (size_t)HALF * K * 2; }
    __device__ __forceinline__ size_t b_hstep() const { return (size_t)HALF * K * 2; }
    __device__ __forceinline__ size_t a_kstep() const { return BK * 2; }
    __device__ __forceinline__ size_t b_kstep() const { return BK * 2; }
};
struct GeoP1 {
    const char* A; const char* B;
    __device__ __forceinline__ int nt() const { return 2; }
    __device__ __forceinline__ const char* a_base(const Unit& u) const { return A + (size_t)u.pm * 256 * 128 * 2; }
    __device__ __forceinline__ const char* b_base(const Unit& u) const { return B + ((size_t)(u.pn >> 5) * SEQ + 4 * (u.pn & 31)) * 1024 * 2 + (size_t)u.pm * 128 * 2; }
    __device__ __forceinline__ unsigned a_off(int R, int C) const { return (unsigned)(R * 128 + C) * 2u; }
    __device__ __forceinline__ unsigned b_off(int R, int C) const { return (unsigned)((128 * (R & 63) + (R >> 6)) * 1024 + C) * 2u; }
    __device__ __forceinline__ size_t a_hstep() const { return (size_t)HALF * 128 * 2; }
    __device__ __forceinline__ size_t b_hstep() const { return (size_t)2 * 1024 * 2; }
    __device__ __forceinline__ size_t a_kstep() const { return BK * 2; }
    __device__ __forceinline__ size_t b_kstep() const { return BK * 2; }
};
struct GeoP2 {
    const char* A; const char* B;
    __device__ __forceinline__ int nt() const { return 2; }
    __device__ __forceinline__ const char* a_base(const Unit&) const { return A + opaque_zero(); }
    __device__ __forceinline__ const char* b_base(const Unit& u) const { const int ep = u.pn & 63, g = (u.pn >> 6) & 7, b = u.pn >> 9; return B + ((size_t)(g * 256 + 2 * ep) * M + (size_t)b * SEQ) * 2; }
    __device__ __forceinline__ unsigned a_off(int R, int C) const { return (unsigned)(R * 128 + C) * 2u; }
    __device__ __forceinline__ unsigned b_off(int R, int C) const { return (unsigned)(R * 64 + C) * 2u; }
    __device__ __forceinline__ size_t a_hstep() const { return (size_t)HALF * 128 * 2; }
    __device__ __forceinline__ size_t b_hstep() const { return (size_t)M * 2; }
    __device__ __forceinline__ size_t a_kstep() const { return BK * 2; }
    __device__ __forceinline__ size_t b_kstep() const { return (size_t)128 * M * 2; }
};

struct EpiSwiGLU8; template <bool FIRST> struct EpiSwiGLU8Q; struct EpiBf16S;
template <class E> struct AccT { using T = f32x4; static constexpr bool I8 = false; };
template <> struct AccT<EpiSwiGLU8> { using T = i32x4; static constexpr bool I8 = true; };
template <> struct AccT<EpiSwiGLU8Q<true>> { using T = i32x4; static constexpr bool I8 = true; };
template <> struct AccT<EpiSwiGLU8Q<false>> { using T = i32x4; static constexpr bool I8 = true; };
template <> struct AccT<EpiBf16S> { using T = i32x4; static constexpr bool I8 = true; };
template <class Epi, class Geo, class Ord>
__device__ __forceinline__ void gemm_phase(LAS unsigned char* lds, const int wid_in, const Geo geo, const Ord& S, const Epi& E) {
    int wid = wid_in; asm volatile("" : "+s"(wid));
    const int lane = lane_fresh(), tid = wid * 64 + lane, wr = wid >> 2, wc = wid & 3, fr = lane & 15, fq = lane >> 4;
    const int nt = geo.nt();
    unsigned voffA[2], voffB[2];
#pragma unroll
    for (int i = 0; i < 2; ++i) { int R, C; stage_rc(tid * 16 + i * 8192, R, C); const int Rb = (R & ~31) + perm32(R & 31);
        voffA[i] = geo.a_off(R, C); voffB[i] = geo.b_off(Rb, C); }
    const size_t kstepA = geo.a_kstep(), kstepB = geo.b_kstep(), hstepA = geo.a_hstep(), hstepB = geo.b_hstep();
    const unsigned ldsw = (unsigned)wid * 1024u;
    const int aoff = lds_byte(wr * 64 + fr, fq * 8), boff = lds_byte(wc * 32 + fr, fq * 8);
#define PG8_SA(b, h) (((b) * 2 + (h)) * HTB)
#define PG8_SB(b, h) ((4 + (b) * 2 + (h)) * HTB)
#define PG8_STAGE(bufoff, gbase, voff) do { _Pragma("unroll") for (int _i = 0; _i < 2; ++_i) \
        __builtin_amdgcn_global_load_lds((const unsigned*)((const char*)(gbase) + (voff)[_i]), (LAS unsigned*)(lds + (bufoff) + ldsw + _i * 8192), 16, 0, 0); } while (0)
#define PG8_LDA(dst, b, h) do { _Pragma("unroll") for (int m = 0; m < 4; ++m) _Pragma("unroll") for (int k = 0; k < 2; ++k) dst[m][k] = *(const LAS bf16x8*)(lds + PG8_SA(b, h) + aoff + m * 2048 + k * 1024); } while (0)
#define PG8_LDB(dst, b, h) do { _Pragma("unroll") for (int n = 0; n < 2; ++n) _Pragma("unroll") for (int k = 0; k < 2; ++k) dst[n][k] = *(const LAS bf16x8*)(lds + PG8_SB(b, h) + boff + n * 2048 + k * 1024); } while (0)
#define PG8_MMA(ai, bj, At, Bt) do { if constexpr ((ai) == 1 && Epi::SKIP_AI1) break; __builtin_amdgcn_s_setprio(1); _Pragma("unroll") for (int m = 0; m < 4; ++m) _Pragma("unroll") for (int n = 0; n < 2; ++n) _Pragma("unroll") for (int k = 0; k < 2; ++k) \
        { if constexpr (AccT<Epi>::I8) acc[ai][bj][m][n] = __builtin_amdgcn_mfma_i32_16x16x64_i8(__builtin_bit_cast(i32x4, Bt[n][k]), __builtin_bit_cast(i32x4, At[m][k]), acc[ai][bj][m][n], 0, 0, 0); \
          else acc[ai][bj][m][n] = __builtin_amdgcn_mfma_f32_16x16x32_bf16(Bt[n][k], At[m][k], acc[ai][bj][m][n], 0, 0, 0); } __builtin_amdgcn_s_setprio(0); } while (0)
#define PG8_WAIT_V(n) asm volatile("s_waitcnt vmcnt(" #n ")" ::: "memory")
#define PG8_WAIT_L(n) asm volatile("s_waitcnt lgkmcnt(" #n ")" ::: "memory")
#define PG8_BAR __builtin_amdgcn_s_barrier()
#define PG8_SCHED __builtin_amdgcn_sched_barrier(0)
    Unit cur, nxt; int ui = 0;
    if (!S.next(0, cur)) return;
    typedef typename AccT<Epi>::T acc_t;
    acc_t acc[2][2][4][2];
#pragma unroll
    for (int a = 0; a < 2; ++a)
#pragma unroll
        for (int b = 0; b < 2; ++b)
#pragma unroll
            for (int m = 0; m < 4; ++m)
#pragma unroll
                for (int n = 0; n < 2; ++n) acc[a][b][m][n] = (acc_t){0, 0, 0, 0};
    bf16x8 At[4][2], B0[2][2], B1[2][2];
    const char* cA = geo.a_base(cur); const char* cB = geo.b_base(cur);
    PG8_STAGE(PG8_SB(0, 0), cB, voffB); PG8_STAGE(PG8_SB(0, 1), cB + hstepB, voffB); PG8_STAGE(PG8_SA(0, 0), cA, voffA); PG8_STAGE(PG8_SA(0, 1), cA + hstepA, voffA);
    if (wr == 1) PG8_BAR;
    PG8_WAIT_V(2); PG8_BAR;
    PG8_STAGE(PG8_SB(1, 0), cB + kstepB, voffB); PG8_STAGE(PG8_SA(1, 0), cA + kstepA, voffA); PG8_STAGE(PG8_SB(1, 1), cB + hstepB + kstepB, voffB);
    PG8_WAIT_V(6); PG8_BAR;
    for (;;) {
        const bool has_next = S.next(ui + 1, nxt);
        const char* nA = has_next ? geo.a_base(nxt) : cA; const char* nB = has_next ? geo.b_base(nxt) : cB;
        for (int t = 0; t < nt; t += 2) {
            const bool last = (t == nt - 2);
            const char* a1 = cA + (size_t)(t + 1) * kstepA;
            const char* a2 = last ? nA : cA + (size_t)(t + 2) * kstepA; const char* b2 = last ? nB : cB + (size_t)(t + 2) * kstepB;
            const char* a3 = a2 + kstepA; const char* b3 = b2 + kstepB;
            PG8_LDB(B0, 0, 0); PG8_LDB(B1, 0, 1); PG8_SCHED; PG8_LDA(At, 0, 0); PG8_STAGE(PG8_SA(1, 1), a1 + hstepA, voffA);
            PG8_WAIT_V(8); PG8_WAIT_L(0); PG8_BAR; PG8_MMA(0, 0, At, B0); PG8_MMA(0, 1, At, B1); PG8_BAR; PG8_SCHED;
            PG8_LDA(At, 0, 1); PG8_STAGE(PG8_SB(0, 0), b2, voffB); PG8_STAGE(PG8_SB(0, 1), b2 + hstepB, voffB); PG8_STAGE(PG8_SA(0, 0), a2, voffA);
            PG8_WAIT_V(8); PG8_WAIT_L(0); PG8_BAR; PG8_MMA(1, 0, At, B0); PG8_MMA(1, 1, At, B1); PG8_BAR; PG8_SCHED;
            PG8_LDB(B0, 1, 0); PG8_LDB(B1, 1, 1); PG8_SCHED; PG8_LDA(At, 1, 0); PG8_STAGE(PG8_SA(0, 1), a2 + hstepA, voffA);
            PG8_WAIT_V(8); PG8_WAIT_L(0); PG8_BAR; PG8_MMA(0, 0, At, B0); PG8_MMA(0, 1, At, B1); PG8_BAR; PG8_SCHED;
            PG8_LDA(At, 1, 1); PG8_STAGE(PG8_SB(1, 0), b3, voffB); PG8_STAGE(PG8_SB(1, 1), b3 + hstepB, voffB); PG8_STAGE(PG8_SA(1, 0), a3, voffA);
            PG8_WAIT_V(8); PG8_WAIT_L(0); PG8_BAR; PG8_MMA(1, 0, At, B0); PG8_MMA(1, 1, At, B1); PG8_BAR; PG8_SCHED;
        }
        if (wr == 0) PG8_BAR;
        { const int le = lane_fresh(); E(acc, cur, wr, wc, le & 15, le >> 4); }
        if (!has_next) break;
#pragma unroll
        for (int a = 0; a < 2; ++a)
#pragma unroll
            for (int b = 0; b < 2; ++b)
#pragma unroll
                for (int m = 0; m < 4; ++m)
#pragma unroll
                    for (int n = 0; n < 2; ++n) acc[a][b][m][n] = (acc_t){0, 0, 0, 0};
        cur = nxt; cA = nA; cB = nB; ++ui;
        if (wr == 1) PG8_BAR;
    }
    PG8_WAIT_V(0);
    PG8_BAR;
#undef PG8_SA
#undef PG8_SB
#undef PG8_STAGE
#undef PG8_LDA
#undef PG8_LDB
#undef PG8_MMA
#undef PG8_WAIT_V
#undef PG8_WAIT_L
#undef PG8_BAR
#undef PG8_SCHED
}

struct EpiBf16 {
    static constexpr bool SKIP_AI1 = false;
    bf16* O; size_t ldc;
    __device__ __forceinline__ void operator()(const f32x4 (&acc)[2][2][4][2], const Unit& u, int wr, int wc, int fr, int fq) const {
        const int row0 = u.pm * BM + wr * 64 + fr, col0 = u.pn * BM + wc * 32 + 8 * fq;
#pragma unroll
        for (int ai = 0; ai < 2; ++ai)
#pragma unroll
            for (int m = 0; m < 4; ++m) { bf16* rowp = O + (size_t)(row0 + ai * HALF + m * 16) * ldc + col0;
#pragma unroll
                for (int bj = 0; bj < 2; ++bj) { const f32x4 v0 = acc[ai][bj][m][0], v1 = acc[ai][bj][m][1];
                    u32x4 w; w.x = cvt_pk_bf16(v0[0], v0[1]); w.y = cvt_pk_bf16(v0[2], v0[3]); w.z = cvt_pk_bf16(v1[0], v1[1]); w.w = cvt_pk_bf16(v1[2], v1[3]);
                    *(u32x4*)(rowp + bj * HALF) = w; } }
    }
};
__device__ __forceinline__ float silu_mul(float g, float u) { return g * u * __builtin_amdgcn_rcpf(1.0f + __expf(-g)); }
struct EpiSwiGLU {
    static constexpr bool SKIP_AI1 = false;
    bf16* O;
    __device__ __forceinline__ void operator()(const f32x4 (&acc)[2][2][4][2], const Unit& u, int wr, int wc, int fr, int fq) const {
        const int row0 = u.pm * BM + wr * 64 + fr, col0 = u.pn * HALF + wc * 32 + 8 * fq;
#pragma unroll
        for (int ai = 0; ai < 2; ++ai)
#pragma unroll
            for (int m = 0; m < 4; ++m) { bf16* rowp = O + (size_t)(row0 + ai * HALF + m * 16) * DFF + col0;
                const f32x4 g0 = acc[ai][0][m][0], g1 = acc[ai][0][m][1], u0 = acc[ai][1][m][0], u1 = acc[ai][1][m][1];
                u32x4 w; w.x = cvt_pk_bf16(silu_mul(g0[0], u0[0]), silu_mul(g0[1], u0[1])); w.y = cvt_pk_bf16(silu_mul(g0[2], u0[2]), silu_mul(g0[3], u0[3]));
                w.z = cvt_pk_bf16(silu_mul(g1[0], u1[0]), silu_mul(g1[1], u1[1])); w.w = cvt_pk_bf16(silu_mul(g1[2], u1[2]), silu_mul(g1[3], u1[3]));
                *(u32x4*)rowp = w; }
    }
};
struct EpiSwiGLU8 {
    static constexpr bool SKIP_AI1 = false;
    bf16* O; const float* SA; const unsigned* AM;
    __device__ __forceinline__ void operator()(const i32x4 (&acc)[2][2][4][2], const Unit& u, int wr, int wc, int fr, int fq) const {
        const int row0 = u.pm * BM + wr * 64 + fr, col0 = u.pn * HALF + wc * 32 + 8 * fq, cw = u.pn * BM + wc * 32 + 8 * fq;
        f32x4 sg[2], su[2]; float sa[2][4];
#pragma unroll
        for (int n = 0; n < 2; ++n) { sg[n] = __builtin_bit_cast(f32x4, *(const u32x4*)(AM + cw + 4 * n)); su[n] = __builtin_bit_cast(f32x4, *(const u32x4*)(AM + cw + HALF + 4 * n)); }
#pragma unroll
        for (int ai = 0; ai < 2; ++ai)
#pragma unroll
            for (int m = 0; m < 4; ++m) sa[ai][m] = SA[row0 + ai * HALF + m * 16];
#pragma unroll
        for (int n = 0; n < 2; ++n) { sg[n] *= (1.0f / 127.0f); su[n] *= (1.0f / 127.0f); }
#pragma unroll
        for (int ai = 0; ai < 2; ++ai)
#pragma unroll
            for (int m = 0; m < 4; ++m) { bf16* rowp = O + (size_t)(row0 + ai * HALF + m * 16) * DFF + col0; const float s = sa[ai][m];
                const f32x4 g0 = __builtin_convertvector(acc[ai][0][m][0], f32x4) * (sg[0] * s), g1 = __builtin_convertvector(acc[ai][0][m][1], f32x4) * (sg[1] * s);
                const f32x4 u0 = __builtin_convertvector(acc[ai][1][m][0], f32x4) * (su[0] * s), u1 = __builtin_convertvector(acc[ai][1][m][1], f32x4) * (su[1] * s);
                u32x4 w; w.x = cvt_pk_bf16(silu_mul(g0[0], u0[0]), silu_mul(g0[1], u0[1])); w.y = cvt_pk_bf16(silu_mul(g0[2], u0[2]), silu_mul(g0[3], u0[3]));
                w.z = cvt_pk_bf16(silu_mul(g1[0], u1[0]), silu_mul(g1[1], u1[1])); w.w = cvt_pk_bf16(silu_mul(g1[2], u1[2]), silu_mul(g1[3], u1[3]));
                *(u32x4*)rowp = w; }
    }
};
__device__ __forceinline__ float xlane(float v, int mask, int lane) { return __builtin_bit_cast(float, __builtin_amdgcn_ds_bpermute((lane ^ mask) << 2, __builtin_bit_cast(int, v))); }
__device__ __forceinline__ unsigned q8c_pack(float a, float b, float c, float d, float inv) {
    const unsigned ua = __float_as_uint(__builtin_amdgcn_fmed3f(a * inv, -127.0f, 127.0f) + 12582912.0f), ub = __float_as_uint(__builtin_amdgcn_fmed3f(b * inv, -127.0f, 127.0f) + 12582912.0f);
    const unsigned uc = __float_as_uint(__builtin_amdgcn_fmed3f(c * inv, -127.0f, 127.0f) + 12582912.0f), ud = __float_as_uint(__builtin_amdgcn_fmed3f(d * inv, -127.0f, 127.0f) + 12582912.0f);
    return __builtin_amdgcn_perm(__builtin_amdgcn_perm(ud, uc, 0x0c0c0400u), __builtin_amdgcn_perm(ub, ua, 0x0c0c0400u), 0x05040100u);
}
constexpr float Q2_CLIP = 6.0f;
template <bool FIRST>
struct EpiSwiGLU8Q {
    static constexpr bool SKIP_AI1 = false;
    unsigned char* O8; const float* SA; const unsigned* AM; float* S2; LAS float* xl;
    __device__ __forceinline__ void row8(float (&h)[8], const i32x4& ag0, const i32x4& ag1, const i32x4& au0, const i32x4& au1, const f32x4 (&sg)[2], const f32x4 (&su)[2], float s, int lane) const {
        const f32x4 g0 = __builtin_convertvector(ag0, f32x4) * (sg[0] * s), g1 = __builtin_convertvector(ag1, f32x4) * (sg[1] * s);
        const f32x4 u0 = __builtin_convertvector(au0, f32x4) * (su[0] * s), u1 = __builtin_convertvector(au1, f32x4) * (su[1] * s);
        h[0] = silu_mul(g0[0], u0[0]); h[1] = silu_mul(g0[1], u0[1]); h[2] = silu_mul(g0[2], u0[2]); h[3] = silu_mul(g0[3], u0[3]);
        h[4] = silu_mul(g1[0], u1[0]); h[5] = silu_mul(g1[1], u1[1]); h[6] = silu_mul(g1[2], u1[2]); h[7] = silu_mul(g1[3], u1[3]);
#pragma unroll
        for (int st = 1; st < 8; st <<= 1)
#pragma unroll
            for (int j = 0; j < 8; ++j) if ((j & st) == 0) { const float a = h[j], b = h[j | st]; h[j] = a + b; h[j | st] = a - b; }
#pragma unroll
        for (int mk = 16; mk < 64; mk <<= 1)
#pragma unroll
            for (int j = 0; j < 8; ++j) { const float p = xlane(h[j], mk, lane); h[j] = (lane & mk) ? p - h[j] : h[j] + p; }
    }
    __device__ __forceinline__ void operator()(const i32x4 (&acc)[2][2][4][2], const Unit& u, int wr, int wc, int fr, int fq) const {
        const int lane = fr + 16 * fq;
        const int row0 = u.pm * BM + wr * 64 + fr, col0 = u.pn * HALF + wc * 32 + 8 * fq, cw = u.pn * BM + wc * 32 + 8 * fq;
        f32x4 sg[2], su[2]; float sa[2][4], inv[2][4];
#pragma unroll
        for (int n = 0; n < 2; ++n) { sg[n] = __builtin_bit_cast(f32x4, *(const u32x4*)(AM + cw + 4 * n)); su[n] = __builtin_bit_cast(f32x4, *(const u32x4*)(AM + cw + HALF + 4 * n)); }
#pragma unroll
        for (int ai = 0; ai < 2; ++ai)
#pragma unroll
            for (int m = 0; m < 4; ++m) { sa[ai][m] = SA[row0 + ai * HALF + m * 16]; if constexpr (!FIRST) inv[ai][m] = S2[row0 + ai * HALF + m * 16]; }
#pragma unroll
        for (int n = 0; n < 2; ++n) { sg[n] *= (1.0f / 127.0f); su[n] *= (1.0f / 127.0f); }
        if constexpr (FIRST) {
#pragma unroll
            for (int ai = 0; ai < 2; ++ai)
#pragma unroll
                for (int m = 0; m < 4; ++m) { float h[8]; row8(h, acc[ai][0][m][0], acc[ai][0][m][1], acc[ai][1][m][0], acc[ai][1][m][1], sg, su, sa[ai][m], lane);
                    float ss = (h[0] * h[0] + h[1] * h[1]) + (h[2] * h[2] + h[3] * h[3]) + (h[4] * h[4] + h[5] * h[5]) + (h[6] * h[6] + h[7] * h[7]);
                    ss += xlane(ss, 16, lane); ss += xlane(ss, 32, lane);
                    if (fq == 0) xl[(ai * HALF + wr * 64 + m * 16 + fr) * 4 + wc] = ss; }
            asm volatile("s_waitcnt lgkmcnt(0)" ::: "memory"); __builtin_amdgcn_s_barrier();
#pragma unroll
            for (int ai = 0; ai < 2; ++ai)
#pragma unroll
                for (int m = 0; m < 4; ++m) { const f32x4 t = *(const LAS f32x4*)(xl + (ai * HALF + wr * 64 + m * 16 + fr) * 4);
                    const float sc = Q2_CLIP * (1.0f / 127.0f) * sqrtf(((t[0] + t[1]) + (t[2] + t[3])) * (1.0f / 128.0f));
                    inv[ai][m] = sc; if (wc == 0 && fq == 0) S2[row0 + ai * HALF + m * 16] = sc; }
        }
#pragma unroll
        for (int ai = 0; ai < 2; ++ai)
#pragma unroll
            for (int m = 0; m < 4; ++m) { float h[8]; row8(h, acc[ai][0][m][0], acc[ai][0][m][1], acc[ai][1][m][0], acc[ai][1][m][1], sg, su, sa[ai][m], lane);
                const float iv = inv[ai][m] > 0.f ? __builtin_amdgcn_rcpf(inv[ai][m]) : 0.f;
                u32x2 w; w.x = q8c_pack(h[0], h[1], h[2], h[3], iv); w.y = q8c_pack(h[4], h[5], h[6], h[7], iv);
                *(u32x2*)(O8 + (size_t)(row0 + ai * HALF + m * 16) * DFF + col0) = w; }
    }
};
struct EpiBf16S {
    static constexpr bool SKIP_AI1 = false;
    bf16* O; const float* S2; const unsigned* AMD;
    __device__ __forceinline__ void operator()(const i32x4 (&acc)[2][2][4][2], const Unit& u, int wr, int wc, int fr, int fq) const {
        const int row0 = u.pm * BM + wr * 64 + fr, col0 = u.pn * BM + wc * 32 + 8 * fq;
        f32x4 sw[2][2]; float sr[2][4];
#pragma unroll
        for (int bj = 0; bj < 2; ++bj)
#pragma unroll
            for (int n = 0; n < 2; ++n) sw[bj][n] = __builtin_bit_cast(f32x4, *(const u32x4*)(AMD + col0 + bj * HALF + 4 * n));
#pragma unroll
        for (int ai = 0; ai < 2; ++ai)
#pragma unroll
            for (int m = 0; m < 4; ++m) sr[ai][m] = S2[row0 + ai * HALF + m * 16];
#pragma unroll
        for (int bj = 0; bj < 2; ++bj)
#pragma unroll
            for (int n = 0; n < 2; ++n) sw[bj][n] *= (1.0f / (127.0f * 32.0f));
#pragma unroll
        for (int ai = 0; ai < 2; ++ai)
#pragma unroll
            for (int m = 0; m < 4; ++m) { bf16* rowp = O + (size_t)(row0 + ai * HALF + m * 16) * DM + col0; const float s = sr[ai][m];
#pragma unroll
                for (int bj = 0; bj < 2; ++bj) { const f32x4 v0 = __builtin_convertvector(acc[ai][bj][m][0], f32x4) * (sw[bj][0] * s), v1 = __builtin_convertvector(acc[ai][bj][m][1], f32x4) * (sw[bj][1] * s);
                    u32x4 w; w.x = cvt_pk_bf16(v0[0], v0[1]); w.y = cvt_pk_bf16(v0[2], v0[3]); w.z = cvt_pk_bf16(v1[0], v1[1]); w.w = cvt_pk_bf16(v1[2], v1[3]);
                    *(u32x4*)(rowp + bj * HALF) = w; } }
    }
};
struct EpiRope {
    static constexpr bool SKIP_AI1 = false;
    static constexpr bool HOOK = false;
    bf16* Q; bf16* KB; const float* COS; const float* SIN; bf16* U;
    __device__ __forceinline__ void operator()(const f32x4 (&acc)[2][2][4][2], const Unit& u, int wr, int wc, int fr, int fq) const {
        if (u.pn >= 5) {
            const int row0u = u.pm * BM + wr * 64 + fr, col0 = (u.pn - 5) * BM + wc * 32 + 8 * fq;
#pragma unroll
            for (int ai = 0; ai < 2; ++ai)
#pragma unroll
                for (int m = 0; m < 4; ++m) { bf16* rowp = U + (size_t)(row0u + ai * HALF + m * 16) * 1024 + col0;
#pragma unroll
                    for (int bj = 0; bj < 2; ++bj) { const f32x4 v0 = acc[ai][bj][m][0], v1 = acc[ai][bj][m][1];
                        u32x4 w; w.x = cvt_pk_bf16(v0[0], v0[1]); w.y = cvt_pk_bf16(v0[2], v0[3]); w.z = cvt_pk_bf16(v1[0], v1[1]); w.w = cvt_pk_bf16(v1[2], v1[3]);
                        *(u32x4*)(rowp + bj * HALF) = w; } }
            return;
        }
        const int row0 = u.pm * BM + wr * 64 + fr, hsel = wc >> 1, d0 = 32 * (wc & 1) + 8 * fq;
        const bool isq = u.pn < 4; const float sc = isq ? QSCALE : 1.0f;
        bf16* base = isq ? Q + (2 * u.pn + hsel) * 128 + d0 : KB + hsel * 128 + d0; const size_t ld = isq ? NQ : NKV;
#pragma unroll
        for (int ai = 0; ai < 2; ++ai) {
            f32x4 c0[4], c1[4], s0[4], s1[4];
#pragma unroll
            for (int m = 0; m < 4; ++m) { const int pos = (row0 + ai * HALF + m * 16) & (SEQ - 1);
                c0[m] = *(const f32x4*)(COS + pos * 64 + d0); c1[m] = *(const f32x4*)(COS + pos * 64 + d0 + 4); s0[m] = *(const f32x4*)(SIN + pos * 64 + d0); s1[m] = *(const f32x4*)(SIN + pos * 64 + d0 + 4); }
            u32x4 w1[4], w2[4];
#pragma unroll
            for (int m = 0; m < 4; ++m) {
                const f32x4 a0 = acc[ai][0][m][0], a1 = acc[ai][0][m][1], b0 = acc[ai][1][m][0], b1 = acc[ai][1][m][1];
                const f32x4 o10 = (a0 * c0[m] - b0 * s0[m]) * sc, o11 = (a1 * c1[m] - b1 * s1[m]) * sc, o20 = (a0 * s0[m] + b0 * c0[m]) * sc, o21 = (a1 * s1[m] + b1 * c1[m]) * sc;
                w1[m].x = cvt_pk_bf16(o10[0], o10[1]); w1[m].y = cvt_pk_bf16(o10[2], o10[3]); w1[m].z = cvt_pk_bf16(o11[0], o11[1]); w1[m].w = cvt_pk_bf16(o11[2], o11[3]);
                w2[m].x = cvt_pk_bf16(o20[0], o20[1]); w2[m].y = cvt_pk_bf16(o20[2], o20[3]); w2[m].z = cvt_pk_bf16(o21[0], o21[1]); w2[m].w = cvt_pk_bf16(o21[2], o21[3]); }
#pragma unroll
            for (int m = 0; m < 4; ++m) { bf16* rp = base + (size_t)(row0 + ai * HALF + m * 16) * ld; *(u32x4*)rp = w1[m]; *(u32x4*)(rp + 64) = w2[m]; }
        }
    }
};
struct EpiTwiddle {
    static constexpr bool SKIP_AI1 = false;
    bf16* Y2;
    __device__ __forceinline__ void operator()(const f32x4 (&acc)[2][2][4][2], const Unit& u, int wr, int wc, int fr, int fq) const {
        if (wr != 0) return;
        int zz = 0; asm volatile("" : "+v"(zz));
        const int ep = u.pn & 63, g = (u.pn >> 6) & 7, b = u.pn >> 9, s20 = wc * 32 + 8 * fq + zz;
#pragma unroll
        for (int m = 0; m < 4; ++m) { const int k1 = 16 * m + fr;
#pragma unroll
            for (int bj = 0; bj < 2; ++bj) { const int e = 2 * ep + bj; bf16* rp = Y2 + ((size_t)((b * 64 + k1) * 8 + g) * 128 + e) * 256 + s20;
                float re[8], im[8];
#pragma unroll
                for (int n = 0; n < 2; ++n)
#pragma unroll
                    for (int i = 0; i < 4; ++i) { const int s2 = s20 + 4 * n + i; const float fr_ = (float)((k1 * s2) & 8191) * (1.0f / 8192.0f);
                        const float ct = __builtin_amdgcn_cosf(fr_), st = __builtin_amdgcn_sinf(fr_); const float yr = acc[0][bj][m][n][i], yi = acc[1][bj][m][n][i];
                        re[4 * n + i] = yr * ct + yi * st; im[4 * n + i] = yi * ct - yr * st; }
                u32x4 w1, w2; w1.x = cvt_pk_bf16(re[0], re[1]); w1.y = cvt_pk_bf16(re[2], re[3]); w1.z = cvt_pk_bf16(re[4], re[5]); w1.w = cvt_pk_bf16(re[6], re[7]);
                w2.x = cvt_pk_bf16(im[0], im[1]); w2.y = cvt_pk_bf16(im[2], im[3]); w2.z = cvt_pk_bf16(im[4], im[5]); w2.w = cvt_pk_bf16(im[6], im[7]);
                *(u32x4*)rp = w1; *(u32x4*)(rp + 128) = w2; } }
    }
};
struct EpiDftOut {
    static constexpr bool SKIP_AI1 = true;
    bf16* MIX;
    __device__ __forceinline__ void operator()(const f32x4 (&acc)[2][2][4][2], const Unit& u, int wr, int wc, int fr, int fq) const {
        const int gp = u.pn & 3, k1 = (u.pn >> 2) & 63, b = u.pn >> 8;
#pragma unroll
        for (int m = 0; m < 4; ++m) { const int k2 = 64 * wr + 16 * m + fr; bf16* rp = MIX + (size_t)(b * SEQ + k1 + 64 * k2) * DM + 1024 + gp * 256 + wc * 32 + 8 * fq;
#pragma unroll
            for (int bj = 0; bj < 2; ++bj) { const f32x4 v0 = acc[0][bj][m][0], v1 = acc[0][bj][m][1];
                u32x4 w; w.x = cvt_pk_bf16(v0[0], v0[1]); w.y = cvt_pk_bf16(v0[2], v0[3]); w.z = cvt_pk_bf16(v1[0], v1[1]); w.w = cvt_pk_bf16(v1[2], v1[3]);
                *(u32x4*)(rp + bj * 128) = w; } }
    }
};
}

#define XB_TMO      128
#define XB_XCNT(j)  (256  + 64 * (j))
#define XB_XSUB(j)  (1280 + 64 * (j))
#define XB_XGEN(j)  (2304 + 64 * (j))
#define XB_TOP      3328
#define XB_TOPGEN   3392
#define XCD_BAR_WORDS 3456
#define XB_SPIN_CAP (1u << 18)
__device__ __forceinline__ unsigned xb_ld(unsigned* p)              { return __hip_atomic_load(p, __ATOMIC_RELAXED, __HIP_MEMORY_SCOPE_AGENT); }
__device__ __forceinline__ unsigned xb_add(unsigned* p, unsigned v) { return __hip_atomic_fetch_add(p, v, __ATOMIC_RELAXED, __HIP_MEMORY_SCOPE_AGENT); }
__device__ __forceinline__ unsigned xb_xcc_id() { return (unsigned)__builtin_amdgcn_s_getreg((3 << 11) | 20) & 0xFu; }
#define XB_SPIN(cond, bar) do { unsigned _sp = 0; while (cond) { __builtin_amdgcn_s_sleep(1); \
    if ((++_sp & 255u) == 0u) { if (xb_ld(&(bar)[XB_TMO])) break; if (_sp > XB_SPIN_CAP) { atomicAdd(&(bar)[XB_TMO], 1u); break; } } } } while (0)
struct XcdBarrier { unsigned* bar; unsigned x; volatile LAS unsigned* st; };
__device__ __forceinline__ XcdBarrier xcd_barrier_post(unsigned* bar, volatile LAS unsigned* st) {
    XcdBarrier b; b.bar = bar; b.x = xb_xcc_id(); b.st = st;
    if (threadIdx.x == 0) (void)xb_add(&bar[XB_XCNT(b.x)], 1u);
    return b;
}
__device__ __forceinline__ void xcd_barrier_complete(unsigned* bar, unsigned x, unsigned& nloc, unsigned& nx) {
    const unsigned G = gridDim.x * gridDim.y * gridDim.z;
    unsigned sum, cnt, mine, sp = 0u;
    for (;;) {
        sum = 0u; cnt = 0u; mine = 0u;
#pragma unroll
        for (unsigned j = 0; j < 16; ++j) { const unsigned c = xb_ld(&bar[XB_XCNT(j)]); sum += c; cnt += (c > 0u) ? 1u : 0u; mine = (j == x) ? c : mine; }
        if (sum == G) break;
        __builtin_amdgcn_s_sleep(1);
        if ((++sp & 255u) == 0u) { if (xb_ld(&bar[XB_TMO])) break; if (sp > XB_SPIN_CAP) { atomicAdd(&bar[XB_TMO], 1u); break; } }
    }
    nloc = mine > 0u ? mine : 1u; nx = cnt > 0u ? cnt : 1u;
}
__device__ __forceinline__ void xcd_barrier(const XcdBarrier& b, const bool leader) {
    asm volatile("s_waitcnt vmcnt(0)" ::: "memory");
    __syncthreads();
    if (leader) {
        unsigned* bar = b.bar;
        __builtin_amdgcn_s_waitcnt(0);
        unsigned nloc = b.st[0], nx = b.st[1];
        if (nloc == 0u) { xcd_barrier_complete(bar, b.x, nloc, nx); b.st[0] = nloc; b.st[1] = nx; }
        const unsigned old = xb_add(&bar[XB_XSUB(b.x)], 1u);
        const unsigned gen = old / nloc;
        if (old + 1u == (gen + 1u) * nloc) {
            __builtin_amdgcn_fence(__ATOMIC_RELEASE, "agent");
            asm volatile("s_waitcnt vmcnt(0)" ::: "memory");
            const unsigned og = xb_add(&bar[XB_TOP], 1u);
            const unsigned tg = og / nx;
            if (og + 1u == (tg + 1u) * nx) xb_add(&bar[XB_TOPGEN], 1u);
            else XB_SPIN(xb_ld(&bar[XB_TOPGEN]) == tg, bar);
            __builtin_amdgcn_fence(__ATOMIC_ACQUIRE, "agent");
            xb_add(&bar[XB_XGEN(b.x)], 1u);
            asm volatile("s_waitcnt vmcnt(0)" ::: "memory");
        } else {
            XB_SPIN(xb_ld(&bar[XB_XGEN(b.x)]) == gen, bar);
            __builtin_amdgcn_fence(__ATOMIC_ACQUIRE, "agent");
            asm volatile("s_waitcnt vmcnt(0)" ::: "memory");
        }
    }
    __syncthreads();
}

struct Args { const float* in[16]; float* out; unsigned char* ws; };
struct Frame {
    LAS unsigned char* lds; int tid, lane, wave, G, bid;
    const float *x_prompt, *x_sample, *c_prompt, *c_sample, *w_mod, *b_mod, *pre_g, *post_g, *w_gate, *w_up, *w_down, *w_in, *sink, *four_w, *branch_g, *w_out;
    bf16* XB; bf16* HB; float* OUT; unsigned char* ws;
};
__device__ __forceinline__ float shfl_xor_l(float v, int mask, int lane) { return __builtin_bit_cast(float, __builtin_amdgcn_ds_bpermute((lane ^ mask) << 2, __builtin_bit_cast(int, v))); }
__device__ __forceinline__ float wave_sum(float v, int lane) {
#pragma unroll
    for (int o = 1; o < 64; o <<= 1) v += shfl_xor_l(v, o, lane);
    return v;
}

__device__ __forceinline__ float wave_max(float v, int lane) {
#pragma unroll
    for (int o = 1; o < 64; o <<= 1) v = fmaxf(v, shfl_xor_l(v, o, lane));
    return v;
}
__device__ __forceinline__ unsigned q8_pack(float a, float b, float c, float d, float inv) {
    const unsigned ua = __float_as_uint(fmaf(a, inv, 12582912.0f)), ub = __float_as_uint(fmaf(b, inv, 12582912.0f)), uc = __float_as_uint(fmaf(c, inv, 12582912.0f)), ud = __float_as_uint(fmaf(d, inv, 12582912.0f));
    return __builtin_amdgcn_perm(__builtin_amdgcn_perm(ud, uc, 0x0c0c0400u), __builtin_amdgcn_perm(ub, ua, 0x0c0c0400u), 0x05040100u);
}

__device__ __forceinline__ void transpose_item(const float* W, size_t ldw, int K, bf16* WT, int dest_row0, int k0, int n0, LAS float* scr, int lane, unsigned* AMD = nullptr) {
#pragma unroll 8
    for (int i = 0; i < 32; ++i) { const int kk = 2 * i + (lane >> 5); scr[kk * 33 + (lane & 31)] = W[(size_t)(k0 + kk) * ldw + n0 + (lane & 31)]; }
    LDS_WAIT(); asm volatile("" ::: "memory");
    if (AMD) {
        LAS float* t = scr + (32 * (lane >> 5)) * 33 + (lane & 31);
        float v[32];
#pragma unroll
        for (int j = 0; j < 32; ++j) v[j] = t[j * 33];
#pragma unroll
        for (int st = 1; st < 32; st <<= 1)
#pragma unroll
            for (int j = 0; j < 32; ++j) if ((j & st) == 0) { const float a = v[j], b = v[j | st]; v[j] = a + b; v[j | st] = a - b; }
        float mx = 0.f;
#pragma unroll
        for (int j = 0; j < 32; ++j) { t[j * 33] = v[j]; mx = fmaxf(mx, fabsf(v[j])); }
        mx = fmaxf(mx, shfl_xor_l(mx, 32, lane));
        if (lane < 32) atomicMax(AMD + dest_row0 + lane, __float_as_uint(mx));
        LDS_WAIT(); asm volatile("" ::: "memory");
    }
    const int c = lane & 7;
#pragma unroll
    for (int j = 0; j < 4; ++j) { const int n = (lane >> 3) + 8 * j; const LAS float* s = scr + (8 * c) * 33 + n;
        u32x4 o; o.x = pk2(s[0 * 33], s[1 * 33]); o.y = pk2(s[2 * 33], s[3 * 33]); o.z = pk2(s[4 * 33], s[5 * 33]); o.w = pk2(s[6 * 33], s[7 * 33]);
        *(GAS u32x4*)(WT + (size_t)(dest_row0 + n) * K + k0 + 8 * c) = o; }
    LDS_WAIT(); asm volatile("" ::: "memory");
}
__device__ __forceinline__ void quant_item(const float* W, const unsigned* AM, unsigned char* W8T, int dest_row0, int k0, int n0, LAS float* scr, int lane) {
#pragma unroll 8
    for (int i = 0; i < 32; ++i) { const int kk = 2 * i + (lane >> 5); scr[kk * 33 + (lane & 31)] = W[(size_t)(k0 + kk) * DFF + n0 + (lane & 31)]; }
    const int n = lane >> 1, hf = lane & 1;
    const float am = __uint_as_float(AM[dest_row0 + n]), inv = am > 0.f ? 127.0f / am : 0.f;
    LDS_WAIT(); asm volatile("" ::: "memory");
    const LAS float* t = scr + (32 * hf) * 33 + n;
    u32x4 o0, o1;
    o0.x = q8_pack(t[0 * 33], t[1 * 33], t[2 * 33], t[3 * 33], inv);     o0.y = q8_pack(t[4 * 33], t[5 * 33], t[6 * 33], t[7 * 33], inv);
    o0.z = q8_pack(t[8 * 33], t[9 * 33], t[10 * 33], t[11 * 33], inv);   o0.w = q8_pack(t[12 * 33], t[13 * 33], t[14 * 33], t[15 * 33], inv);
    o1.x = q8_pack(t[16 * 33], t[17 * 33], t[18 * 33], t[19 * 33], inv); o1.y = q8_pack(t[20 * 33], t[21 * 33], t[22 * 33], t[23 * 33], inv);
    o1.z = q8_pack(t[24 * 33], t[25 * 33], t[26 * 33], t[27 * 33], inv); o1.w = q8_pack(t[28 * 33], t[29 * 33], t[30 * 33], t[31 * 33], inv);
    GAS unsigned char* dst = (GAS unsigned char*)(W8T + (size_t)(dest_row0 + n) * DM + k0 + 32 * hf);
    *(GAS u32x4*)dst = o0; *(GAS u32x4*)(dst + 16) = o1;
    LDS_WAIT(); asm volatile("" ::: "memory");
}
__device__ __forceinline__ bf16* wptr(Frame& F, int l, size_t off) { return (bf16*)(F.ws + WS_W + (size_t)l * W_LAYER + off); }

__device__ __forceinline__ void p0a(Frame& F) {
    {
        LAS float* sc = (LAS float*)F.lds;
        LAS float* red = (LAS float*)(F.lds + 40960);
        bool have_c = false;
        for (int it = F.bid; it < 144; it += F.G) {
            if (!have_c) {
                for (int i = F.tid; i < 5 * 2048; i += NTHREADS) { const int b = i >> 11, k = i & 2047; const float c = (b == 0) ? F.c_prompt[k] : F.c_sample[(b - 1) * 2048 + k]; sc[i] = c / (1.0f + __expf(-c)); }
                __syncthreads(); have_c = true;
            }
            const int l = it / 72, chunk = it % 72, col = chunk * 256 + 4 * F.lane;
            const float* wp = F.w_mod + (size_t)l * DM * NMOD + col;
            f32x4 a[5];
#pragma unroll
            for (int b = 0; b < 5; ++b) a[b] = (f32x4){0.f, 0.f, 0.f, 0.f};
            const int kbeg = F.wave * 256;
#pragma unroll 8
            for (int k = kbeg; k < kbeg + 256; ++k) { const f32x4 w = *(const f32x4*)(wp + (size_t)k * NMOD);
#pragma unroll
                for (int b = 0; b < 5; ++b) a[b] += w * sc[b * 2048 + k]; }
#pragma unroll
            for (int b = 0; b < 5; ++b) *(LAS f32x4*)(red + (F.wave * 5 + b) * 256 + 4 * F.lane) = a[b];
            __syncthreads();
            for (int o = F.tid; o < 5 * 256; o += NTHREADS) { const int b = o >> 8, cc = o & 255; float v = 0.f;
#pragma unroll
                for (int w = 0; w < 8; ++w) v += red[(w * 5 + b) * 256 + cc];
                const int jg = chunk * 256 + cc; v += F.b_mod[l * NMOD + jg];
                const int jj = jg / 6144, t = (jg % 6144) / 2048, cl = jg & 2047;
                float r;
                if (t == 0) r = v; else if (t == 1) r = F.pre_g[(l * 3 + jj) * DM + cl] * (1.0f + v); else r = ((jj == 1) ? 1.0f : 0.5f) * (1.0f + v) * F.post_g[(l * 3 + jj) * DM + cl];
                ((float*)(F.ws + WS_COEF))[((size_t)((l * 3 + jj) * 3 + t) * 5 + b) * DM + cl] = r; }
            __syncthreads();
        }
        __syncthreads();
    }
    {
        LAS float* red = (LAS float*)F.lds;
        unsigned* AM = (unsigned*)(F.ws + WS_AMAX);
        for (int it = (F.bid + F.G - 144 % F.G) % F.G; it < 704; it += F.G) {
            const int mat = it / 88, q = it % 88, chunk = q >> 2, kq = q & 3, up = mat & 1, lf = mat >> 1;
            const float* wp = (up ? F.w_up : F.w_gate) + (size_t)lf * DM * DFF + (size_t)(kq * 512 + F.wave * 64) * DFF + chunk * 256 + 4 * F.lane;
            f32x4 mx = (f32x4){0.f, 0.f, 0.f, 0.f};
#pragma unroll 8
            for (int k = 0; k < 64; ++k) { const f32x4 w = *(const f32x4*)(wp + (size_t)k * DFF);
                mx[0] = fmaxf(mx[0], fabsf(w[0])); mx[1] = fmaxf(mx[1], fabsf(w[1])); mx[2] = fmaxf(mx[2], fabsf(w[2])); mx[3] = fmaxf(mx[3], fabsf(w[3])); }
            *(LAS f32x4*)(red + F.wave * 256 + 4 * F.lane) = mx;
            __syncthreads();
            if (F.tid < 256) { float v = red[F.tid];
#pragma unroll
                for (int w = 1; w < 8; ++w) v = fmaxf(v, red[w * 256 + F.tid]);
                const int n = chunk * 256 + F.tid;
                atomicMax(AM + (size_t)lf * 11264 + 256 * (n >> 7) + (up ? 128 : 0) + (n & 127), __float_as_uint(v)); }
            __syncthreads();
        }
    }
    const int gt = F.bid * NTHREADS + F.tid, NGT = F.G * NTHREADS;
    for (int i = gt; i < SEQ * 64; i += NGT) { const int pos = i >> 6, k = i & 63; const float inv = (float)pow(10000.0, -(double)(2 * k) / 128.0); const float ang = (float)pos * inv;
        double sd, cd; sincos((double)ang, &sd, &cd); ((float*)(F.ws + WS_ROPE))[i] = (float)cd; ((float*)(F.ws + WS_ROPE + 2 * MiB))[i] = (float)sd; }
    for (int i = gt; i < 256 * 128; i += NGT) { const int R = i >> 7, c = i & 127, pp = R >> 7, kk = R & 127, part = c >> 6, s1 = c & 63; float v = 0.f;
        if (kk < 64) { const float fr = (float)((kk * s1) & 63) * (2.0f / 64.0f); const float cv = cospif(fr), sv = sinpif(fr); v = (pp == part) ? cv : (pp == 0 ? sv : -sv); v *= 0.125f; }
        ((bf16*)(F.ws + WS_D1))[i] = (bf16)f2bf(v); }
    for (int i = gt; i < 256 * 256; i += NGT) { const int R = i >> 8, c = i & 255, pp = c >> 7, s2 = c & 127; float v = 0.f;
        if (R < 128) { const float fr = (float)((R * s2) & 127) * (2.0f / 128.0f); v = (pp == 0 ? cospif(fr) : sinpif(fr)) * 0.08838834764831845f; }
        ((bf16*)(F.ws + WS_D2))[i] = (bf16)f2bf(v); }
    {
        LAS float* tab = (LAS float*)F.lds;
        if (F.tid < 128) { const float fr = (float)F.tid * (2.0f / 128.0f); tab[F.tid] = cospif(fr); tab[128 + F.tid] = sinpif(fr); }
        __syncthreads();
        for (int i = gt; i < 2 * 8 * 128 * 256; i += NGT) { const int e2 = i & 255, c = (i >> 8) & 127, lg = i >> 15; const int e = e2 & 127; const bool im = e2 >= 128;
            const float* wl = F.four_w + (size_t)lg * 128 * 128 + e; float s = 0.f;
#pragma unroll 8
            for (int m = 0; m < 128; ++m) s += tab[(im ? 128 : 0) + ((m * c) & 127)] * wl[m * 128];
            ((bf16*)(F.ws + WS_WCS))[((size_t)lg * 256 + e2) * 128 + c] = (bf16)f2bf((im ? -s : s) * 0.08838834764831845f); }
        __syncthreads();
    }
    {
        LAS float* scr = (LAS float*)(F.lds + F.wave * 16384);
        const int gw = F.bid * NWAVES + F.wave, NGW = F.G * NWAVES;
        constexpr int I_D = 2 * 88 * 64, I_QK = 32 * 72, I_V = 32 * 8, I_O = 32 * 64;
        constexpr int I_L = I_D + I_QK + I_V + I_O;
        for (int it = gw; it < 2 * I_L; it += NGW) {
            const int l = it / I_L; int r = it % I_L;
            if (r < I_D) { const int fi = r / (88 * 64), q = r % (88 * 64), kb = q / 64, nb = q % 64;
                transpose_item(F.w_down + (size_t)(l * 2 + fi) * DFF * DM, DM, DFF, wptr(F, l, W_D) + (size_t)fi * 2048 * 5632, nb * 32, kb * 64, nb * 32, scr, F.lane,
                               l == 1 ? (unsigned*)(F.ws + WS_AMAXD) + fi * 2048 : nullptr); continue; }
            r -= I_D;
            if (r < I_QK) { const int kb = r / 72, nb = r % 72; int n0 = nb * 32; int dest;
                if (nb >= 40) { dest = n0; n0 += 256; }
                else if (n0 < 1024) { const int head = n0 >> 7, half = (n0 >> 6) & 1, x = n0 & 63; dest = 256 * (head >> 1) + 128 * half + 64 * (head & 1) + x; }
                else { const int q = n0 - 1024, hs = q >> 7, half = (q >> 6) & 1, x = q & 63; dest = 1024 + 128 * half + 64 * hs + x; }
                transpose_item(F.w_in + (size_t)l * DM * NIN, NIN, DM, wptr(F, l, W_QK), dest, kb * 64, n0, scr, F.lane); continue; }
            r -= I_QK;
            if (r < I_V) { const int kb = r / 8, nb = r % 8;
                transpose_item(F.w_in + (size_t)l * DM * NIN, NIN, DM, wptr(F, l, W_V), nb * 32, kb * 64, 1280 + nb * 32, scr, F.lane); continue; }
            r -= I_V;
            { const int kb = r / 64, nb = r % 64;
                transpose_item(F.w_out + (size_t)l * DM * DM, DM, DM, wptr(F, l, W_O), nb * 32, kb * 64, nb * 32, scr, F.lane); }
        }
    }
}

__device__ __forceinline__ void p0b_quant(Frame& F) {
    LAS float* scr = (LAS float*)(F.lds + 65536 + F.wave * 8704);
    const int gw = F.bid * NWAVES + F.wave, NGW = F.G * NWAVES;
    constexpr int I_M = 32 * 176;
    for (int it = gw; it < 8 * I_M; it += NGW) {
        const int mat = it / I_M, q = it % I_M, kb = q / 176, nb = q % 176, n0 = nb * 32, up = mat & 1, lf = mat >> 1, l = lf >> 1, fi = lf & 1;
        quant_item((up ? F.w_up : F.w_gate) + (size_t)lf * DM * DFF, (const unsigned*)(F.ws + WS_AMAX) + (size_t)lf * 11264,
                   (unsigned char*)wptr(F, l, W_GU) + (size_t)fi * 11264 * 2048, 256 * (n0 >> 7) + (up ? 128 : 0) + (n0 & 127), kb * 64, n0, scr, F.lane);
    }
    for (int it = gw; it < 2 * 2048; it += NGW) {
        const unsigned char* src = (const unsigned char*)wptr(F, 1, W_D) + (size_t)it * 5632 * 2;
        unsigned char* dst = (unsigned char*)wptr(F, 1, W_D8) + (size_t)it * 5632;
        const float am = __uint_as_float(((const unsigned*)(F.ws + WS_AMAXD))[it]), inv = am > 0.f ? 127.0f / am : 0.f;
        u32x4 v[11];
#pragma unroll
        for (int j = 0; j < 11; ++j) v[j] = *(const u32x4*)(src + (size_t)(j * 64 + F.lane) * 16);
#pragma unroll
        for (int j = 0; j < 11; ++j) { u32x2 w; w.x = pg8::q8c_pack(bflo(v[j].x), bfhi(v[j].x), bflo(v[j].y), bfhi(v[j].y), inv); w.y = pg8::q8c_pack(bflo(v[j].z), bfhi(v[j].z), bflo(v[j].w), bfhi(v[j].w), inv);
            *(u32x2*)(dst + (size_t)(j * 64 + F.lane) * 8) = w; }
    }
}

struct NormRow { f32x4 x[8]; u32x2 y[8]; };
__device__ __forceinline__ void norm_load(Frame& F, NormRow& R, int row, bool first, bool do_post) {
    if (first) { const float* xr = ((row >> 13) == 0 ? F.x_prompt + (size_t)row * DM : F.x_sample + (size_t)(row - SEQ) * DM);
#pragma unroll
        for (int j = 0; j < 8; ++j) R.x[j] = *(const f32x4*)(xr + 4 * F.lane + 256 * j);
    } else { const bf16* xr = F.XB + (size_t)row * DM + 4 * F.lane;
#pragma unroll
        for (int j = 0; j < 8; ++j) { const u32x2 v = *(const u32x2*)(xr + 256 * j); R.x[j] = (f32x4){bflo(v.x), bfhi(v.x), bflo(v.y), bfhi(v.y)}; } }
    if (do_post) { const bf16* yr = (const bf16*)(F.ws + WS_Y) + (size_t)row * DM + 4 * F.lane;
#pragma unroll
        for (int j = 0; j < 8; ++j) R.y[j] = *(const u32x2*)(yr + 256 * j); }
}
__device__ __forceinline__ void norm_row(Frame& F, NormRow& R, int row, bool first, bool do_post, bool do_pre, bool q8, const LAS float* cf) {
    if (do_post) {
        float ss = 0.f;
#pragma unroll
        for (int j = 0; j < 8; ++j) { const float a = bflo(R.y[j].x), bb = bfhi(R.y[j].x), c = bflo(R.y[j].y), d = bfhi(R.y[j].y); ss += (a * a + bb * bb) + (c * c + d * d); }
        const float r = 1.0f / sqrtf(wave_sum(ss, F.lane) * (1.0f / DM) + RMS_EPS);
#pragma unroll
        for (int j = 0; j < 8; ++j) { const f32x4 y = (f32x4){bflo(R.y[j].x), bfhi(R.y[j].x), bflo(R.y[j].y), bfhi(R.y[j].y)}; R.x[j] += *(const LAS f32x4*)(cf + 4 * F.lane + 256 * j) * (y * r); }
    }
    if (!do_pre) {
        float* xo = F.OUT + (size_t)row * DM + 4 * F.lane;
#pragma unroll
        for (int j = 0; j < 8; ++j) *(f32x4*)(xo + 256 * j) = R.x[j];
    } else {
        bf16* xo = F.XB + (size_t)row * DM + 4 * F.lane;
#pragma unroll
        for (int j = 0; j < 8; ++j) { u32x2 w; w.x = pk2(R.x[j][0], R.x[j][1]); w.y = pk2(R.x[j][2], R.x[j][3]); *(u32x2*)(xo + 256 * j) = w; }
    }
    if (do_pre) {
        float ss = 0.f;
#pragma unroll
        for (int j = 0; j < 8; ++j) ss += (R.x[j][0] * R.x[j][0] + R.x[j][1] * R.x[j][1]) + (R.x[j][2] * R.x[j][2] + R.x[j][3] * R.x[j][3]);
        const float r = 1.0f / sqrtf(wave_sum(ss, F.lane) * (1.0f / DM) + RMS_EPS);
        if (!q8) {
            bf16* ho = F.HB + (size_t)row * DM + 4 * F.lane;
#pragma unroll
            for (int j = 0; j < 8; ++j) { const f32x4 hv = R.x[j] * r * *(const LAS f32x4*)(cf + 2048 + 4 * F.lane + 256 * j) + *(const LAS f32x4*)(cf + 4096 + 4 * F.lane + 256 * j);
                u32x2 w; w.x = pk2(hv[0], hv[1]); w.y = pk2(hv[2], hv[3]); *(u32x2*)(ho + 256 * j) = w; }
        } else {
            float mx = 0.f;
#pragma unroll
            for (int j = 0; j < 8; ++j) { const f32x4 hv = R.x[j] * r * *(const LAS f32x4*)(cf + 2048 + 4 * F.lane + 256 * j) + *(const LAS f32x4*)(cf + 4096 + 4 * F.lane + 256 * j);
                R.x[j] = hv; mx = fmaxf(fmaxf(mx, fmaxf(fabsf(hv[0]), fabsf(hv[1]))), fmaxf(fabsf(hv[2]), fabsf(hv[3]))); }
            mx = fmaxf(wave_max(mx, F.lane), 1e-30f);
            const float inv = 127.0f / mx;
            unsigned char* ho = (unsigned char*)F.HB + (size_t)row * DM + 4 * F.lane;
#pragma unroll
            for (int j = 0; j < 8; ++j) *(unsigned*)(ho + 256 * j) = q8_pack(R.x[j][0], R.x[j][1], R.x[j][2], R.x[j][3], inv);
            if (F.lane == 0) ((float*)(F.ws + WS_SA))[row] = mx * (1.0f / 127.0f);
        }
    }
}
__device__ __forceinline__ void norm_phase(Frame& F, bool first, bool do_post, int cpost, bool do_pre, int cpre, bool q8) {
    F.lane = lane_fresh(); F.tid = F.wave * 64 + F.lane;
    const int NGW = F.G * NWAVES, per = (M + NGW - 1) / NGW;
    const int blk0 = F.bid * NWAVES * per, rbeg = blk0 + F.wave * per, rend = (rbeg + per < M) ? rbeg + per : M;
    const int b_lo = (blk0 >> 13) > 4 ? 4 : (blk0 >> 13);
    LAS float* cfl = (LAS float*)F.lds;
    {
        const float* COEF = (const float*)(F.ws + WS_COEF);
        for (int i = F.tid; i < 2 * 3 * 2048 / 4; i += NTHREADS) { const int e = 4 * i, set = e / 6144, v = (e % 6144) >> 11, col = e & 2047; const int b = (b_lo + set > 4) ? 4 : b_lo + set;
            const int ci = (v == 0) ? (cpost * 3 + 2) : (v == 1 ? cpre * 3 + 1 : cpre * 3 + 0);
            *(LAS f32x4*)(cfl + e) = *(const f32x4*)(COEF + ((size_t)ci * 5 + b) * DM + col); }
        LDS_WAIT(); __syncthreads();
    }
    if (rbeg < rend) {
        NormRow Ra, Rb;
        norm_load(F, Ra, rbeg, first, do_post);
        for (int row = rbeg; row < rend; row += 2) {
            const bool has_b = row + 1 < rend;
            if (has_b) norm_load(F, Rb, row + 1, first, do_post);
            norm_row(F, Ra, row, first, do_post, do_pre, q8, cfl + (((row >> 13) - b_lo) & 1) * 6144);
            if (has_b) {
                if (row + 2 < rend) norm_load(F, Ra, row + 2, first, do_post);
                norm_row(F, Rb, row + 1, first, do_post, do_pre, q8, cfl + ((((row + 1) >> 13) - b_lo) & 1) * 6144);
            }
        }
    }
    __syncthreads();
}
__device__ __forceinline__ void mixnorm_phase(Frame& F, int l) {
    F.lane = lane_fresh(); F.tid = F.wave * 64 + F.lane;
    const int gw = F.bid * NWAVES + F.wave, NGW = F.G * NWAVES, per = (M + NGW - 1) / NGW, rbeg = gw * per, rend = (rbeg + per < M) ? rbeg + per : M;
    const float* gf = F.branch_g + (size_t)(l * 2 + 1) * 1024 + 8 * F.lane;
    f32x4 g[2][2];
#pragma unroll
    for (int j = 0; j < 2; ++j) { g[j][0] = *(const f32x4*)(gf + 512 * j); g[j][1] = *(const f32x4*)(gf + 512 * j + 4); }
    for (int row0 = rbeg; row0 < rend; row0 += 4) {
        u32x4 v[4][2];
#pragma unroll
        for (int r = 0; r < 4; ++r) { const int row = (row0 + r < rend) ? row0 + r : rend - 1; const bf16* p = F.HB + (size_t)row * DM + 1024 + 8 * F.lane;
#pragma unroll
            for (int j = 0; j < 2; ++j) v[r][j] = *(const u32x4*)(p + 512 * j); }
#pragma unroll
        for (int r = 0; r < 4; ++r) {
            float f[2][8]; float ss = 0.f;
#pragma unroll
            for (int j = 0; j < 2; ++j) { f[j][0] = bflo(v[r][j].x); f[j][1] = bfhi(v[r][j].x); f[j][2] = bflo(v[r][j].y); f[j][3] = bfhi(v[r][j].y); f[j][4] = bflo(v[r][j].z); f[j][5] = bfhi(v[r][j].z); f[j][6] = bflo(v[r][j].w); f[j][7] = bfhi(v[r][j].w);
#pragma unroll
                for (int i = 0; i < 8; ++i) ss += f[j][i] * f[j][i]; }
            const float rr = 1.0f / sqrtf(wave_sum(ss, F.lane) * (1.0f / 1024.0f) + RMS_EPS);
            if (row0 + r < rend) { bf16* p = F.HB + (size_t)(row0 + r) * DM + 1024 + 8 * F.lane;
#pragma unroll
                for (int j = 0; j < 2; ++j) { u32x4 w; w.x = pk2(f[j][0] * rr * g[j][0][0], f[j][1] * rr * g[j][0][1]); w.y = pk2(f[j][2] * rr * g[j][0][2], f[j][3] * rr * g[j][0][3]);
                    w.z = pk2(f[j][4] * rr * g[j][1][0], f[j][5] * rr * g[j][1][1]); w.w = pk2(f[j][6] * rr * g[j][1][2], f[j][7] * rr * g[j][1][3]); *(u32x4*)(p + 512 * j) = w; } }
        }
    }
}

constexpr int ATT_IMG = 147456;
__device__ __forceinline__ void attn_phase(Frame& F, int l) {
    F.lane = lane_fresh(); F.tid = F.wave * 64 + F.lane;
    const bf16* Q = (const bf16*)(F.ws + WS_Q); const bf16* KB = (const bf16*)(F.ws + WS_KB); const bf16* VT = (const bf16*)(F.ws + WS_VT); bf16* MIX = F.HB;
    const bf16* ZERO = (const bf16*)(F.ws + WS_CTL + 512 * 1024);
    LAS float* ssq = (LAS float*)(F.lds + SSQ_OFF);
    const int h = F.wave, hk = h >> 2;
    const float sinkl = F.sink[l * 8 + h] * LOG2E;
    for (int unit = F.bid; unit < NSEQ * 256; unit += F.G) {
        const int b = unit >> 8, q0 = (unit & 255) * 32, k0 = q0 - 128;
        const size_t tok0 = (size_t)b * SEQ;
        { const int ln = lane_fresh();
#pragma unroll 2
        for (int j = F.wave; j < 144; j += 8) {
            const int p = 64 * j + ln, hkk = p >= 4608 ? 1 : 0, pr = p - hkk * 4608, row = pr >> 4, slot = pr & 15;
            const int chunk = slot ^ ((((row >> 3) & 3) << 2) | (row & 3)); const int key = k0 + row; const bool ok = key >= 0 && key < SEQ;
            const bf16* src = ok ? KB + (tok0 + key) * NKV + hkk * 128 + chunk * 8 : ZERO;
            __builtin_amdgcn_global_load_lds((const unsigned*)src, (LAS unsigned*)(F.lds + 1024 * j), 16, 0, 0);
        } }
        bf16x8 qfs[2][4];
        { const int ln = lane_fresh(), c = ln & 15, q = ln >> 4;
#pragma unroll
          for (int qt = 0; qt < 2; ++qt)
#pragma unroll
            for (int ks = 0; ks < 4; ++ks) qfs[qt][ks] = *(const bf16x8*)(Q + (tok0 + q0 + 16 * qt + c) * NQ + h * 128 + 32 * ks + 8 * q); }
        VM_WAIT(); __syncthreads();
        bf16x8 pf[2][9]; float inv[2];
#pragma unroll
        for (int qt = 0; qt < 2; ++qt) {
            const int ln = lane_fresh(), c = ln & 15, q = ln >> 4;
            const LAS unsigned char* Kl = F.lds + hk * 73728 + (8 * (c >> 2) + (c & 3)) * 256;
            int xoff[4];
#pragma unroll
            for (int ks = 0; ks < 4; ++ks) xoff[ks] = ((4 * ks + q) ^ c) << 4;
            bf16x8 qf[4];
#pragma unroll
            for (int ks = 0; ks < 4; ++ks) qf[ks] = qfs[qt][ks];
            f32x4 s[9][2];
            bf16x8 kfa[4], kfb[4];
#define ATT_LDK(dst, T) do { _Pragma("unroll") for (int ks = 0; ks < 4; ++ks) dst[ks] = *(const LAS bf16x8*)(Kl + (32 * ((T) >> 1) + 4 * ((T) & 1)) * 256 + xoff[ks]); } while (0)
#define ATT_MMK(src, T) do { f32x4 a0 = (f32x4){0.f, 0.f, 0.f, 0.f}; _Pragma("unroll") for (int ks = 0; ks < 4; ++ks) a0 = __builtin_amdgcn_mfma_f32_16x16x32_bf16(src[ks], qf[ks], a0, 0, 0, 0); s[(T) >> 1][(T) & 1] = a0; } while (0)
            ATT_LDK(kfa, 0);
#pragma unroll
            for (int T = 0; T < 18; T += 2) {
                ATT_LDK(kfb, T + 1);
                __builtin_amdgcn_sched_barrier(0);
                ATT_MMK(kfa, T);
                if (T + 2 < 18) ATT_LDK(kfa, T + 2);
                __builtin_amdgcn_sched_barrier(0);
                ATT_MMK(kfb, T + 1);
            }
#undef ATT_LDK
#undef ATT_MMK
            const int qpos = q0 + 16 * qt + c; float mx = -1e30f;
            const bool edge = (k0 < 0) || (k0 + 288 > SEQ);
#pragma unroll
            for (int G = 0; G < 9; ++G) {
                if (G == 0 || G == 8 || edge) {
#pragma unroll
                    for (int tt = 0; tt < 2; ++tt)
#pragma unroll
                        for (int r = 0; r < 4; ++r) { const int kpos = k0 + 32 * G + 8 * q + 4 * tt + r; const int d = qpos - kpos;
                            const bool ok = (d <= 128) && (d >= -128) && (kpos >= 0) && (kpos < SEQ); const float v = ok ? s[G][tt][r] : -1e30f; s[G][tt][r] = v; mx = fmaxf(mx, v); }
                } else {
#pragma unroll
                    for (int tt = 0; tt < 2; ++tt)
#pragma unroll
                        for (int r = 0; r < 4; ++r) mx = fmaxf(mx, s[G][tt][r]);
                }
            }
            mx = fmaxf(mx, shfl_xor_l(mx, 16, ln)); mx = fmaxf(mx, shfl_xor_l(mx, 32, ln)); mx = fmaxf(mx, sinkl);
            float lsum = 0.f;
#pragma unroll
            for (int G = 0; G < 9; ++G) { float p[8];
#pragma unroll
                for (int tt = 0; tt < 2; ++tt)
#pragma unroll
                    for (int r = 0; r < 4; ++r) { p[4 * tt + r] = __builtin_amdgcn_exp2f(s[G][tt][r] - mx); lsum += p[4 * tt + r]; }
                u32x4 pw; pw.x = cvt_pk_bf16(p[0], p[1]); pw.y = cvt_pk_bf16(p[2], p[3]); pw.z = cvt_pk_bf16(p[4], p[5]); pw.w = cvt_pk_bf16(p[6], p[7]);
                pf[qt][G] = __builtin_bit_cast(bf16x8, pw); }
            lsum += shfl_xor_l(lsum, 16, ln); lsum += shfl_xor_l(lsum, 32, ln); lsum += __builtin_amdgcn_exp2f(sinkl - mx);
            inv[qt] = 1.0f / lsum;
        }
        __syncthreads();
        { const int ln = lane_fresh();
#pragma unroll 2
        for (int j = F.wave; j < 144; j += 8) {
            const int p = 64 * j + ln, hkk = p >= 4608 ? 1 : 0, pr = p - hkk * 4608, d = pr / 36, c1 = pr - d * 36;
            const int ch = c1 ^ ((d >> 2) & 3); const int tok = k0 + 8 * ch; const bool ok = tok >= 0 && tok < SEQ;
            const bf16* src = ok ? VT + (size_t)(hkk * 128 + d) * M + tok0 + tok : ZERO;
            __builtin_amdgcn_global_load_lds((const unsigned*)src, (LAS unsigned*)(F.lds + 1024 * j), 16, 0, 0);
        } }
        VM_WAIT(); __syncthreads();
        f32x4 o0[8], o1[8];
#pragma unroll
        for (int dt = 0; dt < 8; ++dt) { o0[dt] = (f32x4){0.f, 0.f, 0.f, 0.f}; o1[dt] = (f32x4){0.f, 0.f, 0.f, 0.f}; }
        {
            const int ln = lane_fresh(), c = ln & 15, q = ln >> 4;
            const LAS unsigned char* Vl = F.lds + hk * 73728 + c * 576 + ((q ^ (c >> 2)) << 4);
            bf16x8 vfa[4], vfb[4];
#define ATT_LDV(dst, H) do { _Pragma("unroll") for (int dd = 0; dd < 4; ++dd) dst[dd] = *(const LAS bf16x8*)(Vl + (4 * ((H) & 1) + dd) * 9216 + ((H) >> 1) * 64); } while (0)
#define ATT_MMV(src, H) do { _Pragma("unroll") for (int dd = 0; dd < 4; ++dd) { o0[4 * ((H) & 1) + dd] = __builtin_amdgcn_mfma_f32_16x16x32_bf16(src[dd], pf[0][(H) >> 1], o0[4 * ((H) & 1) + dd], 0, 0, 0); \
        o1[4 * ((H) & 1) + dd] = __builtin_amdgcn_mfma_f32_16x16x32_bf16(src[dd], pf[1][(H) >> 1], o1[4 * ((H) & 1) + dd], 0, 0, 0); } } while (0)
            ATT_LDV(vfa, 0);
#pragma unroll
            for (int H = 0; H < 18; H += 2) {
                ATT_LDV(vfb, H + 1);
                __builtin_amdgcn_sched_barrier(0);
                ATT_MMV(vfa, H);
                if (H + 2 < 18) ATT_LDV(vfa, H + 2);
                __builtin_amdgcn_sched_barrier(0);
                ATT_MMV(vfb, H + 1);
            }
#undef ATT_LDV
#undef ATT_MMV
        }
        const int ln = lane_fresh(), c = ln & 15, q = ln >> 4;
        const float* ga = F.branch_g + (size_t)(l * 2) * 1024 + h * 128 + 4 * q;
        float ss0 = 0.f, ss1 = 0.f;
#pragma unroll
        for (int dt = 0; dt < 8; ++dt) { o0[dt] = o0[dt] * inv[0]; o1[dt] = o1[dt] * inv[1];
            ss0 += (o0[dt][0] * o0[dt][0] + o0[dt][1] * o0[dt][1]) + (o0[dt][2] * o0[dt][2] + o0[dt][3] * o0[dt][3]);
            ss1 += (o1[dt][0] * o1[dt][0] + o1[dt][1] * o1[dt][1]) + (o1[dt][2] * o1[dt][2] + o1[dt][3] * o1[dt][3]); }
        ss0 += shfl_xor_l(ss0, 16, ln); ss0 += shfl_xor_l(ss0, 32, ln); ss1 += shfl_xor_l(ss1, 16, ln); ss1 += shfl_xor_l(ss1, 32, ln);
        if (q == 0) { ssq[h * 32 + c] = ss0; ssq[h * 32 + 16 + c] = ss1; }
        f32x4 gv[8];
#pragma unroll
        for (int dt = 0; dt < 8; ++dt) gv[dt] = *(const f32x4*)(ga + 16 * dt);
        LDS_WAIT(); __syncthreads();
        float t0 = 0.f, t1 = 0.f;
#pragma unroll
        for (int w = 0; w < 8; ++w) { t0 += ssq[w * 32 + c]; t1 += ssq[w * 32 + 16 + c]; }
        const float r0 = 1.0f / sqrtf(t0 * (1.0f / 1024.0f) + RMS_EPS), r1 = 1.0f / sqrtf(t1 * (1.0f / 1024.0f) + RMS_EPS);
        bf16* op = MIX + (tok0 + q0 + c) * DM + h * 128 + 4 * q;
#pragma unroll
        for (int dt = 0; dt < 8; ++dt) { const f32x4 g = gv[dt]; const f32x4 v0 = o0[dt] * r0 * g, v1 = o1[dt] * r1 * g;
            u32x2 w0, w1; w0.x = pk2(v0[0], v0[1]); w0.y = pk2(v0[2], v0[3]); w1.x = pk2(v1[0], v1[1]); w1.y = pk2(v1[2], v1[3]);
            *(u32x2*)(op + 16 * dt) = w0; *(u32x2*)(op + (size_t)16 * DM + 16 * dt) = w1; }
        LDS_WAIT();
    }
    VM_WAIT(); __syncthreads();
}

__global__ void __launch_bounds__(NTHREADS, 2) fwd_kernel(Args args) {
    extern __shared__ __attribute__((aligned(16))) unsigned char lds_raw[];
    Frame F;
    F.lds = (LAS unsigned char*)lds_raw;
    F.tid = threadIdx.x; F.lane = F.tid & 63; F.wave = __builtin_amdgcn_readfirstlane(F.tid >> 6); F.G = gridDim.x; F.bid = blockIdx.x;
    F.x_prompt = args.in[0]; F.x_sample = args.in[1]; F.c_prompt = args.in[2]; F.c_sample = args.in[3]; F.w_mod = args.in[4]; F.b_mod = args.in[5]; F.pre_g = args.in[6]; F.post_g = args.in[7];
    F.w_gate = args.in[8]; F.w_up = args.in[9]; F.w_down = args.in[10]; F.w_in = args.in[11]; F.sink = args.in[12]; F.four_w = args.in[13]; F.branch_g = args.in[14]; F.w_out = args.in[15];
    F.OUT = args.out; F.HB = (bf16*)args.out; F.ws = args.ws; F.XB = (bf16*)(args.ws + WS_X);
    volatile LAS unsigned* MISC = (volatile LAS unsigned*)(F.lds + MISC_OFF);
    for (int u = F.tid; u < (LDS_BYTES - LDSCTL_OFF) / 4; u += NTHREADS) ((LAS unsigned*)(F.lds + LDSCTL_OFF))[u] = 0u;
    __syncthreads();
    (void)xcd_barrier_post((unsigned*)(F.ws + WS_CTL) + 4096, MISC + 8);
#define GRID_BAR() do { XcdBarrier b2_; b2_.bar = (unsigned*)(args.ws + opaque_zero()) + 4096; b2_.x = xb_xcc_id(); b2_.st = (volatile LAS unsigned*)(F.lds + MISC_OFF) + 8; xcd_barrier(b2_, F.wave == 0 && lane_fresh() == 0); } while (0)

    p0a(F);
    GRID_BAR();
    p0b_quant(F);
    norm_phase(F, true, false, 0, true, 0, true);
    GRID_BAR();

    for (int hs = 0; hs < 2 * DEPTH; ++hs) {
        const int l = hs >> 1, fi = hs & 1;
        F.ws = args.ws + opaque_zero(); { int b_ = blockIdx.x, g_ = gridDim.x; asm volatile("" : "+s"(b_), "+s"(g_)); F.bid = b_; F.G = g_; }
        if (l == 0) {
        {
            pg8::GeoPlain geo{(const char*)F.HB, (const char*)wptr(F, l, W_GU) + (size_t)fi * 11264 * 2048, DM / 2};
            pg8::StaticOrder S; S.init(M, 11264, F.G, F.bid);
            pg8::EpiSwiGLU8 E{(bf16*)(F.ws + WS_BIG), (const float*)(F.ws + WS_SA), (const unsigned*)(F.ws + WS_AMAX) + (size_t)(l * 2 + fi) * 11264};
            pg8::gemm_phase(F.lds, F.wave, geo, S, E);
        }
        GRID_BAR();
        {
            pg8::GeoPlain geo{(const char*)(F.ws + WS_BIG), (const char*)(wptr(F, l, W_D) + (size_t)fi * 2048 * 5632), DFF};
            pg8::StaticOrder S; S.init(M, DM, F.G, F.bid);
            pg8::EpiBf16 E{(bf16*)(F.ws + WS_Y), (size_t)DM};
            pg8::gemm_phase(F.lds, F.wave, geo, S, E);
        }
        GRID_BAR();
        } else {
        {
            pg8::GeoPlain geo{(const char*)F.HB, (const char*)wptr(F, l, W_GU) + (size_t)fi * 11264 * 2048, DM / 2};
            pg8::Col0Order S{F.G, F.bid};
            pg8::EpiSwiGLU8Q<true> E{F.ws + WS_BIG, (const float*)(F.ws + WS_SA), (const unsigned*)(F.ws + WS_AMAX) + (size_t)(l * 2 + fi) * 11264, (float*)(F.ws + WS_S2), (LAS float*)(F.lds + RING_BYTES)};
            pg8::gemm_phase(F.lds, F.wave, geo, S, E);
        }
        GRID_BAR();
        {
            pg8::GeoPlain geo{(const char*)F.HB, (const char*)wptr(F, l, W_GU) + (size_t)fi * 11264 * 2048, DM / 2};
            pg8::ShiftOrder S; S.S.init(M, 11264 - 256, F.G, F.bid);
            pg8::EpiSwiGLU8Q<false> E{F.ws + WS_BIG, (const float*)(F.ws + WS_SA), (const unsigned*)(F.ws + WS_AMAX) + (size_t)(l * 2 + fi) * 11264, (float*)(F.ws + WS_S2), (LAS float*)(F.lds + RING_BYTES)};
            pg8::gemm_phase(F.lds, F.wave, geo, S, E);
        }
        GRID_BAR();
        {
            pg8::GeoPlain geo{(const char*)(F.ws + WS_BIG), (const char*)wptr(F, l, W_D8) + (size_t)fi * 2048 * 5632, DFF / 2};
            pg8::StaticOrder S; S.init(M, DM, F.G, F.bid);
            pg8::EpiBf16S E{(bf16*)(F.ws + WS_Y), (const float*)(F.ws + WS_S2), (const unsigned*)(F.ws + WS_AMAXD) + fi * 2048};
            pg8::gemm_phase(F.lds, F.wave, geo, S, E);
        }
        GRID_BAR();
        }
        if (fi == 0) {
            norm_phase(F, false, true, l * 3 + 0, true, l * 3 + 1, false);
            GRID_BAR();
            {
                pg8::GeoPlain geo{(const char*)F.HB, (const char*)wptr(F, l, W_QK), DM};
                pg8::StaticOrder S; S.init(M, 2304, F.G, F.bid);
                pg8::EpiRope E{(bf16*)(F.ws + WS_Q), (bf16*)(F.ws + WS_KB), (const float*)(F.ws + WS_ROPE), (const float*)(F.ws + WS_ROPE + 2 * MiB), (bf16*)(F.ws + WS_U)};
                pg8::gemm_phase(F.lds, F.wave, geo, S, E);
            }
            {
                pg8::GeoPlain geo{(const char*)wptr(F, l, W_V), (const char*)F.HB, DM};
                pg8::StaticOrder S; S.init(256, M, F.G, (F.bid + 96) % F.G);
                pg8::EpiBf16 E{(bf16*)(F.ws + WS_VT), (size_t)M};
                pg8::gemm_phase(F.lds, F.wave, geo, S, E);
            }
            GRID_BAR();
            attn_phase(F, l);
            {
                pg8::GeoP1 geo{(const char*)(F.ws + WS_WCS) + (size_t)l * 8 * 256 * 128 * 2, (const char*)(F.ws + WS_U)};
                pg8::StaticOrder S; S.init(2048, M, F.G, F.bid);
                pg8::EpiBf16 E{(bf16*)(F.ws + WS_Z1), (size_t)M};
                pg8::gemm_phase(F.lds, F.wave, geo, S, E);
            }
            GRID_BAR();
            {
                pg8::GeoP2 geo{(const char*)(F.ws + WS_D1), (const char*)(F.ws + WS_Z1)};
                pg8::StaticOrder S; S.init(256, 2560 * 256, F.G, F.bid);
                pg8::EpiTwiddle E{(bf16*)(F.ws + WS_Y2)};
                pg8::gemm_phase(F.lds, F.wave, geo, S, E);
            }
            GRID_BAR();
            {
                pg8::GeoPlain geo{(const char*)(F.ws + WS_D2), (const char*)(F.ws + WS_Y2), 256};
                pg8::StaticOrder S; S.init(256, 1280 * 256, F.G, F.bid);
                pg8::EpiDftOut E{F.HB};
                pg8::gemm_phase(F.lds, F.wave, geo, S, E);
            }
            GRID_BAR();
            mixnorm_phase(F, l);
            GRID_BAR();
            {
                pg8::GeoPlain geo{(const char*)F.HB, (const char*)wptr(F, l, W_O), DM};
                pg8::StaticOrder S; S.init(M, DM, F.G, F.bid);
                pg8::EpiBf16 E{(bf16*)(F.ws + WS_Y), (size_t)DM};
                pg8::gemm_phase(F.lds, F.wave, geo, S, E);
            }
            GRID_BAR();
            norm_phase(F, false, true, l * 3 + 1, true, l * 3 + 2, true);
            GRID_BAR();
        } else {
            const bool lastl = (hs == 2 * DEPTH - 1);
            norm_phase(F, false, true, l * 3 + 2, !lastl, (l + 1) * 3 + 0, true);
            if (!lastl) GRID_BAR();
        }
    }
}

extern "C" void kernel_launch(void* const* d_in, const int* in_sizes, int n_in, void* d_out, int out_size, void* d_ws, size_t ws_size, hipStream_t stream) {
    static int grid = 0;
    if (grid == 0) {
        if (n_in != 16 || out_size != M * DM || ws_size < WS_END) { fprintf(stderr, "kernel_launch: unexpected problem (n_in %d, out %d, ws %zu < %zu)\n", n_in, out_size, ws_size, (size_t)WS_END); grid = -1; return; }
        int dev = 0, cus = 0, per_cu = 0;
        if (hipGetDevice(&dev) != hipSuccess || hipDeviceGetAttribute(&cus, hipDeviceAttributeMultiprocessorCount, dev) != hipSuccess) { grid = -1; return; }
        if (hipFuncSetAttribute((const void*)fwd_kernel, hipFuncAttributeMaxDynamicSharedMemorySize, LDS_BYTES) != hipSuccess) { fprintf(stderr, "kernel_launch: hipFuncSetAttribute failed\n"); grid = -1; return; }
        if (hipOccupancyMaxActiveBlocksPerMultiprocessor(&per_cu, (const void*)fwd_kernel, NTHREADS, LDS_BYTES) != hipSuccess || per_cu < 1) { fprintf(stderr, "kernel_launch: occupancy query reports %d\n", per_cu); }
        (void)hipGetLastError();
        grid = cus;
    }
    if (grid < 0) return;
    if (hipMemsetAsync((char*)d_ws + WS_CTL, 0, CTL_ZERO_BYTES, stream) != hipSuccess) return;
    Args a{};
    for (int i = 0; i < 16; ++i) a.in[i] = (const float*)d_in[i];
    a.out = (float*)d_out; a.ws = (unsigned char*)d_ws;
    hipLaunchKernelGGL(fwd_kernel, dim3(grid), dim3(NTHREADS), LDS_BYTES, stream, a);
}
```

```cpp
#include <hip/hip_runtime.h>
#include <cstdio>
#include <cstdint>

#define LAS __attribute__((address_space(3)))
#define GAS __attribute__((address_space(1)))
typedef unsigned short bf16;
typedef short bf16x8 __attribute__((ext_vector_type(8)));
typedef float f32x4 __attribute__((ext_vector_type(4)));
typedef float f32x2 __attribute__((ext_vector_type(2)));
typedef unsigned u32x4 __attribute__((ext_vector_type(4)));
typedef int i32x4 __attribute__((ext_vector_type(4)));
typedef unsigned u32x2 __attribute__((ext_vector_type(2)));
typedef GAS unsigned gu32;

constexpr int DM = 2048, SEQ = 8192, NSEQ = 5, M = NSEQ * SEQ, DFF = 5632, DEPTH = 2;
constexpr int NQ = 1024, NKV = 256, NIN = 2560, NMOD = 18432;
constexpr float RMS_EPS = 1e-6f;
constexpr float QSCALE = 0.08838834764831845f * 1.4426950408889634f;
constexpr float LOG2E = 1.4426950408889634f;
constexpr int NWAVES = 8, NTHREADS = 512;

constexpr size_t MiB = 1u << 20;
constexpr size_t WS_CTL = 0, CTL_ZERO_BYTES = 1 * MiB;
constexpr size_t WS_AMAX = 262144;
constexpr size_t WS_AMAXD = 458752;
constexpr size_t WS_COEF = 1 * MiB;
constexpr size_t WS_SA = WS_COEF + 768 * 1024;
constexpr size_t WS_ROPE = 2 * MiB;
constexpr size_t WS_D1 = 6 * MiB;
constexpr size_t WS_D2 = 6 * MiB + 65536;
constexpr size_t WS_S2 = 6 * MiB + 262144;
constexpr size_t WS_WCS = 7 * MiB;
constexpr size_t WS_W = 9 * MiB;
constexpr size_t W_GU = 0;
constexpr size_t W_D8 = W_GU + (size_t)2 * 11264 * 2048;
constexpr size_t W_D = W_GU + (size_t)2 * 11264 * 2048 * 2;
constexpr size_t W_QK = W_D + (size_t)2 * 2048 * 5632 * 2;
constexpr size_t W_V = W_QK + (size_t)2304 * 2048 * 2;
constexpr size_t W_Z = W_V + (size_t)256 * 2048 * 2;
constexpr size_t W_O = W_Z + (size_t)1024 * 2048 * 2;
constexpr size_t W_LAYER = W_O + (size_t)2048 * 2048 * 2;
static_assert(W_LAYER == 154 * MiB, "weights per layer");
constexpr size_t WS_X = WS_W + 2 * W_LAYER;
constexpr size_t WS_Y = WS_X + 160 * MiB;
constexpr size_t WS_BIG = WS_Y + 160 * MiB;
constexpr size_t WS_Q = WS_BIG, WS_KB = WS_BIG + 80 * MiB, WS_VT = WS_BIG + 100 * MiB, WS_Z1 = WS_BIG + 120 * MiB, WS_Y2 = WS_BIG + 280 * MiB, WS_U = WS_Y2;
constexpr size_t WS_END = WS_BIG + 440 * MiB;
static_assert((size_t)M * DFF * 2 == 440 * MiB && (size_t)M * DM * 2 == 160 * MiB, "sizes");

constexpr int RING_BYTES = 131072;
constexpr int LDSCTL_OFF = 147456, MISC_OFF = LDSCTL_OFF + 320, SSQ_OFF = LDSCTL_OFF + 512;
constexpr int LDS_BYTES = 147456 + 2048;

#define LDS_WAIT() asm volatile("s_waitcnt lgkmcnt(0)" ::: "memory")
#define VM_WAIT() asm volatile("s_waitcnt vmcnt(0)" ::: "memory")
__device__ __forceinline__ unsigned f2bf(float f) { unsigned u = __builtin_bit_cast(unsigned, f); return (u + 0x7fffu + ((u >> 16) & 1u)) >> 16; }
__device__ __forceinline__ unsigned pk2(float lo, float hi) { return f2bf(lo) | (f2bf(hi) << 16); }
__device__ __forceinline__ float bflo(unsigned w) { return __builtin_bit_cast(float, w << 16); }
__device__ __forceinline__ float bfhi(unsigned w) { return __builtin_bit_cast(float, w & 0xffff0000u); }
__device__ __forceinline__ unsigned cvt_pk_bf16(float lo, float hi) { unsigned r; asm volatile("v_cvt_pk_bf16_f32 %0, %1, %2" : "=v"(r) : "v"(lo), "v"(hi)); return r; }

__device__ __forceinline__ int lane_fresh() { int l; asm volatile("v_mbcnt_lo_u32_b32 %0, -1, 0\n\tv_mbcnt_hi_u32_b32 %0, -1, %0" : "=v"(l)); return l; }
__device__ __forceinline__ size_t opaque_zero() { size_t z = 0; asm volatile("" : "+s"(z)); return z; }
namespace pg8 {
constexpr int BM = 256, BK = 64, HALF = 128, HTB = HALF * BK * 2, STAGE_BYTES = 8 * HTB, NXCD = 8, WGM = 4;
__host__ __device__ __forceinline__ int lds_byte(int r, int c) { const int st = (r >> 4) * 2 + (c >> 5), rr = r & 15, cc = c & 31, ob = rr * 64 + cc * 2; return st * 1024 + (ob ^ (((ob >> 9) & 1) << 5)); }
__host__ __device__ __forceinline__ void stage_rc(int b, int& R, int& C) { const int st = b / 1024, sb = b % 1024, swz = sb ^ (((sb >> 9) & 1) << 5); R = (st >> 1) * 16 + swz / 64; C = (st & 1) * 32 + (swz % 64) / 2; }
__host__ __device__ __forceinline__ int perm32(int rho) { const int n = rho >> 4, i = rho & 15; return 8 * (i >> 2) + 4 * n + (i & 3); }

struct Unit { int pm, pn; };
struct StaticOrder {
    int nM, nN, nwg, G, c;
    __device__ void init(int Mr, int Nc, int G_, int c_) { nM = Mr / BM; nN = Nc / BM; nwg = nM * nN; G = G_; c = c_; }
    __device__ bool next(int i, Unit& u) const {
        const long L = (long)i * G + c; if (L >= nwg) return false;
        int wgid = (int)L; { const int q = nwg / NXCD, r = nwg % NXCD, xcd = wgid % NXCD, off = wgid / NXCD; wgid = (xcd < r ? xcd * (q + 1) : r * (q + 1) + (xcd - r) * q) + off; }
        const int nig = WGM * nN, gid = wgid / nig, fm = gid * WGM, gsz = (nM - fm) < WGM ? (nM - fm) : WGM;
        u.pm = fm + ((wgid % nig) % gsz); u.pn = (wgid % nig) / gsz; return true;
    }
};

struct Col0Order {
    int G, c;
    __device__ bool next(int i, Unit& u) const { const long L = (long)i * G + c; if (L >= 160) return false; u.pm = (int)L; u.pn = 0; return true; }
};
struct ShiftOrder {
    StaticOrder S;
    __device__ bool next(int i, Unit& u) const { if (!S.next(i, u)) return false; u.pn += 1; return true; }
};

struct GeoPlain {
    const char* A; const char* B; int K;
    __device__ __forceinline__ int nt() const { return K / BK; }
    __device__ __forceinline__ const char* a_base(const Unit& u) const { return A + (size_t)u.pm * BM * K * 2; }
    __device__ __forceinline__ const char* b_base(const Unit& u) const { return B + (size_t)u.pn * BM * K * 2; }
    __device__ __forceinline__ unsigned a_off(int R, int C) const { return (unsigned)(R * K + C) * 2u; }
    __device__ __forceinline__ unsigned b_off(int R, int C) const { return (unsigned)(R * K + C) * 2u; }
    __device__ __forceinline__ size_t a_hstep() const { return (size_t)HALF * K * 2; }
    __device__ __forceinline__ size_t b_hstep() const { return (size_t)HALF * K * 2; }
    __device__ __forceinline__ size_t a_kstep() const { return BK * 2; }
    __device__ __forceinline__ size_t b_kstep() const { return BK * 2; }
};
struct GeoP1 {
    const char* A; const char* B;
    __device__ __forceinline__ int nt() const { return 2; }
    __device__ __forceinline__ const char* a_base(const Unit& u) const { return A + (size_t)u.pm * 256 * 128 * 2; }
    __device__ __forceinline__ const char* b_base(const Unit& u) const { return B + ((size_t)(u.pn >> 5) * SEQ + 4 * (u.pn & 31)) * 1024 * 2 + (size_t)u.pm * 128 * 2; }
    __device__ __forceinline__ unsigned a_off(int R, int C) const { return (unsigned)(R * 128 + C) * 2u; }
    __device__ __forceinline__ unsigned b_off(int R, int C) const { return (unsigned)((128 * (R & 63) + (R >> 6)) * 1024 + C) * 2u; }
    __device__ __forceinline__ size_t a_hstep() const { return (size_t)HALF * 128 * 2; }
    __device__ __forceinline__ size_t b_hstep() const { return (size_t)2 * 1024 * 2; }
    __device__ __forceinline__ size_t a_kstep() const { return BK * 2; }
    __device__ __forceinline__ size_t b_kstep() const { return BK * 2; }
};
struct GeoP2 {
    const char* A; const char* B;
    __device__ __forceinline__ int nt() const { return 2; }
    __device__ __forceinline__ const char* a_base(const Unit&) const { return A + opaque_zero(); }
    __device__ __forceinline__ const char* b_base(const Unit& u) const { const int ep = u.pn & 63, g = (u.pn >> 6) & 7, b = u.pn >> 9; return B + ((size_t)(g * 256 + 2 * ep) * M + (size_t)b * SEQ) * 2; }
    __device__ __forceinline__ unsigned a_off(int R, int C) const { return (unsigned)(R * 128 + C) * 2u; }
    __device__ __forceinline__ unsigned b_off(int R, int C) const { return (unsigned)(R * 64 + C) * 2u; }
    __device__ __forceinline__ size_t a_hstep() const { return (size_t)HALF * 128 * 2; }
    __device__ __forceinline__ size_t b_hstep() const { return (size_t)M * 2; }
    __device__ __forceinline__ size_t a_kstep() const { return BK * 2; }
    __device__ __forceinline__ size_t b_kstep() const { return (size_t)128 * M * 2; }
};

struct EpiSwiGLU8; template <bool FIRST> struct EpiSwiGLU8Q; struct EpiBf16S;
template <class E> struct AccT { using T = f32x4; static constexpr bool I8 = false; };
template <> struct AccT<EpiSwiGLU8> { using T = i32x4; static constexpr bool I8 = true; };
template <> struct AccT<EpiSwiGLU8Q<true>> { using T = i32x4; static constexpr bool I8 = true; };
template <> struct AccT<EpiSwiGLU8Q<false>> { using T = i32x4; static constexpr bool I8 = true; };
template <> struct AccT<EpiBf16S> { using T = i32x4; static constexpr bool I8 = true; };
template <class Epi, class Geo, class Ord>
__device__ __forceinline__ void gemm_phase(LAS unsigned char* lds, const int wid_in, const Geo geo, const Ord& S, const Epi& E) {
    int wid = wid_in; asm volatile("" : "+s"(wid));
    const int lane = lane_fresh(), tid = wid * 64 + lane, wr = wid >> 2, wc = wid & 3, fr = lane & 15, fq = lane >> 4;
    const int nt = geo.nt();
    unsigned voffA[2], voffB[2];
#pragma unroll
    for (int i = 0; i < 2; ++i) { int R, C; stage_rc(tid * 16 + i * 8192, R, C); const int Rb = (R & ~31) + perm32(R & 31);
        voffA[i] = geo.a_off(R, C); voffB[i] = geo.b_off(Rb, C); }
    const size_t kstepA = geo.a_kstep(), kstepB = geo.b_kstep(), hstepA = geo.a_hstep(), hstepB = geo.b_hstep();
    const unsigned ldsw = (unsigned)wid * 1024u;
    const int aoff = lds_byte(wr * 64 + fr, fq * 8), boff = lds_byte(wc * 32 + fr, fq * 8);
#define PG8_SA(b, h) (((b) * 2 + (h)) * HTB)
#define PG8_SB(b, h) ((4 + (b) * 2 + (h)) * HTB)
#define PG8_STAGE(bufoff, gbase, voff) do { _Pragma("unroll") for (int _i = 0; _i < 2; ++_i) \
        __builtin_amdgcn_global_load_lds((const unsigned*)((const char*)(gbase) + (voff)[_i]), (LAS unsigned*)(lds + (bufoff) + ldsw + _i * 8192), 16, 0, 0); } while (0)
#define PG8_LDA(dst, b, h) do { _Pragma("unroll") for (int m = 0; m < 4; ++m) _Pragma("unroll") for (int k = 0; k < 2; ++k) dst[m][k] = *(const LAS bf16x8*)(lds + PG8_SA(b, h) + aoff + m * 2048 + k * 1024); } while (0)
#define PG8_LDB(dst, b, h) do { _Pragma("unroll") for (int n = 0; n < 2; ++n) _Pragma("unroll") for (int k = 0; k < 2; ++k) dst[n][k] = *(const LAS bf16x8*)(lds + PG8_SB(b, h) + boff + n * 2048 + k * 1024); } while (0)
#define PG8_MMA(ai, bj, At, Bt) do { if constexpr ((ai) == 1 && Epi::SKIP_AI1) break; __builtin_amdgcn_s_setprio(1); _Pragma("unroll") for (int m = 0; m < 4; ++m) _Pragma("unroll") for (int n = 0; n < 2; ++n) _Pragma("unroll") for (int k = 0; k < 2; ++k) \
        { if constexpr (AccT<Epi>::I8) acc[ai][bj][m][n] = __builtin_amdgcn_mfma_i32_16x16x64_i8(__builtin_bit_cast(i32x4, Bt[n][k]), __builtin_bit_cast(i32x4, At[m][k]), acc[ai][bj][m][n], 0, 0, 0); \
          else acc[ai][bj][m][n] = __builtin_amdgcn_mfma_f32_16x16x32_bf16(Bt[n][k], At[m][k], acc[ai][bj][m][n], 0, 0, 0); } __builtin_amdgcn_s_setprio(0); } while (0)
#define PG8_WAIT_V(n) asm volatile("s_waitcnt vmcnt(" #n ")" ::: "memory")
#define PG8_WAIT_L(n) asm volatile("s_waitcnt lgkmcnt(" #n ")" ::: "memory")
#define PG8_BAR __builtin_amdgcn_s_barrier()
#define PG8_SCHED __builtin_amdgcn_sched_barrier(0)
    Unit cur, nxt; int ui = 0;
    if (!S.next(0, cur)) return;
    typedef typename AccT<Epi>::T acc_t;
    acc_t acc[2][2][4][2];
#pragma unroll
    for (int a = 0; a < 2; ++a)
#pragma unroll
        for (int b = 0; b < 2; ++b)
#pragma unroll
            for (int m = 0; m < 4; ++m)
#pragma unroll
                for (int n = 0; n < 2; ++n) acc[a][b][m][n] = (acc_t){0, 0, 0, 0};
    bf16x8 At[4][2], B0[2][2], B1[2][2];
    const char* cA = geo.a_base(cur); const char* cB = geo.b_base(cur);
    PG8_STAGE(PG8_SB(0, 0), cB, voffB); PG8_STAGE(PG8_SB(0, 1), cB + hstepB, voffB); PG8_STAGE(PG8_SA(0, 0), cA, voffA); PG8_STAGE(PG8_SA(0, 1), cA + hstepA, voffA);
    if (wr == 1) PG8_BAR;
    PG8_WAIT_V(2); PG8_BAR;
    PG8_STAGE(PG8_SB(1, 0), cB + kstepB, voffB); PG8_STAGE(PG8_SA(1, 0), cA + kstepA, voffA); PG8_STAGE(PG8_SB(1, 1), cB + hstepB + kstepB, voffB);
    PG8_WAIT_V(6); PG8_BAR;
    for (;;) {
        const bool has_next = S.next(ui + 1, nxt);
        const char* nA = has_next ? geo.a_base(nxt) : cA; const char* nB = has_next ? geo.b_base(nxt) : cB;
        for (int t = 0; t < nt; t += 2) {
            const bool last = (t == nt - 2);
            const char* a1 = cA + (size_t)(t + 1) * kstepA;
            const char* a2 = last ? nA : cA + (size_t)(t + 2) * kstepA; const char* b2 = last ? nB : cB + (size_t)(t + 2) * kstepB;
            const char* a3 = a2 + kstepA; const char* b3 = b2 + kstepB;
            PG8_LDB(B0, 0, 0); PG8_LDB(B1, 0, 1); PG8_SCHED; PG8_LDA(At, 0, 0); PG8_STAGE(PG8_SA(1, 1), a1 + hstepA, voffA);
            PG8_WAIT_V(8); PG8_WAIT_L(0); PG8_BAR; PG8_MMA(0, 0, At, B0); PG8_MMA(0, 1, At, B1); PG8_BAR; PG8_SCHED;
            PG8_LDA(At, 0, 1); PG8_STAGE(PG8_SB(0, 0), b2, voffB); PG8_STAGE(PG8_SB(0, 1), b2 + hstepB, voffB); PG8_STAGE(PG8_SA(0, 0), a2, voffA);
            PG8_WAIT_V(8); PG8_WAIT_L(0); PG8_BAR; PG8_MMA(1, 0, At, B0); PG8_MMA(1, 1, At, B1); PG8_BAR; PG8_SCHED;
            PG8_LDB(B0, 1, 0); PG8_LDB(B1, 1, 1); PG8_SCHED; PG8_LDA(At, 1, 0); PG8_STAGE(PG8_SA(0, 1), a2 + hstepA, voffA);
            PG8_WAIT_V(8); PG8_WAIT_L(0); PG8_BAR; PG8_MMA(0, 0, At, B0); PG8_MMA(0, 1, At, B1); PG8_BAR; PG8_SCHED;
            PG8_LDA(At, 1, 1); PG8_STAGE(PG8_SB(1, 0), b3, voffB); PG8_STAGE(PG8_SB(1, 1), b3 + hstepB, voffB); PG8_STAGE(PG8_SA(1, 0), a3, voffA);
            PG8_WAIT_V(8); PG8_WAIT_L(0); PG8_BAR; PG8_MMA(1, 0, At, B0); PG8_MMA(1, 1, At, B1); PG8_BAR; PG8_SCHED;
        }
        if (wr == 0) PG8_BAR;
        { const int le = lane_fresh(); E(acc, cur, wr, wc, le & 15, le >> 4); }
        if (!has_next) break;
#pragma unroll
        for (int a = 0; a < 2; ++a)
#pragma unroll
            for (int b = 0; b < 2; ++b)
#pragma unroll
                for (int m = 0; m < 4; ++m)
#pragma unroll
                    for (int n = 0; n < 2; ++n) acc[a][b][m][n] = (acc_t){0, 0, 0, 0};
        cur = nxt; cA = nA; cB = nB; ++ui;
        if (wr == 1) PG8_BAR;
    }
    PG8_WAIT_V(0);
    PG8_BAR;
#undef PG8_SA
#undef PG8_SB
#undef PG8_STAGE
#undef PG8_LDA
#undef PG8_LDB
#undef PG8_MMA
#undef PG8_WAIT_V
#undef PG8_WAIT_L
#undef PG8_BAR
#undef PG8_SCHED
}

struct EpiBf16 {
    static constexpr bool SKIP_AI1 = false;
    bf16* O; size_t ldc;
    __device__ __forceinline__ void operator()(const f32x4 (&acc)[2][2][4][2], const Unit& u, int wr, int wc, int fr, int fq) const {
        const int row0 = u.pm * BM + wr * 64 + fr, col0 = u.pn * BM + wc * 32 + 8 * fq;
#pragma unroll
        for (int ai = 0; ai < 2; ++ai)
#pragma unroll
            for (int m = 0; m < 4; ++m) { bf16* rowp = O + (size_t)(row0 + ai * HALF + m * 16) * ldc + col0;
#pragma unroll
                for (int bj = 0; bj < 2; ++bj) { const f32x4 v0 = acc[ai][bj][m][0], v1 = acc[ai][bj][m][1];
                    u32x4 w; w.x = cvt_pk_bf16(v0[0], v0[1]); w.y = cvt_pk_bf16(v0[2], v0[3]); w.z = cvt_pk_bf16(v1[0], v1[1]); w.w = cvt_pk_bf16(v1[2], v1[3]);
                    *(u32x4*)(rowp + bj * HALF) = w; } }
    }
};
__device__ __forceinline__ float silu_mul(float g, float u) { return g * u * __builtin_amdgcn_rcpf(1.0f + __expf(-g)); }
struct EpiSwiGLU {
    static constexpr bool SKIP_AI1 = false;
    bf16* O;
    __device__ __forceinline__ void operator()(const f32x4 (&acc)[2][2][4][2], const Unit& u, int wr, int wc, int fr, int fq) const {
        const int row0 = u.pm * BM + wr * 64 + fr, col0 = u.pn * HALF + wc * 32 + 8 * fq;
#pragma unroll
        for (int ai = 0; ai < 2; ++ai)
#pragma unroll
            for (int m = 0; m < 4; ++m) { bf16* rowp = O + (size_t)(row0 + ai * HALF + m * 16) * DFF + col0;
                const f32x4 g0 = acc[ai][0][m][0], g1 = acc[ai][0][m][1], u0 = acc[ai][1][m][0], u1 = acc[ai][1][m][1];
                u32x4 w; w.x = cvt_pk_bf16(silu_mul(g0[0], u0[0]), silu_mul(g0[1], u0[1])); w.y = cvt_pk_bf16(silu_mul(g0[2], u0[2]), silu_mul(g0[3], u0[3]));
                w.z = cvt_pk_bf16(silu_mul(g1[0], u1[0]), silu_mul(g1[1], u1[1])); w.w = cvt_pk_bf16(silu_mul(g1[2], u1[2]), silu_mul(g1[3], u1[3]));
                *(u32x4*)rowp = w; }
    }
};
struct EpiSwiGLU8 {
    static constexpr bool SKIP_AI1 = false;
    bf16* O; const float* SA; const unsigned* AM;
    __device__ __forceinline__ void operator()(const i32x4 (&acc)[2][2][4][2], const Unit& u, int wr, int wc, int fr, int fq) const {
        const int row0 = u.pm * BM + wr * 64 + fr, col0 = u.pn * HALF + wc * 32 + 8 * fq, cw = u.pn * BM + wc * 32 + 8 * fq;
        f32x4 sg[2], su[2]; float sa[2][4];
#pragma unroll
        for (int n = 0; n < 2; ++n) { sg[n] = __builtin_bit_cast(f32x4, *(const u32x4*)(AM + cw + 4 * n)); su[n] = __builtin_bit_cast(f32x4, *(const u32x4*)(AM + cw + HALF + 4 * n)); }
#pragma unroll
        for (int ai = 0; ai < 2; ++ai)
#pragma unroll
            for (int m = 0; m < 4; ++m) sa[ai][m] = SA[row0 + ai * HALF + m * 16];
#pragma unroll
        for (int n = 0; n < 2; ++n) { sg[n] *= (1.0f / 127.0f); su[n] *= (1.0f / 127.0f); }
#pragma unroll
        for (int ai = 0; ai < 2; ++ai)
#pragma unroll
            for (int m = 0; m < 4; ++m) { bf16* rowp = O + (size_t)(row0 + ai * HALF + m * 16) * DFF + col0; const float s = sa[ai][m];
                const f32x4 g0 = __builtin_convertvector(acc[ai][0][m][0], f32x4) * (sg[0] * s), g1 = __builtin_convertvector(acc[ai][0][m][1], f32x4) * (sg[1] * s);
                const f32x4 u0 = __builtin_convertvector(acc[ai][1][m][0], f32x4) * (su[0] * s), u1 = __builtin_convertvector(acc[ai][1][m][1], f32x4) * (su[1] * s);
                u32x4 w; w.x = cvt_pk_bf16(silu_mul(g0[0], u0[0]), silu_mul(g0[1], u0[1])); w.y = cvt_pk_bf16(silu_mul(g0[2], u0[2]), silu_mul(g0[3], u0[3]));
                w.z = cvt_pk_bf16(silu_mul(g1[0], u1[0]), silu_mul(g1[1], u1[1])); w.w = cvt_pk_bf16(silu_mul(g1[2], u1[2]), silu_mul(g1[3], u1[3]));
                *(u32x4*)rowp = w; }
    }
};
__device__ __forceinline__ float xlane(float v, int mask, int lane) { return __builtin_bit_cast(float, __builtin_amdgcn_ds_bpermute((lane ^ mask) << 2, __builtin_bit_cast(int, v))); }
__device__ __forceinline__ unsigned q8c_pack(float a, float b, float c, float d, float inv) {
    const unsigned ua = __float_as_uint(__builtin_amdgcn_fmed3f(a * inv, -127.0f, 127.0f) + 12582912.0f), ub = __float_as_uint(__builtin_amdgcn_fmed3f(b * inv, -127.0f, 127.0f) + 12582912.0f);
    const unsigned uc = __float_as_uint(__builtin_amdgcn_fmed3f(c * inv, -127.0f, 127.0f) + 12582912.0f), ud = __float_as_uint(__builtin_amdgcn_fmed3f(d * inv, -127.0f, 127.0f) + 12582912.0f);
    return __builtin_amdgcn_perm(__builtin_amdgcn_perm(ud, uc, 0x0c0c0400u), __builtin_amdgcn_perm(ub, ua, 0x0c0c0400u), 0x05040100u);
}
constexpr float Q2_CLIP = 6.0f;
template <bool FIRST>
struct EpiSwiGLU8Q {
    static constexpr bool SKIP_AI1 = false;
    unsigned char* O8; const float* SA; const unsigned* AM; float* S2; LAS float* xl;
    __device__ __forceinline__ void row8(float (&h)[8], const i32x4& ag0, const i32x4& ag1, const i32x4& au0, const i32x4& au1, const f32x4 (&sg)[2], const f32x4 (&su)[2], float s, int lane) const {
        const f32x4 g0 = __builtin_convertvector(ag0, f32x4) * (sg[0] * s), g1 = __builtin_convertvector(ag1, f32x4) * (sg[1] * s);
        const f32x4 u0 = __builtin_convertvector(au0, f32x4) * (su[0] * s), u1 = __builtin_convertvector(au1, f32x4) * (su[1] * s);
        h[0] = silu_mul(g0[0], u0[0]); h[1] = silu_mul(g0[1], u0[1]); h[2] = silu_mul(g0[2], u0[2]); h[3] = silu_mul(g0[3], u0[3]);
        h[4] = silu_mul(g1[0], u1[0]); h[5] = silu_mul(g1[1], u1[1]); h[6] = silu_mul(g1[2], u1[2]); h[7] = silu_mul(g1[3], u1[3]);
#pragma unroll
        for (int st = 1; st < 8; st <<= 1)
#pragma unroll
            for (int j = 0; j < 8; ++j) if ((j & st) == 0) { const float a = h[j], b = h[j | st]; h[j] = a + b; h[j | st] = a - b; }
#pragma unroll
        for (int j = 0; j < 8; j += 2) {
            const auto r = __builtin_amdgcn_permlane16_swap(__float_as_uint(h[j]), __float_as_uint(h[j + 1]), false, false);
            const float a = __uint_as_float(r[0]), b = __uint_as_float(r[1]);
            const auto q = __builtin_amdgcn_permlane16_swap(__float_as_uint(a + b), __float_as_uint(a - b), false, false);
            h[j] = __uint_as_float(q[0]); h[j + 1] = __uint_as_float(q[1]); }
#pragma unroll
        for (int j = 0; j < 8; j += 2) {
            const auto r = __builtin_amdgcn_permlane32_swap(__float_as_uint(h[j]), __float_as_uint(h[j + 1]), false, false);
            const float a = __uint_as_float(r[0]), b = __uint_as_float(r[1]);
            const auto q = __builtin_amdgcn_permlane32_swap(__float_as_uint(a + b), __float_as_uint(a - b), false, false);
            h[j] = __uint_as_float(q[0]); h[j + 1] = __uint_as_float(q[1]); }
    }
    __device__ __forceinline__ void operator()(const i32x4 (&acc)[2][2][4][2], const Unit& u, int wr, int wc, int fr, int fq) const {
        const int lane = fr + 16 * fq;
        const int row0 = u.pm * BM + wr * 64 + fr, col0 = u.pn * HALF + wc * 32 + 8 * fq, cw = u.pn * BM + wc * 32 + 8 * fq;
        f32x4 sg[2], su[2]; float sa[2][4], inv[2][4];
#pragma unroll
        for (int n = 0; n < 2; ++n) { sg[n] = __builtin_bit_cast(f32x4, *(const u32x4*)(AM + cw + 4 * n)); su[n] = __builtin_bit_cast(f32x4, *(const u32x4*)(AM + cw + HALF + 4 * n)); }
#pragma unroll
        for (int ai = 0; ai < 2; ++ai)
#pragma unroll
            for (int m = 0; m < 4; ++m) { sa[ai][m] = SA[row0 + ai * HALF + m * 16]; if constexpr (!FIRST) inv[ai][m] = S2[row0 + ai * HALF + m * 16]; }
#pragma unroll
        for (int n = 0; n < 2; ++n) { sg[n] *= (1.0f / 127.0f); su[n] *= (1.0f / 127.0f); }
        if constexpr (FIRST) {
#pragma unroll
            for (int ai = 0; ai < 2; ++ai)
#pragma unroll
                for (int m = 0; m < 4; ++m) { float h[8]; row8(h, acc[ai][0][m][0], acc[ai][0][m][1], acc[ai][1][m][0], acc[ai][1][m][1], sg, su, sa[ai][m], lane);
                    float ss = (h[0] * h[0] + h[1] * h[1]) + (h[2] * h[2] + h[3] * h[3]) + (h[4] * h[4] + h[5] * h[5]) + (h[6] * h[6] + h[7] * h[7]);
                    ss += xlane(ss, 16, lane); ss += xlane(ss, 32, lane);
                    if (fq == 0) xl[(ai * HALF + wr * 64 + m * 16 + fr) * 4 + wc] = ss; }
            asm volatile("s_waitcnt lgkmcnt(0)" ::: "memory"); __builtin_amdgcn_s_barrier();
#pragma unroll
            for (int ai = 0; ai < 2; ++ai)
#pragma unroll
                for (int m = 0; m < 4; ++m) { const f32x4 t = *(const LAS f32x4*)(xl + (ai * HALF + wr * 64 + m * 16 + fr) * 4);
                    const float sc = Q2_CLIP * (1.0f / 127.0f) * sqrtf(((t[0] + t[1]) + (t[2] + t[3])) * (1.0f / 128.0f));
                    inv[ai][m] = sc; if (wc == 0 && fq == 0) S2[row0 + ai * HALF + m * 16] = sc; }
        }
#pragma unroll
        for (int ai = 0; ai < 2; ++ai)
#pragma unroll
            for (int m = 0; m < 4; ++m) { float h[8]; row8(h, acc[ai][0][m][0], acc[ai][0][m][1], acc[ai][1][m][0], acc[ai][1][m][1], sg, su, sa[ai][m], lane);
                const float iv = inv[ai][m] > 0.f ? __builtin_amdgcn_rcpf(inv[ai][m]) : 0.f;
                u32x2 w; w.x = q8c_pack(h[0], h[1], h[2], h[3], iv); w.y = q8c_pack(h[4], h[5], h[6], h[7], iv);
                *(u32x2*)(O8 + (size_t)(row0 + ai * HALF + m * 16) * DFF + col0) = w; }
    }
};
struct EpiBf16S {
    static constexpr bool SKIP_AI1 = false;
    bf16* O; const float* S2; const unsigned* AMD;
    __device__ __forceinline__ void operator()(const i32x4 (&acc)[2][2][4][2], const Unit& u, int wr, int wc, int fr, int fq) const {
        const int row0 = u.pm * BM + wr * 64 + fr, col0 = u.pn * BM + wc * 32 + 8 * fq;
        f32x4 sw[2][2]; float sr[2][4];
#pragma unroll
        for (int bj = 0; bj < 2; ++bj)
#pragma unroll
            for (int n = 0; n < 2; ++n) sw[bj][n] = __builtin_bit_cast(f32x4, *(const u32x4*)(AMD + col0 + bj * HALF + 4 * n));
#pragma unroll
        for (int ai = 0; ai < 2; ++ai)
#pragma unroll
            for (int m = 0; m < 4; ++m) sr[ai][m] = S2[row0 + ai * HALF + m * 16];
#pragma unroll
        for (int bj = 0; bj < 2; ++bj)
#pragma unroll
            for (int n = 0; n < 2; ++n) sw[bj][n] *= (1.0f / (127.0f * 32.0f));
#pragma unroll
        for (int ai = 0; ai < 2; ++ai)
#pragma unroll
            for (int m = 0; m < 4; ++m) { bf16* rowp = O + (size_t)(row0 + ai * HALF + m * 16) * DM + col0; const float s = sr[ai][m];
#pragma unroll
                for (int bj = 0; bj < 2; ++bj) { const f32x4 v0 = __builtin_convertvector(acc[ai][bj][m][0], f32x4) * (sw[bj][0] * s), v1 = __builtin_convertvector(acc[ai][bj][m][1], f32x4) * (sw[bj][1] * s);
                    u32x4 w; w.x = cvt_pk_bf16(v0[0], v0[1]); w.y = cvt_pk_bf16(v0[2], v0[3]); w.z = cvt_pk_bf16(v1[0], v1[1]); w.w = cvt_pk_bf16(v1[2], v1[3]);
                    *(u32x4*)(rowp + bj * HALF) = w; } }
    }
};
struct EpiRope {
    static constexpr bool SKIP_AI1 = false;
    static constexpr bool HOOK = false;
    bf16* Q; bf16* KB; const float* COS; const float* SIN; bf16* U;
    __device__ __forceinline__ void operator()(const f32x4 (&acc)[2][2][4][2], const Unit& u, int wr, int wc, int fr, int fq) const {
        if (u.pn >= 5) {
            const int row0u = u.pm * BM + wr * 64 + fr, col0 = (u.pn - 5) * BM + wc * 32 + 8 * fq;
#pragma unroll
            for (int ai = 0; ai < 2; ++ai)
#pragma unroll
                for (int m = 0; m < 4; ++m) { bf16* rowp = U + (size_t)(row0u + ai * HALF + m * 16) * 1024 + col0;
#pragma unroll
                    for (int bj = 0; bj < 2; ++bj) { const f32x4 v0 = acc[ai][bj][m][0], v1 = acc[ai][bj][m][1];
                        u32x4 w; w.x = cvt_pk_bf16(v0[0], v0[1]); w.y = cvt_pk_bf16(v0[2], v0[3]); w.z = cvt_pk_bf16(v1[0], v1[1]); w.w = cvt_pk_bf16(v1[2], v1[3]);
                        *(u32x4*)(rowp + bj * HALF) = w; } }
            return;
        }
        const int row0 = u.pm * BM + wr * 64 + fr, hsel = wc >> 1, d0 = 32 * (wc & 1) + 8 * fq;
        const bool isq = u.pn < 4; const float sc = isq ? QSCALE : 1.0f;
        bf16* base = isq ? Q + (2 * u.pn + hsel) * 128 + d0 : KB + hsel * 128 + d0; const size_t ld = isq ? NQ : NKV;
#pragma unroll
        for (int ai = 0; ai < 2; ++ai) {
            f32x4 c0[4], c1[4], s0[4], s1[4];
#pragma unroll
            for (int m = 0; m < 4; ++m) { const int pos = (row0 + ai * HALF + m * 16) & (SEQ - 1);
                c0[m] = *(const f32x4*)(COS + pos * 64 + d0); c1[m] = *(const f32x4*)(COS + pos * 64 + d0 + 4); s0[m] = *(const f32x4*)(SIN + pos * 64 + d0); s1[m] = *(const f32x4*)(SIN + pos * 64 + d0 + 4); }
            u32x4 w1[4], w2[4];
#pragma unroll
            for (int m = 0; m < 4; ++m) {
                const f32x4 a0 = acc[ai][0][m][0], a1 = acc[ai][0][m][1], b0 = acc[ai][1][m][0], b1 = acc[ai][1][m][1];
                const f32x4 o10 = (a0 * c0[m] - b0 * s0[m]) * sc, o11 = (a1 * c1[m] - b1 * s1[m]) * sc, o20 = (a0 * s0[m] + b0 * c0[m]) * sc, o21 = (a1 * s1[m] + b1 * c1[m]) * sc;
                w1[m].x = cvt_pk_bf16(o10[0], o10[1]); w1[m].y = cvt_pk_bf16(o10[2], o10[3]); w1[m].z = cvt_pk_bf16(o11[0], o11[1]); w1[m].w = cvt_pk_bf16(o11[2], o11[3]);
                w2[m].x = cvt_pk_bf16(o20[0], o20[1]); w2[m].y = cvt_pk_bf16(o20[2], o20[3]); w2[m].z = cvt_pk_bf16(o21[0], o21[1]); w2[m].w = cvt_pk_bf16(o21[2], o21[3]); }
#pragma unroll
            for (int m = 0; m < 4; ++m) { bf16* rp = base + (size_t)(row0 + ai * HALF + m * 16) * ld; *(u32x4*)rp = w1[m]; *(u32x4*)(rp + 64) = w2[m]; }
        }
    }
};
struct EpiTwiddle {
    static constexpr bool SKIP_AI1 = false;
    bf16* Y2;
    __device__ __forceinline__ void operator()(const f32x4 (&acc)[2][2][4][2], const Unit& u, int wr, int wc, int fr, int fq) const {
        if (wr != 0) return;
        int zz = 0; asm volatile("" : "+v"(zz));
        const int ep = u.pn & 63, g = (u.pn >> 6) & 7, b = u.pn >> 9, s20 = wc * 32 + 8 * fq + zz;
#pragma unroll
        for (int m = 0; m < 4; ++m) { const int k1 = 16 * m + fr;
#pragma unroll
            for (int bj = 0; bj < 2; ++bj) { const int e = 2 * ep + bj; bf16* rp = Y2 + ((size_t)((b * 64 + k1) * 8 + g) * 128 + e) * 256 + s20;
                float re[8], im[8];
#pragma unroll
                for (int n = 0; n < 2; ++n)
#pragma unroll
                    for (int i = 0; i < 4; ++i) { const int s2 = s20 + 4 * n + i; const float fr_ = (float)((k1 * s2) & 8191) * (1.0f / 8192.0f);
                        const float ct = __builtin_amdgcn_cosf(fr_), st = __builtin_amdgcn_sinf(fr_); const float yr = acc[0][bj][m][n][i], yi = acc[1][bj][m][n][i];
                        re[4 * n + i] = yr * ct + yi * st; im[4 * n + i] = yi * ct - yr * st; }
                u32x4 w1, w2; w1.x = cvt_pk_bf16(re[0], re[1]); w1.y = cvt_pk_bf16(re[2], re[3]); w1.z = cvt_pk_bf16(re[4], re[5]); w1.w = cvt_pk_bf16(re[6], re[7]);
                w2.x = cvt_pk_bf16(im[0], im[1]); w2.y = cvt_pk_bf16(im[2], im[3]); w2.z = cvt_pk_bf16(im[4], im[5]); w2.w = cvt_pk_bf16(im[6], im[7]);
                *(u32x4*)rp = w1; *(u32x4*)(rp + 128) = w2; } }
    }
};
struct EpiDftOut {
    static constexpr bool SKIP_AI1 = true;
    bf16* MIX;
    __device__ __forceinline__ void operator()(const f32x4 (&acc)[2][2][4][2], const Unit& u, int wr, int wc, int fr, int fq) const {
        const int gp = u.pn & 3, k1 = (u.pn >> 2) & 63, b = u.pn >> 8;
#pragma unroll
        for (int m = 0; m < 4; ++m) { const int k2 = 64 * wr + 16 * m + fr; bf16* rp = MIX + (size_t)(b * SEQ + k1 + 64 * k2) * DM + 1024 + gp * 256 + wc * 32 + 8 * fq;
#pragma unroll
            for (int bj = 0; bj < 2; ++bj) { const f32x4 v0 = acc[0][bj][m][0], v1 = acc[0][bj][m][1];
                u32x4 w; w.x = cvt_pk_bf16(v0[0], v0[1]); w.y = cvt_pk_bf16(v0[2], v0[3]); w.z = cvt_pk_bf16(v1[0], v1[1]); w.w = cvt_pk_bf16(v1[2], v1[3]);
                *(u32x4*)(rp + bj * 128) = w; } }
    }
};
}

#define XB_TMO      128
#define XB_XCNT(j)  (256  + 64 * (j))
#define XB_XSUB(j)  (1280 + 64 * (j))
#define XB_XGEN(j)  (2304 + 64 * (j))
#define XB_TOP      3328
#define XB_TOPGEN   3392
#define XCD_BAR_WORDS 3456
#define XB_SPIN_CAP (1u << 18)
__device__ __forceinline__ unsigned xb_ld(unsigned* p)              { return __hip_atomic_load(p, __ATOMIC_RELAXED, __HIP_MEMORY_SCOPE_AGENT); }
__device__ __forceinline__ unsigned xb_add(unsigned* p, unsigned v) { return __hip_atomic_fetch_add(p, v, __ATOMIC_RELAXED, __HIP_MEMORY_SCOPE_AGENT); }
__device__ __forceinline__ unsigned xb_xcc_id() { return (unsigned)__builtin_amdgcn_s_getreg((3 << 11) | 20) & 0xFu; }
#define XB_SPIN(cond, bar) do { unsigned _sp = 0; while (cond) { __builtin_amdgcn_s_sleep(1); \
    if ((++_sp & 255u) == 0u) { if (xb_ld(&(bar)[XB_TMO])) break; if (_sp > XB_SPIN_CAP) { atomicAdd(&(bar)[XB_TMO], 1u); break; } } } } while (0)
struct XcdBarrier { unsigned* bar; unsigned x; volatile LAS unsigned* st; };
__device__ __forceinline__ XcdBarrier xcd_barrier_post(unsigned* bar, volatile LAS unsigned* st) {
    XcdBarrier b; b.bar = bar; b.x = xb_xcc_id(); b.st = st;
    if (threadIdx.x == 0) (void)xb_add(&bar[XB_XCNT(b.x)], 1u);
    return b;
}
__device__ __forceinline__ void xcd_barrier_complete(unsigned* bar, unsigned x, unsigned& nloc, unsigned& nx) {
    const unsigned G = gridDim.x * gridDim.y * gridDim.z;
    unsigned sum, cnt, mine, sp = 0u;
    for (;;) {
        sum = 0u; cnt = 0u; mine = 0u;
#pragma unroll
        for (unsigned j = 0; j < 16; ++j) { const unsigned c = xb_ld(&bar[XB_XCNT(j)]); sum += c; cnt += (c > 0u) ? 1u : 0u; mine = (j == x) ? c : mine; }
        if (sum == G) break;
        __builtin_amdgcn_s_sleep(1);
        if ((++sp & 255u) == 0u) { if (xb_ld(&bar[XB_TMO])) break; if (sp > XB_SPIN_CAP) { atomicAdd(&bar[XB_TMO], 1u); break; } }
    }
    nloc = mine > 0u ? mine : 1u; nx = cnt > 0u ? cnt : 1u;
}
__device__ __forceinline__ void xcd_barrier(const XcdBarrier& b, const bool leader) {
    asm volatile("s_waitcnt vmcnt(0)" ::: "memory");
    __syncthreads();
    if (leader) {
        unsigned* bar = b.bar;
        __builtin_amdgcn_s_waitcnt(0);
        unsigned nloc = b.st[0], nx = b.st[1];
        if (nloc == 0u) { xcd_barrier_complete(bar, b.x, nloc, nx); b.st[0] = nloc; b.st[1] = nx; }
        const unsigned old = xb_add(&bar[XB_XSUB(b.x)], 1u);
        const unsigned gen = old / nloc;
        if (old + 1u == (gen + 1u) * nloc) {
            __builtin_amdgcn_fence(__ATOMIC_RELEASE, "agent");
            asm volatile("s_waitcnt vmcnt(0)" ::: "memory");
            const unsigned og = xb_add(&bar[XB_TOP], 1u);
            const unsigned tg = og / nx;
            if (og + 1u == (tg + 1u) * nx) xb_add(&bar[XB_TOPGEN], 1u);
            else XB_SPIN(xb_ld(&bar[XB_TOPGEN]) == tg, bar);
            __builtin_amdgcn_fence(__ATOMIC_ACQUIRE, "agent");
            xb_add(&bar[XB_XGEN(b.x)], 1u);
            asm volatile("s_waitcnt vmcnt(0)" ::: "memory");
        } else {
            XB_SPIN(xb_ld(&bar[XB_XGEN(b.x)]) == gen, bar);
            __builtin_amdgcn_fence(__ATOMIC_ACQUIRE, "agent");
            asm volatile("s_waitcnt vmcnt(0)" ::: "memory");
        }
    }
    __syncthreads();
}

struct Args { const float* in[16]; float* out; unsigned char* ws; };
struct Frame {
    LAS unsigned char* lds; int tid, lane, wave, G, bid;
    const float *x_prompt, *x_sample, *c_prompt, *c_sample, *w_mod, *b_mod, *pre_g, *post_g, *w_gate, *w_up, *w_down, *w_in, *sink, *four_w, *branch_g, *w_out;
    bf16* XB; bf16* HB; float* OUT; unsigned char* ws;
};
__device__ __forceinline__ float shfl_xor_l(float v, int mask, int lane) { return __builtin_bit_cast(float, __builtin_amdgcn_ds_bpermute((lane ^ mask) << 2, __builtin_bit_cast(int, v))); }
__device__ __forceinline__ float wave_sum(float v, int lane) {
#pragma unroll
    for (int o = 1; o < 64; o <<= 1) v += shfl_xor_l(v, o, lane);
    return v;
}

__device__ __forceinline__ float wave_max(float v, int lane) {
#pragma unroll
    for (int o = 1; o < 64; o <<= 1) v = fmaxf(v, shfl_xor_l(v, o, lane));
    return v;
}
__device__ __forceinline__ unsigned q8_pack(float a, float b, float c, float d, float inv) {
    const unsigned ua = __float_as_uint(fmaf(a, inv, 12582912.0f)), ub = __float_as_uint(fmaf(b, inv, 12582912.0f)), uc = __float_as_uint(fmaf(c, inv, 12582912.0f)), ud = __float_as_uint(fmaf(d, inv, 12582912.0f));
    return __builtin_amdgcn_perm(__builtin_amdgcn_perm(ud, uc, 0x0c0c0400u), __builtin_amdgcn_perm(ub, ua, 0x0c0c0400u), 0x05040100u);
}

__device__ __forceinline__ void transpose_item(const float* W, size_t ldw, int K, bf16* WT, int dest_row0, int k0, int n0, LAS float* scr, int lane, unsigned* AMD = nullptr) {
#pragma unroll 8
    for (int i = 0; i < 32; ++i) { const int kk = 2 * i + (lane >> 5); scr[kk * 33 + (lane & 31)] = W[(size_t)(k0 + kk) * ldw + n0 + (lane & 31)]; }
    LDS_WAIT(); asm volatile("" ::: "memory");
    if (AMD) {
        LAS float* t = scr + (32 * (lane >> 5)) * 33 + (lane & 31);
        float v[32];
#pragma unroll
        for (int j = 0; j < 32; ++j) v[j] = t[j * 33];
#pragma unroll
        for (int st = 1; st < 32; st <<= 1)
#pragma unroll
            for (int j = 0; j < 32; ++j) if ((j & st) == 0) { const float a = v[j], b = v[j | st]; v[j] = a + b; v[j | st] = a - b; }
        float mx = 0.f;
#pragma unroll
        for (int j = 0; j < 32; ++j) { t[j * 33] = v[j]; mx = fmaxf(mx, fabsf(v[j])); }
        mx = fmaxf(mx, shfl_xor_l(mx, 32, lane));
        if (lane < 32) atomicMax(AMD + dest_row0 + lane, __float_as_uint(mx));
        LDS_WAIT(); asm volatile("" ::: "memory");
    }
    const int c = lane & 7;
#pragma unroll
    for (int j = 0; j < 4; ++j) { const int n = (lane >> 3) + 8 * j; const LAS float* s = scr + (8 * c) * 33 + n;
        u32x4 o; o.x = pk2(s[0 * 33], s[1 * 33]); o.y = pk2(s[2 * 33], s[3 * 33]); o.z = pk2(s[4 * 33], s[5 * 33]); o.w = pk2(s[6 * 33], s[7 * 33]);
        *(GAS u32x4*)(WT + (size_t)(dest_row0 + n) * K + k0 + 8 * c) = o; }
    LDS_WAIT(); asm volatile("" ::: "memory");
}
__device__ __forceinline__ void quant_item(const float* W, const unsigned* AM, unsigned char* W8T, int dest_row0, int k0, int n0, LAS float* scr, int lane) {
#pragma unroll 8
    for (int i = 0; i < 32; ++i) { const int kk = 2 * i + (lane >> 5); scr[kk * 33 + (lane & 31)] = W[(size_t)(k0 + kk) * DFF + n0 + (lane & 31)]; }
    const int n = lane >> 1, hf = lane & 1;
    const float am = __uint_as_float(AM[dest_row0 + n]), inv = am > 0.f ? 127.0f / am : 0.f;
    LDS_WAIT(); asm volatile("" ::: "memory");
    const LAS float* t = scr + (32 * hf) * 33 + n;
    u32x4 o0, o1;
    o0.x = q8_pack(t[0 * 33], t[1 * 33], t[2 * 33], t[3 * 33], inv);     o0.y = q8_pack(t[4 * 33], t[5 * 33], t[6 * 33], t[7 * 33], inv);
    o0.z = q8_pack(t[8 * 33], t[9 * 33], t[10 * 33], t[11 * 33], inv);   o0.w = q8_pack(t[12 * 33], t[13 * 33], t[14 * 33], t[15 * 33], inv);
    o1.x = q8_pack(t[16 * 33], t[17 * 33], t[18 * 33], t[19 * 33], inv); o1.y = q8_pack(t[20 * 33], t[21 * 33], t[22 * 33], t[23 * 33], inv);
    o1.z = q8_pack(t[24 * 33], t[25 * 33], t[26 * 33], t[27 * 33], inv); o1.w = q8_pack(t[28 * 33], t[29 * 33], t[30 * 33], t[31 * 33], inv);
    GAS unsigned char* dst = (GAS unsigned char*)(W8T + (size_t)(dest_row0 + n) * DM + k0 + 32 * hf);
    *(GAS u32x4*)dst = o0; *(GAS u32x4*)(dst + 16) = o1;
    LDS_WAIT(); asm volatile("" ::: "memory");
}
__device__ __forceinline__ bf16* wptr(Frame& F, int l, size_t off) { return (bf16*)(F.ws + WS_W + (size_t)l * W_LAYER + off); }

__device__ __forceinline__ void p0a(Frame& F) {
    {
        LAS float* sc = (LAS float*)F.lds;
        LAS float* red = (LAS float*)(F.lds + 40960);
        bool have_c = false;
        for (int it = F.bid; it < 144; it += F.G) {
            if (!have_c) {
                for (int i = F.tid; i < 5 * 2048; i += NTHREADS) { const int b = i >> 11, k = i & 2047; const float c = (b == 0) ? F.c_prompt[k] : F.c_sample[(b - 1) * 2048 + k]; sc[i] = c / (1.0f + __expf(-c)); }
                __syncthreads(); have_c = true;
            }
            const int l = it / 72, chunk = it % 72, col = chunk * 256 + 4 * F.lane;
            const float* wp = F.w_mod + (size_t)l * DM * NMOD + col;
            f32x4 a[5];
#pragma unroll
            for (int b = 0; b < 5; ++b) a[b] = (f32x4){0.f, 0.f, 0.f, 0.f};
            const int kbeg = F.wave * 256;
#pragma unroll 8
            for (int k = kbeg; k < kbeg + 256; ++k) { const f32x4 w = *(const f32x4*)(wp + (size_t)k * NMOD);
#pragma unroll
                for (int b = 0; b < 5; ++b) a[b] += w * sc[b * 2048 + k]; }
#pragma unroll
            for (int b = 0; b < 5; ++b) *(LAS f32x4*)(red + (F.wave * 5 + b) * 256 + 4 * F.lane) = a[b];
            __syncthreads();
            for (int o = F.tid; o < 5 * 256; o += NTHREADS) { const int b = o >> 8, cc = o & 255; float v = 0.f;
#pragma unroll
                for (int w = 0; w < 8; ++w) v += red[(w * 5 + b) * 256 + cc];
                const int jg = chunk * 256 + cc; v += F.b_mod[l * NMOD + jg];
                const int jj = jg / 6144, t = (jg % 6144) / 2048, cl = jg & 2047;
                float r;
                if (t == 0) r = v; else if (t == 1) r = F.pre_g[(l * 3 + jj) * DM + cl] * (1.0f + v); else r = ((jj == 1) ? 1.0f : 0.5f) * (1.0f + v) * F.post_g[(l * 3 + jj) * DM + cl];
                ((float*)(F.ws + WS_COEF))[((size_t)((l * 3 + jj) * 3 + t) * 5 + b) * DM + cl] = r; }
            __syncthreads();
        }
        __syncthreads();
    }
    {
        LAS float* red = (LAS float*)F.lds;
        unsigned* AM = (unsigned*)(F.ws + WS_AMAX);
        for (int it = (F.bid + F.G - 144 % F.G) % F.G; it < 704; it += F.G) {
            const int mat = it / 88, q = it % 88, chunk = q >> 2, kq = q & 3, up = mat & 1, lf = mat >> 1;
            const float* wp = (up ? F.w_up : F.w_gate) + (size_t)lf * DM * DFF + (size_t)(kq * 512 + F.wave * 64) * DFF + chunk * 256 + 4 * F.lane;
            f32x4 mx = (f32x4){0.f, 0.f, 0.f, 0.f};
#pragma unroll 8
            for (int k = 0; k < 64; ++k) { const f32x4 w = *(const f32x4*)(wp + (size_t)k * DFF);
                mx[0] = fmaxf(mx[0], fabsf(w[0])); mx[1] = fmaxf(mx[1], fabsf(w[1])); mx[2] = fmaxf(mx[2], fabsf(w[2])); mx[3] = fmaxf(mx[3], fabsf(w[3])); }
            *(LAS f32x4*)(red + F.wave * 256 + 4 * F.lane) = mx;
            __syncthreads();
            if (F.tid < 256) { float v = red[F.tid];
#pragma unroll
                for (int w = 1; w < 8; ++w) v = fmaxf(v, red[w * 256 + F.tid]);
                const int n = chunk * 256 + F.tid;
                atomicMax(AM + (size_t)lf * 11264 + 256 * (n >> 7) + (up ? 128 : 0) + (n & 127), __float_as_uint(v)); }
            __syncthreads();
        }
    }
    const int gt = F.bid * NTHREADS + F.tid, NGT = F.G * NTHREADS;
    for (int i = gt; i < SEQ * 64; i += NGT) { const int pos = i >> 6, k = i & 63; const float inv = (float)pow(10000.0, -(double)(2 * k) / 128.0); const float ang = (float)pos * inv;
        double sd, cd; sincos((double)ang, &sd, &cd); ((float*)(F.ws + WS_ROPE))[i] = (float)cd; ((float*)(F.ws + WS_ROPE + 2 * MiB))[i] = (float)sd; }
    for (int i = gt; i < 256 * 128; i += NGT) { const int R = i >> 7, c = i & 127, pp = R >> 7, kk = R & 127, part = c >> 6, s1 = c & 63; float v = 0.f;
        if (kk < 64) { const float fr = (float)((kk * s1) & 63) * (2.0f / 64.0f); const float cv = cospif(fr), sv = sinpif(fr); v = (pp == part) ? cv : (pp == 0 ? sv : -sv); v *= 0.125f; }
        ((bf16*)(F.ws + WS_D1))[i] = (bf16)f2bf(v); }
    for (int i = gt; i < 256 * 256; i += NGT) { const int R = i >> 8, c = i & 255, pp = c >> 7, s2 = c & 127; float v = 0.f;
        if (R < 128) { const float fr = (float)((R * s2) & 127) * (2.0f / 128.0f); v = (pp == 0 ? cospif(fr) : sinpif(fr)) * 0.08838834764831845f; }
        ((bf16*)(F.ws + WS_D2))[i] = (bf16)f2bf(v); }
    {
        LAS float* tab = (LAS float*)F.lds;
        if (F.tid < 128) { const float fr = (float)F.tid * (2.0f / 128.0f); tab[F.tid] = cospif(fr); tab[128 + F.tid] = sinpif(fr); }
        __syncthreads();
        for (int i = gt; i < 2 * 8 * 128 * 256; i += NGT) { const int e2 = i & 255, c = (i >> 8) & 127, lg = i >> 15; const int e = e2 & 127; const bool im = e2 >= 128;
            const float* wl = F.four_w + (size_t)lg * 128 * 128 + e; float s = 0.f;
#pragma unroll 8
            for (int m = 0; m < 128; ++m) s += tab[(im ? 128 : 0) + ((m * c) & 127)] * wl[m * 128];
            ((bf16*)(F.ws + WS_WCS))[((size_t)lg * 256 + e2) * 128 + c] = (bf16)f2bf((im ? -s : s) * 0.08838834764831845f); }
        __syncthreads();
    }
    {
        LAS float* scr = (LAS float*)(F.lds + F.wave * 16384);
        const int gw = F.bid * NWAVES + F.wave, NGW = F.G * NWAVES;
        constexpr int I_D = 2 * 88 * 64, I_QK = 32 * 72, I_V = 32 * 8, I_O = 32 * 64;
        constexpr int I_L = I_D + I_QK + I_V + I_O;
        for (int it = gw; it < 2 * I_L; it += NGW) {
            const int l = it / I_L; int r = it % I_L;
            if (r < I_D) { const int fi = r / (88 * 64), q = r % (88 * 64), kb = q / 64, nb = q % 64;
                transpose_item(F.w_down + (size_t)(l * 2 + fi) * DFF * DM, DM, DFF, wptr(F, l, W_D) + (size_t)fi * 2048 * 5632, nb * 32, kb * 64, nb * 32, scr, F.lane,
                               l == 1 ? (unsigned*)(F.ws + WS_AMAXD) + fi * 2048 : nullptr); continue; }
            r -= I_D;
            if (r < I_QK) { const int kb = r / 72, nb = r % 72; int n0 = nb * 32; int dest;
                if (nb >= 40) { dest = n0; n0 += 256; }
                else if (n0 < 1024) { const int head = n0 >> 7, half = (n0 >> 6) & 1, x = n0 & 63; dest = 256 * (head >> 1) + 128 * half + 64 * (head & 1) + x; }
                else { const int q = n0 - 1024, hs = q >> 7, half = (q >> 6) & 1, x = q & 63; dest = 1024 + 128 * half + 64 * hs + x; }
                transpose_item(F.w_in + (size_t)l * DM * NIN, NIN, DM, wptr(F, l, W_QK), dest, kb * 64, n0, scr, F.lane); continue; }
            r -= I_QK;
            if (r < I_V) { const int kb = r / 8, nb = r % 8;
                transpose_item(F.w_in + (size_t)l * DM * NIN, NIN, DM, wptr(F, l, W_V), nb * 32, kb * 64, 1280 + nb * 32, scr, F.lane); continue; }
            r -= I_V;
            { const int kb = r / 64, nb = r % 64;
                transpose_item(F.w_out + (size_t)l * DM * DM, DM, DM, wptr(F, l, W_O), nb * 32, kb * 64, nb * 32, scr, F.lane); }
        }
    }
}

__device__ __forceinline__ void p0b_quant(Frame& F) {
    LAS float* scr = (LAS float*)(F.lds + 65536 + F.wave * 8704);
    const int gw = F.bid * NWAVES + F.wave, NGW = F.G * NWAVES;
    constexpr int I_M = 32 * 176;
    for (int it = gw; it < 8 * I_M; it += NGW) {
        const int mat = it / I_M, q = it % I_M, kb = q / 176, nb = q % 176, n0 = nb * 32, up = mat & 1, lf = mat >> 1, l = lf >> 1, fi = lf & 1;
        quant_item((up ? F.w_up : F.w_gate) + (size_t)lf * DM * DFF, (const unsigned*)(F.ws + WS_AMAX) + (size_t)lf * 11264,
                   (unsigned char*)wptr(F, l, W_GU) + (size_t)fi * 11264 * 2048, 256 * (n0 >> 7) + (up ? 128 : 0) + (n0 & 127), kb * 64, n0, scr, F.lane);
    }
    for (int it = gw; it < 2 * 2048; it += NGW) {
        const unsigned char* src = (const unsigned char*)wptr(F, 1, W_D) + (size_t)it * 5632 * 2;
        unsigned char* dst = (unsigned char*)wptr(F, 1, W_D8) + (size_t)it * 5632;
        const float am = __uint_as_float(((const unsigned*)(F.ws + WS_AMAXD))[it]), inv = am > 0.f ? 127.0f / am : 0.f;
        u32x4 v[11];
#pragma unroll
        for (int j = 0; j < 11; ++j) v[j] = *(const u32x4*)(src + (size_t)(j * 64 + F.lane) * 16);
#pragma unroll
        for (int j = 0; j < 11; ++j) { u32x2 w; w.x = pg8::q8c_pack(bflo(v[j].x), bfhi(v[j].x), bflo(v[j].y), bfhi(v[j].y), inv); w.y = pg8::q8c_pack(bflo(v[j].z), bfhi(v[j].z), bflo(v[j].w), bfhi(v[j].w), inv);
            *(u32x2*)(dst + (size_t)(j * 64 + F.lane) * 8) = w; }
    }
}

struct NormRow { f32x4 x[8]; u32x2 y[8]; };
__device__ __forceinline__ void norm_load(Frame& F, NormRow& R, int row, bool first, bool do_post) {
    if (first) { const float* xr = ((row >> 13) == 0 ? F.x_prompt + (size_t)row * DM : F.x_sample + (size_t)(row - SEQ) * DM);
#pragma unroll
        for (int j = 0; j < 8; ++j) R.x[j] = *(const f32x4*)(xr + 4 * F.lane + 256 * j);
    } else { const bf16* xr = F.XB + (size_t)row * DM + 4 * F.lane;
#pragma unroll
        for (int j = 0; j < 8; ++j) { const u32x2 v = *(const u32x2*)(xr + 256 * j); R.x[j] = (f32x4){bflo(v.x), bfhi(v.x), bflo(v.y), bfhi(v.y)}; } }
    if (do_post) { const bf16* yr = (const bf16*)(F.ws + WS_Y) + (size_t)row * DM + 4 * F.lane;
#pragma unroll
        for (int j = 0; j < 8; ++j) R.y[j] = *(const u32x2*)(yr + 256 * j); }
}
__device__ __forceinline__ void norm_row(Frame& F, NormRow& R, int row, bool first, bool do_post, bool do_pre, bool q8, const LAS float* cf) {
    if (do_post) {
        float ss = 0.f;
#pragma unroll
        for (int j = 0; j < 8; ++j) { const float a = bflo(R.y[j].x), bb = bfhi(R.y[j].x), c = bflo(R.y[j].y), d = bfhi(R.y[j].y); ss += (a * a + bb * bb) + (c * c + d * d); }
        const float r = 1.0f / sqrtf(wave_sum(ss, F.lane) * (1.0f / DM) + RMS_EPS);
#pragma unroll
        for (int j = 0; j < 8; ++j) { const f32x4 y = (f32x4){bflo(R.y[j].x), bfhi(R.y[j].x), bflo(R.y[j].y), bfhi(R.y[j].y)}; R.x[j] += *(const LAS f32x4*)(cf + 4 * F.lane + 256 * j) * (y * r); }
    }
    if (!do_pre) {
        float* xo = F.OUT + (size_t)row * DM + 4 * F.lane;
#pragma unroll
        for (int j = 0; j < 8; ++j) *(f32x4*)(xo + 256 * j) = R.x[j];
    } else {
        bf16* xo = F.XB + (size_t)row * DM + 4 * F.lane;
#pragma unroll
        for (int j = 0; j < 8; ++j) { u32x2 w; w.x = pk2(R.x[j][0], R.x[j][1]); w.y = pk2(R.x[j][2], R.x[j][3]); *(u32x2*)(xo + 256 * j) = w; }
    }
    if (do_pre) {
        float ss = 0.f;
#pragma unroll
        for (int j = 0; j < 8; ++j) ss += (R.x[j][0] * R.x[j][0] + R.x[j][1] * R.x[j][1]) + (R.x[j][2] * R.x[j][2] + R.x[j][3] * R.x[j][3]);
        const float r = 1.0f / sqrtf(wave_sum(ss, F.lane) * (1.0f / DM) + RMS_EPS);
        if (!q8) {
            bf16* ho = F.HB + (size_t)row * DM + 4 * F.lane;
#pragma unroll
            for (int j = 0; j < 8; ++j) { const f32x4 hv = R.x[j] * r * *(const LAS f32x4*)(cf + 2048 + 4 * F.lane + 256 * j) + *(const LAS f32x4*)(cf + 4096 + 4 * F.lane + 256 * j);
                u32x2 w; w.x = pk2(hv[0], hv[1]); w.y = pk2(hv[2], hv[3]); *(u32x2*)(ho + 256 * j) = w; }
        } else {
            float mx = 0.f;
#pragma unroll
            for (int j = 0; j < 8; ++j) { const f32x4 hv = R.x[j] * r * *(const LAS f32x4*)(cf + 2048 + 4 * F.lane + 256 * j) + *(const LAS f32x4*)(cf + 4096 + 4 * F.lane + 256 * j);
                R.x[j] = hv; mx = fmaxf(fmaxf(mx, fmaxf(fabsf(hv[0]), fabsf(hv[1]))), fmaxf(fabsf(hv[2]), fabsf(hv[3]))); }
            mx = fmaxf(wave_max(mx, F.lane), 1e-30f);
            const float inv = 127.0f / mx;
            unsigned char* ho = (unsigned char*)F.HB + (size_t)row * DM + 4 * F.lane;
#pragma unroll
            for (int j = 0; j < 8; ++j) *(unsigned*)(ho + 256 * j) = q8_pack(R.x[j][0], R.x[j][1], R.x[j][2], R.x[j][3], inv);
            if (F.lane == 0) ((float*)(F.ws + WS_SA))[row] = mx * (1.0f / 127.0f);
        }
    }
}
__device__ __forceinline__ void norm_phase(Frame& F, bool first, bool do_post, int cpost, bool do_pre, int cpre, bool q8) {
    F.lane = lane_fresh(); F.tid = F.wave * 64 + F.lane;
    const int NGW = F.G * NWAVES, per = (M + NGW - 1) / NGW;
    const int blk0 = F.bid * NWAVES * per, rbeg = blk0 + F.wave * per, rend = (rbeg + per < M) ? rbeg + per : M;
    const int b_lo = (blk0 >> 13) > 4 ? 4 : (blk0 >> 13);
    LAS float* cfl = (LAS float*)F.lds;
    {
        const float* COEF = (const float*)(F.ws + WS_COEF);
        for (int i = F.tid; i < 2 * 3 * 2048 / 4; i += NTHREADS) { const int e = 4 * i, set = e / 6144, v = (e % 6144) >> 11, col = e & 2047; const int b = (b_lo + set > 4) ? 4 : b_lo + set;
            const int ci = (v == 0) ? (cpost * 3 + 2) : (v == 1 ? cpre * 3 + 1 : cpre * 3 + 0);
            *(LAS f32x4*)(cfl + e) = *(const f32x4*)(COEF + ((size_t)ci * 5 + b) * DM + col); }
        LDS_WAIT(); __syncthreads();
    }
    if (rbeg < rend) {
        NormRow Ra, Rb;
        norm_load(F, Ra, rbeg, first, do_post);
        for (int row = rbeg; row < rend; row += 2) {
            const bool has_b = row + 1 < rend;
            if (has_b) norm_load(F, Rb, row + 1, first, do_post);
            norm_row(F, Ra, row, first, do_post, do_pre, q8, cfl + (((row >> 13) - b_lo) & 1) * 6144);
            if (has_b) {
                if (row + 2 < rend) norm_load(F, Ra, row + 2, first, do_post);
                norm_row(F, Rb, row + 1, first, do_post, do_pre, q8, cfl + ((((row + 1) >> 13) - b_lo) & 1) * 6144);
            }
        }
    }
    __syncthreads();
}
__device__ __forceinline__ void mixnorm_phase(Frame& F, int l) {
    F.lane = lane_fresh(); F.tid = F.wave * 64 + F.lane;
    const int gw = F.bid * NWAVES + F.wave, NGW = F.G * NWAVES, per = (M + NGW - 1) / NGW, rbeg = gw * per, rend = (rbeg + per < M) ? rbeg + per : M;
    const float* gf = F.branch_g + (size_t)(l * 2 + 1) * 1024 + 8 * F.lane;
    f32x4 g[2][2];
#pragma unroll
    for (int j = 0; j < 2; ++j) { g[j][0] = *(const f32x4*)(gf + 512 * j); g[j][1] = *(const f32x4*)(gf + 512 * j + 4); }
    for (int row0 = rbeg; row0 < rend; row0 += 4) {
        u32x4 v[4][2];
#pragma unroll
        for (int r = 0; r < 4; ++r) { const int row = (row0 + r < rend) ? row0 + r : rend - 1; const bf16* p = F.HB + (size_t)row * DM + 1024 + 8 * F.lane;
#pragma unroll
            for (int j = 0; j < 2; ++j) v[r][j] = *(const u32x4*)(p + 512 * j); }
#pragma unroll
        for (int r = 0; r < 4; ++r) {
            float f[2][8]; float ss = 0.f;
#pragma unroll
            for (int j = 0; j < 2; ++j) { f[j][0] = bflo(v[r][j].x); f[j][1] = bfhi(v[r][j].x); f[j][2] = bflo(v[r][j].y); f[j][3] = bfhi(v[r][j].y); f[j][4] = bflo(v[r][j].z); f[j][5] = bfhi(v[r][j].z); f[j][6] = bflo(v[r][j].w); f[j][7] = bfhi(v[r][j].w);
#pragma unroll
                for (int i = 0; i < 8; ++i) ss += f[j][i] * f[j][i]; }
            const float rr = 1.0f / sqrtf(wave_sum(ss, F.lane) * (1.0f / 1024.0f) + RMS_EPS);
            if (row0 + r < rend) { bf16* p = F.HB + (size_t)(row0 + r) * DM + 1024 + 8 * F.lane;
#pragma unroll
                for (int j = 0; j < 2; ++j) { u32x4 w; w.x = pk2(f[j][0] * rr * g[j][0][0], f[j][1] * rr * g[j][0][1]); w.y = pk2(f[j][2] * rr * g[j][0][2], f[j][3] * rr * g[j][0][3]);
                    w.z = pk2(f[j][4] * rr * g[j][1][0], f[j][5] * rr * g[j][1][1]); w.w = pk2(f[j][6] * rr * g[j][1][2], f[j][7] * rr * g[j][1][3]); *(u32x4*)(p + 512 * j) = w; } }
        }
    }
}

constexpr int ATT_IMG = 147456;
__device__ __forceinline__ void attn_phase(Frame& F, int l) {
    F.lane = lane_fresh(); F.tid = F.wave * 64 + F.lane;
    const bf16* Q = (const bf16*)(F.ws + WS_Q); const bf16* KB = (const bf16*)(F.ws + WS_KB); const bf16* VT = (const bf16*)(F.ws + WS_VT); bf16* MIX = F.HB;
    const bf16* ZERO = (const bf16*)(F.ws + WS_CTL + 512 * 1024);
    LAS float* ssq = (LAS float*)(F.lds + SSQ_OFF);
    const int h = F.wave, hk = h >> 2;
    const float sinkl = F.sink[l * 8 + h] * LOG2E;
    for (int unit = F.bid; unit < NSEQ * 256; unit += F.G) {
        const int b = unit >> 8, q0 = (unit & 255) * 32, k0 = q0 - 128;
        const size_t tok0 = (size_t)b * SEQ;
        { const int ln = lane_fresh();
#pragma unroll 2
        for (int j = F.wave; j < 144; j += 8) {
            const int p = 64 * j + ln, hkk = p >= 4608 ? 1 : 0, pr = p - hkk * 4608, row = pr >> 4, slot = pr & 15;
            const int chunk = slot ^ ((((row >> 3) & 3) << 2) | (row & 3)); const int key = k0 + row; const bool ok = key >= 0 && key < SEQ;
            const bf16* src = ok ? KB + (tok0 + key) * NKV + hkk * 128 + chunk * 8 : ZERO;
            __builtin_amdgcn_global_load_lds((const unsigned*)src, (LAS unsigned*)(F.lds + 1024 * j), 16, 0, 0);
        } }
        bf16x8 qfs[2][4];
        { const int ln = lane_fresh(), c = ln & 15, q = ln >> 4;
#pragma unroll
          for (int qt = 0; qt < 2; ++qt)
#pragma unroll
            for (int ks = 0; ks < 4; ++ks) qfs[qt][ks] = *(const bf16x8*)(Q + (tok0 + q0 + 16 * qt + c) * NQ + h * 128 + 32 * ks + 8 * q); }
        VM_WAIT(); __syncthreads();
        bf16x8 pf[2][9]; float inv[2];
#pragma unroll
        for (int qt = 0; qt < 2; ++qt) {
            const int ln = lane_fresh(), c = ln & 15, q = ln >> 4;
            const LAS unsigned char* Kl = F.lds + hk * 73728 + (8 * (c >> 2) + (c & 3)) * 256;
            int xoff[4];
#pragma unroll
            for (int ks = 0; ks < 4; ++ks) xoff[ks] = ((4 * ks + q) ^ c) << 4;
            bf16x8 qf[4];
#pragma unroll
            for (int ks = 0; ks < 4; ++ks) qf[ks] = qfs[qt][ks];
            f32x4 s[9][2];
            bf16x8 kfa[4], kfb[4];
#define ATT_LDK(dst, T) do { _Pragma("unroll") for (int ks = 0; ks < 4; ++ks) dst[ks] = *(const LAS bf16x8*)(Kl + (32 * ((T) >> 1) + 4 * ((T) & 1)) * 256 + xoff[ks]); } while (0)
#define ATT_MMK(src, T) do { f32x4 a0 = (f32x4){0.f, 0.f, 0.f, 0.f}; _Pragma("unroll") for (int ks = 0; ks < 4; ++ks) a0 = __builtin_amdgcn_mfma_f32_16x16x32_bf16(src[ks], qf[ks], a0, 0, 0, 0); s[(T) >> 1][(T) & 1] = a0; } while (0)
            ATT_LDK(kfa, 0);
#pragma unroll
            for (int T = 0; T < 18; T += 2) {
                ATT_LDK(kfb, T + 1);
                __builtin_amdgcn_sched_barrier(0);
                ATT_MMK(kfa, T);
                if (T + 2 < 18) ATT_LDK(kfa, T + 2);
                __builtin_amdgcn_sched_barrier(0);
                ATT_MMK(kfb, T + 1);
            }
#undef ATT_LDK
#undef ATT_MMK
            const int qpos = q0 + 16 * qt + c; float mx = -1e30f;
            const bool edge = (k0 < 0) || (k0 + 288 > SEQ);
#pragma unroll
            for (int G = 0; G < 9; ++G) {
                if (G == 0 || G == 8 || edge) {
#pragma unroll
                    for (int tt = 0; tt < 2; ++tt)
#pragma unroll
                        for (int r = 0; r < 4; ++r) { const int kpos = k0 + 32 * G + 8 * q + 4 * tt + r; const int d = qpos - kpos;
                            const bool ok = (d <= 128) && (d >= -128) && (kpos >= 0) && (kpos < SEQ); const float v = ok ? s[G][tt][r] : -1e30f; s[G][tt][r] = v; mx = fmaxf(mx, v); }
                } else {
#pragma unroll
                    for (int tt = 0; tt < 2; ++tt)
#pragma unroll
                        for (int r = 0; r < 4; ++r) mx = fmaxf(mx, s[G][tt][r]);
                }
            }
            mx = fmaxf(mx, shfl_xor_l(mx, 16, ln)); mx = fmaxf(mx, shfl_xor_l(mx, 32, ln)); mx = fmaxf(mx, sinkl);
            float lsum = 0.f;
#pragma unroll
            for (int G = 0; G < 9; ++G) { float p[8];
#pragma unroll
                for (int tt = 0; tt < 2; ++tt)
#pragma unroll
                    for (int r = 0; r < 4; ++r) { p[4 * tt + r] = __builtin_amdgcn_exp2f(s[G][tt][r] - mx); lsum += p[4 * tt + r]; }
                u32x4 pw; pw.x = cvt_pk_bf16(p[0], p[1]); pw.y = cvt_pk_bf16(p[2], p[3]); pw.z = cvt_pk_bf16(p[4], p[5]); pw.w = cvt_pk_bf16(p[6], p[7]);
                pf[qt][G] = __builtin_bit_cast(bf16x8, pw); }
            lsum += shfl_xor_l(lsum, 16, ln); lsum += shfl_xor_l(lsum, 32, ln); lsum += __builtin_amdgcn_exp2f(sinkl - mx);
            inv[qt] = 1.0f / lsum;
        }
        __syncthreads();
        { const int ln = lane_fresh();
#pragma unroll 2
        for (int j = F.wave; j < 144; j += 8) {
            const int p = 64 * j + ln, hkk = p >= 4608 ? 1 : 0, pr = p - hkk * 4608, d = pr / 36, c1 = pr - d * 36;
            const int ch = c1 ^ ((d >> 2) & 3); const int tok = k0 + 8 * ch; const bool ok = tok >= 0 && tok < SEQ;
            const bf16* src = ok ? VT + (size_t)(hkk * 128 + d) * M + tok0 + tok : ZERO;
            __builtin_amdgcn_global_load_lds((const unsigned*)src, (LAS unsigned*)(F.lds + 1024 * j), 16, 0, 0);
        } }
        VM_WAIT(); __syncthreads();
        f32x4 o0[8], o1[8];
#pragma unroll
        for (int dt = 0; dt < 8; ++dt) { o0[dt] = (f32x4){0.f, 0.f, 0.f, 0.f}; o1[dt] = (f32x4){0.f, 0.f, 0.f, 0.f}; }
        {
            const int ln = lane_fresh(), c = ln & 15, q = ln >> 4;
            const LAS unsigned char* Vl = F.lds + hk * 73728 + c * 576 + ((q ^ (c >> 2)) << 4);
            bf16x8 vfa[4], vfb[4];
#define ATT_LDV(dst, H) do { _Pragma("unroll") for (int dd = 0; dd < 4; ++dd) dst[dd] = *(const LAS bf16x8*)(Vl + (4 * ((H) & 1) + dd) * 9216 + ((H) >> 1) * 64); } while (0)
#define ATT_MMV(src, H) do { _Pragma("unroll") for (int dd = 0; dd < 4; ++dd) { o0[4 * ((H) & 1) + dd] = __builtin_amdgcn_mfma_f32_16x16x32_bf16(src[dd], pf[0][(H) >> 1], o0[4 * ((H) & 1) + dd], 0, 0, 0); \
        o1[4 * ((H) & 1) + dd] = __builtin_amdgcn_mfma_f32_16x16x32_bf16(src[dd], pf[1][(H) >> 1], o1[4 * ((H) & 1) + dd], 0, 0, 0); } } while (0)
            ATT_LDV(vfa, 0);
#pragma unroll
            for (int H = 0; H < 18; H += 2) {
                ATT_LDV(vfb, H + 1);
                __builtin_amdgcn_sched_barrier(0);
                ATT_MMV(vfa, H);
                if (H + 2 < 18) ATT_LDV(vfa, H + 2);
                __builtin_amdgcn_sched_barrier(0);
                ATT_MMV(vfb, H + 1);
            }
#undef ATT_LDV
#undef ATT_MMV
        }
        const int ln = lane_fresh(), c = ln & 15, q = ln >> 4;
        const float* ga = F.branch_g + (size_t)(l * 2) * 1024 + h * 128 + 4 * q;
        float ss0 = 0.f, ss1 = 0.f;
#pragma unroll
        for (int dt = 0; dt < 8; ++dt) { o0[dt] = o0[dt] * inv[0]; o1[dt] = o1[dt] * inv[1];
            ss0 += (o0[dt][0] * o0[dt][0] + o0[dt][1] * o0[dt][1]) + (o0[dt][2] * o0[dt][2] + o0[dt][3] * o0[dt][3]);
            ss1 += (o1[dt][0] * o1[dt][0] + o1[dt][1] * o1[dt][1]) + (o1[dt][2] * o1[dt][2] + o1[dt][3] * o1[dt][3]); }
        ss0 += shfl_xor_l(ss0, 16, ln); ss0 += shfl_xor_l(ss0, 32, ln); ss1 += shfl_xor_l(ss1, 16, ln); ss1 += shfl_xor_l(ss1, 32, ln);
        if (q == 0) { ssq[h * 32 + c] = ss0; ssq[h * 32 + 16 + c] = ss1; }
        f32x4 gv[8];
#pragma unroll
        for (int dt = 0; dt < 8; ++dt) gv[dt] = *(const f32x4*)(ga + 16 * dt);
        LDS_WAIT(); __syncthreads();
        float t0 = 0.f, t1 = 0.f;
#pragma unroll
        for (int w = 0; w < 8; ++w) { t0 += ssq[w * 32 + c]; t1 += ssq[w * 32 + 16 + c]; }
        const float r0 = 1.0f / sqrtf(t0 * (1.0f / 1024.0f) + RMS_EPS), r1 = 1.0f / sqrtf(t1 * (1.0f / 1024.0f) + RMS_EPS);
        bf16* op = MIX + (tok0 + q0 + c) * DM + h * 128 + 4 * q;
#pragma unroll
        for (int dt = 0; dt < 8; ++dt) { const f32x4 g = gv[dt]; const f32x4 v0 = o0[dt] * r0 * g, v1 = o1[dt] * r1 * g;
            u32x2 w0, w1; w0.x = pk2(v0[0], v0[1]); w0.y = pk2(v0[2], v0[3]); w1.x = pk2(v1[0], v1[1]); w1.y = pk2(v1[2], v1[3]);
            *(u32x2*)(op + 16 * dt) = w0; *(u32x2*)(op + (size_t)16 * DM + 16 * dt) = w1; }
        LDS_WAIT();
    }
    VM_WAIT(); __syncthreads();
}

__global__ void __launch_bounds__(NTHREADS, 2) fwd_kernel(Args args) {
    extern __shared__ __attribute__((aligned(16))) unsigned char lds_raw[];
    Frame F;
    F.lds = (LAS unsigned char*)lds_raw;
    F.tid = threadIdx.x; F.lane = F.tid & 63; F.wave = __builtin_amdgcn_readfirstlane(F.tid >> 6); F.G = gridDim.x; F.bid = blockIdx.x;
    F.x_prompt = args.in[0]; F.x_sample = args.in[1]; F.c_prompt = args.in[2]; F.c_sample = args.in[3]; F.w_mod = args.in[4]; F.b_mod = args.in[5]; F.pre_g = args.in[6]; F.post_g = args.in[7];
    F.w_gate = args.in[8]; F.w_up = args.in[9]; F.w_down = args.in[10]; F.w_in = args.in[11]; F.sink = args.in[12]; F.four_w = args.in[13]; F.branch_g = args.in[14]; F.w_out = args.in[15];
    F.OUT = args.out; F.HB = (bf16*)args.out; F.ws = args.ws; F.XB = (bf16*)(args.ws + WS_X);
    volatile LAS unsigned* MISC = (volatile LAS unsigned*)(F.lds + MISC_OFF);
    for (int u = F.tid; u < (LDS_BYTES - LDSCTL_OFF) / 4; u += NTHREADS) ((LAS unsigned*)(F.lds + LDSCTL_OFF))[u] = 0u;
    __syncthreads();
    (void)xcd_barrier_post((unsigned*)(F.ws + WS_CTL) + 4096, MISC + 8);
#define GRID_BAR() do { XcdBarrier b2_; b2_.bar = (unsigned*)(args.ws + opaque_zero()) + 4096; b2_.x = xb_xcc_id(); b2_.st = (volatile LAS unsigned*)(F.lds + MISC_OFF) + 8; xcd_barrier(b2_, F.wave == 0 && lane_fresh() == 0); } while (0)

    p0a(F);
    GRID_BAR();
    p0b_quant(F);
    norm_phase(F, true, false, 0, true, 0, true);
    GRID_BAR();

    for (int hs = 0; hs < 2 * DEPTH; ++hs) {
        const int l = hs >> 1, fi = hs & 1;
        F.ws = args.ws + opaque_zero(); { int b_ = blockIdx.x, g_ = gridDim.x; asm volatile("" : "+s"(b_), "+s"(g_)); F.bid = b_; F.G = g_; }
        if (l == 0) {
        {
            pg8::GeoPlain geo{(const char*)F.HB, (const char*)wptr(F, l, W_GU) + (size_t)fi * 11264 * 2048, DM / 2};
            pg8::StaticOrder S; S.init(M, 11264, F.G, F.bid);
            pg8::EpiSwiGLU8 E{(bf16*)(F.ws + WS_BIG), (const float*)(F.ws + WS_SA), (const unsigned*)(F.ws + WS_AMAX) + (size_t)(l * 2 + fi) * 11264};
            pg8::gemm_phase(F.lds, F.wave, geo, S, E);
        }
        GRID_BAR();
        {
            pg8::GeoPlain geo{(const char*)(F.ws + WS_BIG), (const char*)(wptr(F, l, W_D) + (size_t)fi * 2048 * 5632), DFF};
            pg8::StaticOrder S; S.init(M, DM, F.G, F.bid);
            pg8::EpiBf16 E{(bf16*)(F.ws + WS_Y), (size_t)DM};
            pg8::gemm_phase(F.lds, F.wave, geo, S, E);
        }
        GRID_BAR();
        } else {
        {
            pg8::GeoPlain geo{(const char*)F.HB, (const char*)wptr(F, l, W_GU) + (size_t)fi * 11264 * 2048, DM / 2};
            pg8::Col0Order S{F.G, F.bid};
            pg8::EpiSwiGLU8Q<true> E{F.ws + WS_BIG, (const float*)(F.ws + WS_SA), (const unsigned*)(F.ws + WS_AMAX) + (size_t)(l * 2 + fi) * 11264, (float*)(F.ws + WS_S2), (LAS float*)(F.lds + RING_BYTES)};
            pg8::gemm_phase(F.lds, F.wave, geo, S, E);
        }
        GRID_BAR();
        {
            pg8::GeoPlain geo{(const char*)F.HB, (const char*)wptr(F, l, W_GU) + (size_t)fi * 11264 * 2048, DM / 2};
            pg8::ShiftOrder S; S.S.init(M, 11264 - 256, F.G, F.bid);
            pg8::EpiSwiGLU8Q<false> E{F.ws + WS_BIG, (const float*)(F.ws + WS_SA), (const unsigned*)(F.ws + WS_AMAX) + (size_t)(l * 2 + fi) * 11264, (float*)(F.ws + WS_S2), (LAS float*)(F.lds + RING_BYTES)};
            pg8::gemm_phase(F.lds, F.wave, geo, S, E);
        }
        GRID_BAR();
        {
            pg8::GeoPlain geo{(const char*)(F.ws + WS_BIG), (const char*)wptr(F, l, W_D8) + (size_t)fi * 2048 * 5632, DFF / 2};
            pg8::StaticOrder S; S.init(M, DM, F.G, F.bid);
            pg8::EpiBf16S E{(bf16*)(F.ws + WS_Y), (const float*)(F.ws + WS_S2), (const unsigned*)(F.ws + WS_AMAXD) + fi * 2048};
            pg8::gemm_phase(F.lds, F.wave, geo, S, E);
        }
        GRID_BAR();
        }
        if (fi == 0) {
            norm_phase(F, false, true, l * 3 + 0, true, l * 3 + 1, false);
            GRID_BAR();
            {
                pg8::GeoPlain geo{(const char*)F.HB, (const char*)wptr(F, l, W_QK), DM};
                pg8::StaticOrder S; S.init(M, 2304, F.G, F.bid);
                pg8::EpiRope E{(bf16*)(F.ws + WS_Q), (bf16*)(F.ws + WS_KB), (const float*)(F.ws + WS_ROPE), (const float*)(F.ws + WS_ROPE + 2 * MiB), (bf16*)(F.ws + WS_U)};
                pg8::gemm_phase(F.lds, F.wave, geo, S, E);
            }
            {
                pg8::GeoPlain geo{(const char*)wptr(F, l, W_V), (const char*)F.HB, DM};
                pg8::StaticOrder S; S.init(256, M, F.G, (F.bid + 96) % F.G);
                pg8::EpiBf16 E{(bf16*)(F.ws + WS_VT), (size_t)M};
                pg8::gemm_phase(F.lds, F.wave, geo, S, E);
            }
            GRID_BAR();
            attn_phase(F, l);
            {
                pg8::GeoP1 geo{(const char*)(F.ws + WS_WCS) + (size_t)l * 8 * 256 * 128 * 2, (const char*)(F.ws + WS_U)};
                pg8::StaticOrder S; S.init(2048, M, F.G, F.bid);
                pg8::EpiBf16 E{(bf16*)(F.ws + WS_Z1), (size_t)M};
                pg8::gemm_phase(F.lds, F.wave, geo, S, E);
            }
            GRID_BAR();
            {
                pg8::GeoP2 geo{(const char*)(F.ws + WS_D1), (const char*)(F.ws + WS_Z1)};
                pg8::StaticOrder S; S.init(256, 2560 * 256, F.G, F.bid);
                pg8::EpiTwiddle E{(bf16*)(F.ws + WS_Y2)};
                pg8::gemm_phase(F.lds, F.wave, geo, S, E);
            }
            GRID_BAR();
            {
                pg8::GeoPlain geo{(const char*)(F.ws + WS_D2), (const char*)(F.ws + WS_Y2), 256};
                pg8::StaticOrder S; S.init(256, 1280 * 256, F.G, F.bid);
                pg8::EpiDftOut E{F.HB};
                pg8::gemm_phase(F.lds, F.wave, geo, S, E);
            }
            GRID_BAR();
            mixnorm_phase(F, l);
            GRID_BAR();
            {
                pg8::GeoPlain geo{(const char*)F.HB, (const char*)wptr(F, l, W_O), DM};
                pg8::StaticOrder S; S.init(M, DM, F.G, F.bid);
                pg8::EpiBf16 E{(bf16*)(F.ws + WS_Y), (size_t)DM};
                pg8::gemm_phase(F.lds, F.wave, geo, S, E);
            }
            GRID_BAR();
            norm_phase(F, false, true, l * 3 + 1, true, l * 3 + 2, true);
            GRID_BAR();
        } else {
            const bool lastl = (hs == 2 * DEPTH - 1);
            norm_phase(F, false, true, l * 3 + 2, !lastl, (l + 1) * 3 + 0, true);
            if (!lastl) GRID_BAR();
        }
    }
}

extern "C" void kernel_launch(void* const* d_in, const int* in_sizes, int n_in, void* d_out, int out_size, void* d_ws, size_t ws_size, hipStream_t stream) {
    static int grid = 0;
    if (grid == 0) {
        if (n_in != 16 || out_size != M * DM || ws_size < WS_END) { fprintf(stderr, "kernel_launch: unexpected problem (n_in %d, out %d, ws %zu < %zu)\n", n_in, out_size, ws_size, (size_t)WS_END); grid = -1; return; }
        int dev = 0, cus = 0, per_cu = 0;
        if (hipGetDevice(&dev) != hipSuccess || hipDeviceGetAttribute(&cus, hipDeviceAttributeMultiprocessorCount, dev) != hipSuccess) { grid = -1; return; }
        if (hipFuncSetAttribute((const void*)fwd_kernel, hipFuncAttributeMaxDynamicSharedMemorySize, LDS_BYTES) != hipSuccess) { fprintf(stderr, "kernel_launch: hipFuncSetAttribute failed\n"); grid = -1; return; }
        if (hipOccupancyMaxActiveBlocksPerMultiprocessor(&per_cu, (const void*)fwd_kernel, NTHREADS, LDS_BYTES) != hipSuccess || per_cu < 1) { fprintf(stderr, "kernel_launch: occupancy query reports %d\n", per_cu); }
        (void)hipGetLastError();
        grid = cus;
    }
    if (grid < 0) return;
    if (hipMemsetAsync((char*)d_ws + WS_CTL, 0, CTL_ZERO_BYTES, stream) != hipSuccess) return;
    Args a{};
    for (int i = 0; i < 16; ++i) a.in[i] = (const float*)d_in[i];
    a.out = (float*)d_out; a.ws = (unsigned char*)d_ws;
    hipLaunchKernelGGL(fwd_kernel, dim3(grid), dim3(NTHREADS), LDS_BYTES, stream, a);
}
```

```cpp
#include <hip/hip_runtime.h>
#include <cstdio>
#include <cstdint>

#define LAS __attribute__((address_space(3)))
#define GAS __attribute__((address_space(1)))
typedef unsigned short bf16;
typedef short bf16x8 __attribute__((ext_vector_type(8)));
typedef float f32x4 __attribute__((ext_vector_type(4)));
typedef float f32x2 __attribute__((ext_vector_type(2)));
typedef unsigned u32x4 __attribute__((ext_vector_type(4)));
typedef int i32x4 __attribute__((ext_vector_type(4)));
typedef unsigned u32x2 __attribute__((ext_vector_type(2)));
typedef GAS unsigned gu32;

constexpr int DM = 2048, SEQ = 8192, NSEQ = 5, M = NSEQ * SEQ, DFF = 5632, DEPTH = 2;
constexpr int NQ = 1024, NKV = 256, NIN = 2560, NMOD = 18432;
constexpr float RMS_EPS = 1e-6f;
constexpr float QSCALE = 0.08838834764831845f * 1.4426950408889634f;
constexpr float LOG2E = 1.4426950408889634f;
constexpr int NWAVES = 8, NTHREADS = 512;

constexpr size_t MiB = 1u << 20;
constexpr size_t WS_CTL = 0, CTL_ZERO_BYTES = 1 * MiB;
constexpr size_t WS_AMAX = 262144;
constexpr size_t WS_AMAXD = 458752;
constexpr unsigned Q2_MASK = 0xEu;
constexpr size_t WS_COEF = 1 * MiB;
constexpr size_t WS_SA = WS_COEF + 768 * 1024;
constexpr size_t WS_ROPE = 2 * MiB;
constexpr size_t WS_D1 = 6 * MiB;
constexpr size_t WS_D2 = 6 * MiB + 65536;
constexpr size_t WS_S2 = 6 * MiB + 262144;
constexpr size_t WS_WCS = 7 * MiB;
constexpr size_t WS_W = 9 * MiB;
constexpr size_t W_GU = 0;
constexpr size_t W_D8 = W_GU + (size_t)2 * 11264 * 2048;
constexpr size_t W_D = W_GU + (size_t)2 * 11264 * 2048 * 2;
constexpr size_t W_QK = W_D + (size_t)2 * 2048 * 5632 * 2;
constexpr size_t W_V = W_QK + (size_t)2304 * 2048 * 2;
constexpr size_t W_Z = W_V + (size_t)256 * 2048 * 2;
constexpr size_t W_O = W_Z + (size_t)1024 * 2048 * 2;
constexpr size_t W_LAYER = W_O + (size_t)2048 * 2048 * 2;
static_assert(W_LAYER == 154 * MiB, "weights per layer");
constexpr size_t WS_X = WS_W + 2 * W_LAYER;
constexpr size_t WS_Y = WS_X + 160 * MiB;
constexpr size_t WS_BIG = WS_Y + 160 * MiB;
constexpr size_t WS_Q = WS_BIG, WS_KB = WS_BIG + 80 * MiB, WS_VT = WS_BIG + 100 * MiB, WS_Z1 = WS_BIG + 120 * MiB, WS_Y2 = WS_BIG + 280 * MiB, WS_U = WS_Y2;
constexpr size_t WS_END = WS_BIG + 440 * MiB;
static_assert((size_t)M * DFF * 2 == 440 * MiB && (size_t)M * DM * 2 == 160 * MiB, "sizes");

constexpr int RING_BYTES = 131072;
constexpr int LDSCTL_OFF = 147456, MISC_OFF = LDSCTL_OFF + 320, SSQ_OFF = LDSCTL_OFF + 512;
constexpr int LDS_BYTES = 147456 + 2048;

#define LDS_WAIT() asm volatile("s_waitcnt lgkmcnt(0)" ::: "memory")
#define VM_WAIT() asm volatile("s_waitcnt vmcnt(0)" ::: "memory")
__device__ __forceinline__ unsigned f2bf(float f) { unsigned u = __builtin_bit_cast(unsigned, f); return (u + 0x7fffu + ((u >> 16) & 1u)) >> 16; }
__device__ __forceinline__ unsigned pk2(float lo, float hi) { return f2bf(lo) | (f2bf(hi) << 16); }
__device__ __forceinline__ float bflo(unsigned w) { return __builtin_bit_cast(float, w << 16); }
__device__ __forceinline__ float bfhi(unsigned w) { return __builtin_bit_cast(float, w & 0xffff0000u); }
__device__ __forceinline__ unsigned cvt_pk_bf16(float lo, float hi) { unsigned r; asm volatile("v_cvt_pk_bf16_f32 %0, %1, %2" : "=v"(r) : "v"(lo), "v"(hi)); return r; }

__device__ __forceinline__ int lane_fresh() { int l; asm volatile("v_mbcnt_lo_u32_b32 %0, -1, 0\n\tv_mbcnt_hi_u32_b32 %0, -1, %0" : "=v"(l)); return l; }
__device__ __forceinline__ size_t opaque_zero() { size_t z = 0; asm volatile("" : "+s"(z)); return z; }
namespace pg8 {
constexpr int BM = 256, BK = 64, HALF = 128, HTB = HALF * BK * 2, STAGE_BYTES = 8 * HTB, NXCD = 8, WGM = 4;
__host__ __device__ __forceinline__ int lds_byte(int r, int c) { const int st = (r >> 4) * 2 + (c >> 5), rr = r & 15, cc = c & 31, ob = rr * 64 + cc * 2; return st * 1024 + (ob ^ (((ob >> 9) & 1) << 5)); }
__host__ __device__ __forceinline__ void stage_rc(int b, int& R, int& C) { const int st = b / 1024, sb = b % 1024, swz = sb ^ (((sb >> 9) & 1) << 5); R = (st >> 1) * 16 + swz / 64; C = (st & 1) * 32 + (swz % 64) / 2; }
__host__ __device__ __forceinline__ int perm32(int rho) { const int n = rho >> 4, i = rho & 15; return 8 * (i >> 2) + 4 * n + (i & 3); }

struct Unit { int pm, pn; };
struct StaticOrder {
    int nM, nN, nwg, G, c;
    __device__ void init(int Mr, int Nc, int G_, int c_) { nM = Mr / BM; nN = Nc / BM; nwg = nM * nN; G = G_; c = c_; }
    __device__ bool next(int i, Unit& u) const {
        const long L = (long)i * G + c; if (L >= nwg) return false;
        int wgid = (int)L; { const int q = nwg / NXCD, r = nwg % NXCD, xcd = wgid % NXCD, off = wgid / NXCD; wgid = (xcd < r ? xcd * (q + 1) : r * (q + 1) + (xcd - r) * q) + off; }
        const int nig = WGM * nN, gid = wgid / nig, fm = gid * WGM, gsz = (nM - fm) < WGM ? (nM - fm) : WGM;
        u.pm = fm + ((wgid % nig) % gsz); u.pn = (wgid % nig) / gsz; return true;
    }
};

struct Col0Order {
    int G, c;
    __device__ bool next(int i, Unit& u) const { const long L = (long)i * G + c; if (L >= 160) return false; u.pm = (int)L; u.pn = 0; return true; }
};
struct ShiftOrder {
    StaticOrder S;
    __device__ bool next(int i, Unit& u) const { if (!S.next(i, u)) return false; u.pn += 1; return true; }
};

struct GeoPlain {
    const char* A; const char* B; int K;
    __device__ __forceinline__ int nt() const { return K / BK; }
    __device__ __forceinline__ const char* a_base(const Unit& u) const { return A + (size_t)u.pm * BM * K * 2; }
    __device__ __forceinline__ const char* b_base(const Unit& u) const { return B + (size_t)u.pn * BM * K * 2; }
    __device__ __forceinline__ unsigned a_off(int R, int C) const { return (unsigned)(R * K + C) * 2u; }
    __device__ __forceinline__ unsigned b_off(int R, int C) const { return (unsigned)(R * K + C) * 2u; }
    __device__ __forceinline__ size_t a_hstep() const { return (size_t)HALF * K * 2; }
    __device__ __forceinline__ size_t b_hstep() const { return (size_t)HALF * K * 2; }
    __device__ __forceinline__ size_t a_kstep() const { return BK * 2; }
    __device__ __forceinline__ size_t b_kstep() const { return BK * 2; }
};
struct GeoP1 {
    const char* A; const char* B;
    __device__ __forceinline__ int nt() const { return 2; }
    __device__ __forceinline__ const char* a_base(const Unit& u) const { return A + (size_t)u.pm * 256 * 128 * 2; }
    __device__ __forceinline__ const char* b_base(const Unit& u) const { return B + ((size_t)(u.pn >> 5) * SEQ + 4 * (u.pn & 31)) * 1024 * 2 + (size_t)u.pm * 128 * 2; }
    __device__ __forceinline__ unsigned a_off(int R, int C) const { return (unsigned)(R * 128 + C) * 2u; }
    __device__ __forceinline__ unsigned b_off(int R, int C) const { return (unsigned)((128 * (R & 63) + (R >> 6)) * 1024 + C) * 2u; }
    __device__ __forceinline__ size_t a_hstep() const { return (size_t)HALF * 128 * 2; }
    __device__ __forceinline__ size_t b_hstep() const { return (size_t)2 * 1024 * 2; }
    __device__ __forceinline__ size_t a_kstep() const { return BK * 2; }
    __device__ __forceinline__ size_t b_kstep() const { return BK * 2; }
};
struct GeoP2 {
    const char* A; const char* B;
    __device__ __forceinline__ int nt() const { return 2; }
    __device__ __forceinline__ const char* a_base(const Unit&) const { return A + opaque_zero(); }
    __device__ __forceinline__ const char* b_base(const Unit& u) const { const int ep = u.pn & 63, g = (u.pn >> 6) & 7, b = u.pn >> 9; return B + ((size_t)(g * 256 + 2 * ep) * M + (size_t)b * SEQ) * 2; }
    __device__ __forceinline__ unsigned a_off(int R, int C) const { return (unsigned)(R * 128 + C) * 2u; }
    __device__ __forceinline__ unsigned b_off(int R, int C) const { return (unsigned)(R * 64 + C) * 2u; }
    __device__ __forceinline__ size_t a_hstep() const { return (size_t)HALF * 128 * 2; }
    __device__ __forceinline__ size_t b_hstep() const { return (size_t)M * 2; }
    __device__ __forceinline__ size_t a_kstep() const { return BK * 2; }
    __device__ __forceinline__ size_t b_kstep() const { return (size_t)128 * M * 2; }
};

struct EpiSwiGLU8; template <bool FIRST> struct EpiSwiGLU8Q; struct EpiBf16S;
template <class E> struct AccT { using T = f32x4; static constexpr bool I8 = false; };
template <> struct AccT<EpiSwiGLU8> { using T = i32x4; static constexpr bool I8 = true; };
template <> struct AccT<EpiSwiGLU8Q<true>> { using T = i32x4; static constexpr bool I8 = true; };
template <> struct AccT<EpiSwiGLU8Q<false>> { using T = i32x4; static constexpr bool I8 = true; };
template <> struct AccT<EpiBf16S> { using T = i32x4; static constexpr bool I8 = true; };
template <class Epi, class Geo, class Ord>
__device__ __forceinline__ void gemm_phase(LAS unsigned char* lds, const int wid_in, const Geo geo, const Ord& S, const Epi& E) {
    int wid = wid_in; asm volatile("" : "+s"(wid));
    const int lane = lane_fresh(), tid = wid * 64 + lane, wr = wid >> 2, wc = wid & 3, fr = lane & 15, fq = lane >> 4;
    const int nt = geo.nt();
    unsigned voffA[2], voffB[2];
#pragma unroll
    for (int i = 0; i < 2; ++i) { int R, C; stage_rc(tid * 16 + i * 8192, R, C); const int Rb = (R & ~31) + perm32(R & 31);
        voffA[i] = geo.a_off(R, C); voffB[i] = geo.b_off(Rb, C); }
    const size_t kstepA = geo.a_kstep(), kstepB = geo.b_kstep(), hstepA = geo.a_hstep(), hstepB = geo.b_hstep();
    const unsigned ldsw = (unsigned)wid * 1024u;
    const int aoff = lds_byte(wr * 64 + fr, fq * 8), boff = lds_byte(wc * 32 + fr, fq * 8);
#define PG8_SA(b, h) (((b) * 2 + (h)) * HTB)
#define PG8_SB(b, h) ((4 + (b) * 2 + (h)) * HTB)
#define PG8_STAGE(bufoff, gbase, voff) do { _Pragma("unroll") for (int _i = 0; _i < 2; ++_i) \
        __builtin_amdgcn_global_load_lds((const unsigned*)((const char*)(gbase) + (voff)[_i]), (LAS unsigned*)(lds + (bufoff) + ldsw + _i * 8192), 16, 0, 0); } while (0)
#define PG8_LDA(dst, b, h) do { _Pragma("unroll") for (int m = 0; m < 4; ++m) _Pragma("unroll") for (int k = 0; k < 2; ++k) dst[m][k] = *(const LAS bf16x8*)(lds + PG8_SA(b, h) + aoff + m * 2048 + k * 1024); } while (0)
#define PG8_LDB(dst, b, h) do { _Pragma("unroll") for (int n = 0; n < 2; ++n) _Pragma("unroll") for (int k = 0; k < 2; ++k) dst[n][k] = *(const LAS bf16x8*)(lds + PG8_SB(b, h) + boff + n * 2048 + k * 1024); } while (0)
#define PG8_MMA(ai, bj, At, Bt) do { if constexpr ((ai) == 1 && Epi::SKIP_AI1) break; __builtin_amdgcn_s_setprio(1); _Pragma("unroll") for (int m = 0; m < 4; ++m) _Pragma("unroll") for (int n = 0; n < 2; ++n) _Pragma("unroll") for (int k = 0; k < 2; ++k) \
        { if constexpr (AccT<Epi>::I8) acc[ai][bj][m][n] = __builtin_amdgcn_mfma_i32_16x16x64_i8(__builtin_bit_cast(i32x4, Bt[n][k]), __builtin_bit_cast(i32x4, At[m][k]), acc[ai][bj][m][n], 0, 0, 0); \
          else acc[ai][bj][m][n] = __builtin_amdgcn_mfma_f32_16x16x32_bf16(Bt[n][k], At[m][k], acc[ai][bj][m][n], 0, 0, 0); } __builtin_amdgcn_s_setprio(0); } while (0)
#define PG8_WAIT_V(n) asm volatile("s_waitcnt vmcnt(" #n ")" ::: "memory")
#define PG8_WAIT_L(n) asm volatile("s_waitcnt lgkmcnt(" #n ")" ::: "memory")
#define PG8_BAR __builtin_amdgcn_s_barrier()
#define PG8_SCHED __builtin_amdgcn_sched_barrier(0)
    Unit cur, nxt; int ui = 0;
    if (!S.next(0, cur)) return;
    typedef typename AccT<Epi>::T acc_t;
    acc_t acc[2][2][4][2];
#pragma unroll
    for (int a = 0; a < 2; ++a)
#pragma unroll
        for (int b = 0; b < 2; ++b)
#pragma unroll
            for (int m = 0; m < 4; ++m)
#pragma unroll
                for (int n = 0; n < 2; ++n) acc[a][b][m][n] = (acc_t){0, 0, 0, 0};
    bf16x8 At[4][2], B0[2][2], B1[2][2];
    const char* cA = geo.a_base(cur); const char* cB = geo.b_base(cur);
    PG8_STAGE(PG8_SB(0, 0), cB, voffB); PG8_STAGE(PG8_SB(0, 1), cB + hstepB, voffB); PG8_STAGE(PG8_SA(0, 0), cA, voffA); PG8_STAGE(PG8_SA(0, 1), cA + hstepA, voffA);
    if (wr == 1) PG8_BAR;
    PG8_WAIT_V(2); PG8_BAR;
    PG8_STAGE(PG8_SB(1, 0), cB + kstepB, voffB); PG8_STAGE(PG8_SA(1, 0), cA + kstepA, voffA); PG8_STAGE(PG8_SB(1, 1), cB + hstepB + kstepB, voffB);
    PG8_WAIT_V(6); PG8_BAR;
    for (;;) {
        const bool has_next = S.next(ui + 1, nxt);
        const char* nA = has_next ? geo.a_base(nxt) : cA; const char* nB = has_next ? geo.b_base(nxt) : cB;
        for (int t = 0; t < nt; t += 2) {
            const bool last = (t == nt - 2);
            const char* a1 = cA + (size_t)(t + 1) * kstepA;
            const char* a2 = last ? nA : cA + (size_t)(t + 2) * kstepA; const char* b2 = last ? nB : cB + (size_t)(t + 2) * kstepB;
            const char* a3 = a2 + kstepA; const char* b3 = b2 + kstepB;
            PG8_LDB(B0, 0, 0); PG8_LDB(B1, 0, 1); PG8_SCHED; PG8_LDA(At, 0, 0); PG8_STAGE(PG8_SA(1, 1), a1 + hstepA, voffA);
            PG8_WAIT_V(8); PG8_WAIT_L(0); PG8_BAR; PG8_MMA(0, 0, At, B0); PG8_MMA(0, 1, At, B1); PG8_BAR; PG8_SCHED;
            PG8_LDA(At, 0, 1); PG8_STAGE(PG8_SB(0, 0), b2, voffB); PG8_STAGE(PG8_SB(0, 1), b2 + hstepB, voffB); PG8_STAGE(PG8_SA(0, 0), a2, voffA);
            PG8_WAIT_V(8); PG8_WAIT_L(0); PG8_BAR; PG8_MMA(1, 0, At, B0); PG8_MMA(1, 1, At, B1); PG8_BAR; PG8_SCHED;
            PG8_LDB(B0, 1, 0); PG8_LDB(B1, 1, 1); PG8_SCHED; PG8_LDA(At, 1, 0); PG8_STAGE(PG8_SA(0, 1), a2 + hstepA, voffA);
            PG8_WAIT_V(8); PG8_WAIT_L(0); PG8_BAR; PG8_MMA(0, 0, At, B0); PG8_MMA(0, 1, At, B1); PG8_BAR; PG8_SCHED;
            PG8_LDA(At, 1, 1); PG8_STAGE(PG8_SB(1, 0), b3, voffB); PG8_STAGE(PG8_SB(1, 1), b3 + hstepB, voffB); PG8_STAGE(PG8_SA(1, 0), a3, voffA);
            PG8_WAIT_V(8); PG8_WAIT_L(0); PG8_BAR; PG8_MMA(1, 0, At, B0); PG8_MMA(1, 1, At, B1); PG8_BAR; PG8_SCHED;
        }
        if (wr == 0) PG8_BAR;
        { const int le = lane_fresh(); E(acc, cur, wr, wc, le & 15, le >> 4); }
        if (!has_next) break;
#pragma unroll
        for (int a = 0; a < 2; ++a)
#pragma unroll
            for (int b = 0; b < 2; ++b)
#pragma unroll
                for (int m = 0; m < 4; ++m)
#pragma unroll
                    for (int n = 0; n < 2; ++n) acc[a][b][m][n] = (acc_t){0, 0, 0, 0};
        cur = nxt; cA = nA; cB = nB; ++ui;
        if (wr == 1) PG8_BAR;
    }
    PG8_WAIT_V(0);
    PG8_BAR;
#undef PG8_SA
#undef PG8_SB
#undef PG8_STAGE
#undef PG8_LDA
#undef PG8_LDB
#undef PG8_MMA
#undef PG8_WAIT_V
#undef PG8_WAIT_L
#undef PG8_BAR
#undef PG8_SCHED
}

struct EpiBf16 {
    static constexpr bool SKIP_AI1 = false;
    bf16* O; size_t ldc;
    __device__ __forceinline__ void operator()(const f32x4 (&acc)[2][2][4][2], const Unit& u, int wr, int wc, int fr, int fq) const {
        const int row0 = u.pm * BM + wr * 64 + fr, col0 = u.pn * BM + wc * 32 + 8 * fq;
#pragma unroll
        for (int ai = 0; ai < 2; ++ai)
#pragma unroll
            for (int m = 0; m < 4; ++m) { bf16* rowp = O + (size_t)(row0 + ai * HALF + m * 16) * ldc + col0;
#pragma unroll
                for (int bj = 0; bj < 2; ++bj) { const f32x4 v0 = acc[ai][bj][m][0], v1 = acc[ai][bj][m][1];
                    u32x4 w; w.x = cvt_pk_bf16(v0[0], v0[1]); w.y = cvt_pk_bf16(v0[2], v0[3]); w.z = cvt_pk_bf16(v1[0], v1[1]); w.w = cvt_pk_bf16(v1[2], v1[3]);
                    *(u32x4*)(rowp + bj * HALF) = w; } }
    }
};
__device__ __forceinline__ float silu_mul(float g, float u) { return g * u * __builtin_amdgcn_rcpf(1.0f + __expf(-g)); }
struct EpiSwiGLU {
    static constexpr bool SKIP_AI1 = false;
    bf16* O;
    __device__ __forceinline__ void operator()(const f32x4 (&acc)[2][2][4][2], const Unit& u, int wr, int wc, int fr, int fq) const {
        const int row0 = u.pm * BM + wr * 64 + fr, col0 = u.pn * HALF + wc * 32 + 8 * fq;
#pragma unroll
        for (int ai = 0; ai < 2; ++ai)
#pragma unroll
            for (int m = 0; m < 4; ++m) { bf16* rowp = O + (size_t)(row0 + ai * HALF + m * 16) * DFF + col0;
                const f32x4 g0 = acc[ai][0][m][0], g1 = acc[ai][0][m][1], u0 = acc[ai][1][m][0], u1 = acc[ai][1][m][1];
                u32x4 w; w.x = cvt_pk_bf16(silu_mul(g0[0], u0[0]), silu_mul(g0[1], u0[1])); w.y = cvt_pk_bf16(silu_mul(g0[2], u0[2]), silu_mul(g0[3], u0[3]));
                w.z = cvt_pk_bf16(silu_mul(g1[0], u1[0]), silu_mul(g1[1], u1[1])); w.w = cvt_pk_bf16(silu_mul(g1[2], u1[2]), silu_mul(g1[3], u1[3]));
                *(u32x4*)rowp = w; }
    }
};
struct EpiSwiGLU8 {
    static constexpr bool SKIP_AI1 = false;
    bf16* O; const float* SA; const unsigned* AM;
    __device__ __forceinline__ void operator()(const i32x4 (&acc)[2][2][4][2], const Unit& u, int wr, int wc, int fr, int fq) const {
        const int row0 = u.pm * BM + wr * 64 + fr, col0 = u.pn * HALF + wc * 32 + 8 * fq, cw = u.pn * BM + wc * 32 + 8 * fq;
        f32x4 sg[2], su[2]; float sa[2][4];
#pragma unroll
        for (int n = 0; n < 2; ++n) { sg[n] = __builtin_bit_cast(f32x4, *(const u32x4*)(AM + cw + 4 * n)); su[n] = __builtin_bit_cast(f32x4, *(const u32x4*)(AM + cw + HALF + 4 * n)); }
#pragma unroll
        for (int ai = 0; ai < 2; ++ai)
#pragma unroll
            for (int m = 0; m < 4; ++m) sa[ai][m] = SA[row0 + ai * HALF + m * 16];
#pragma unroll
        for (int n = 0; n < 2; ++n) { sg[n] *= (1.0f / 127.0f); su[n] *= (1.0f / 127.0f); }
#pragma unroll
        for (int ai = 0; ai < 2; ++ai)
#pragma unroll
            for (int m = 0; m < 4; ++m) { bf16* rowp = O + (size_t)(row0 + ai * HALF + m * 16) * DFF + col0; const float s = sa[ai][m];
                const f32x4 g0 = __builtin_convertvector(acc[ai][0][m][0], f32x4) * (sg[0] * s), g1 = __builtin_convertvector(acc[ai][0][m][1], f32x4) * (sg[1] * s);
                const f32x4 u0 = __builtin_convertvector(acc[ai][1][m][0], f32x4) * (su[0] * s), u1 = __builtin_convertvector(acc[ai][1][m][1], f32x4) * (su[1] * s);
                u32x4 w; w.x = cvt_pk_bf16(silu_mul(g0[0], u0[0]), silu_mul(g0[1], u0[1])); w.y = cvt_pk_bf16(silu_mul(g0[2], u0[2]), silu_mul(g0[3], u0[3]));
                w.z = cvt_pk_bf16(silu_mul(g1[0], u1[0]), silu_mul(g1[1], u1[1])); w.w = cvt_pk_bf16(silu_mul(g1[2], u1[2]), silu_mul(g1[3], u1[3]));
                *(u32x4*)rowp = w; }
    }
};
__device__ __forceinline__ float xlane(float v, int mask, int lane) { return __builtin_bit_cast(float, __builtin_amdgcn_ds_bpermute((lane ^ mask) << 2, __builtin_bit_cast(int, v))); }
__device__ __forceinline__ unsigned q8c_pack(float a, float b, float c, float d, float inv) {
    const unsigned ua = __float_as_uint(__builtin_amdgcn_fmed3f(a * inv, -127.0f, 127.0f) + 12582912.0f), ub = __float_as_uint(__builtin_amdgcn_fmed3f(b * inv, -127.0f, 127.0f) + 12582912.0f);
    const unsigned uc = __float_as_uint(__builtin_amdgcn_fmed3f(c * inv, -127.0f, 127.0f) + 12582912.0f), ud = __float_as_uint(__builtin_amdgcn_fmed3f(d * inv, -127.0f, 127.0f) + 12582912.0f);
    return __builtin_amdgcn_perm(__builtin_amdgcn_perm(ud, uc, 0x0c0c0400u), __builtin_amdgcn_perm(ub, ua, 0x0c0c0400u), 0x05040100u);
}
constexpr float Q2_CLIP = 6.0f;
template <bool FIRST>
struct EpiSwiGLU8Q {
    static constexpr bool SKIP_AI1 = false;
    unsigned char* O8; const float* SA; const unsigned* AM; float* S2; LAS float* xl;
    __device__ __forceinline__ void row8(float (&h)[8], const i32x4& ag0, const i32x4& ag1, const i32x4& au0, const i32x4& au1, const f32x4 (&sg)[2], const f32x4 (&su)[2], float s, int lane) const {
        const f32x4 g0 = __builtin_convertvector(ag0, f32x4) * (sg[0] * s), g1 = __builtin_convertvector(ag1, f32x4) * (sg[1] * s);
        const f32x4 u0 = __builtin_convertvector(au0, f32x4) * (su[0] * s), u1 = __builtin_convertvector(au1, f32x4) * (su[1] * s);
        h[0] = silu_mul(g0[0], u0[0]); h[1] = silu_mul(g0[1], u0[1]); h[2] = silu_mul(g0[2], u0[2]); h[3] = silu_mul(g0[3], u0[3]);
        h[4] = silu_mul(g1[0], u1[0]); h[5] = silu_mul(g1[1], u1[1]); h[6] = silu_mul(g1[2], u1[2]); h[7] = silu_mul(g1[3], u1[3]);
#pragma unroll
        for (int st = 1; st < 8; st <<= 1)
#pragma unroll
            for (int j = 0; j < 8; ++j) if ((j & st) == 0) { const float a = h[j], b = h[j | st]; h[j] = a + b; h[j | st] = a - b; }
#pragma unroll
        for (int j = 0; j < 8; j += 2) {
            const auto r = __builtin_amdgcn_permlane16_swap(__float_as_uint(h[j]), __float_as_uint(h[j + 1]), false, false);
            const float a = __uint_as_float(r[0]), b = __uint_as_float(r[1]);
            const auto q = __builtin_amdgcn_permlane16_swap(__float_as_uint(a + b), __float_as_uint(a - b), false, false);
            h[j] = __uint_as_float(q[0]); h[j + 1] = __uint_as_float(q[1]); }
#pragma unroll
        for (int j = 0; j < 8; j += 2) {
            const auto r = __builtin_amdgcn_permlane32_swap(__float_as_uint(h[j]), __float_as_uint(h[j + 1]), false, false);
            const float a = __uint_as_float(r[0]), b = __uint_as_float(r[1]);
            const auto q = __builtin_amdgcn_permlane32_swap(__float_as_uint(a + b), __float_as_uint(a - b), false, false);
            h[j] = __uint_as_float(q[0]); h[j + 1] = __uint_as_float(q[1]); }
    }
    __device__ __forceinline__ void operator()(const i32x4 (&acc)[2][2][4][2], const Unit& u, int wr, int wc, int fr, int fq) const {
        const int lane = fr + 16 * fq;
        const int row0 = u.pm * BM + wr * 64 + fr, col0 = u.pn * HALF + wc * 32 + 8 * fq, cw = u.pn * BM + wc * 32 + 8 * fq;
        f32x4 sg[2], su[2]; float sa[2][4], inv[2][4];
#pragma unroll
        for (int n = 0; n < 2; ++n) { sg[n] = __builtin_bit_cast(f32x4, *(const u32x4*)(AM + cw + 4 * n)); su[n] = __builtin_bit_cast(f32x4, *(const u32x4*)(AM + cw + HALF + 4 * n)); }
#pragma unroll
        for (int ai = 0; ai < 2; ++ai)
#pragma unroll
            for (int m = 0; m < 4; ++m) { sa[ai][m] = SA[row0 + ai * HALF + m * 16]; if constexpr (!FIRST) inv[ai][m] = S2[row0 + ai * HALF + m * 16]; }
#pragma unroll
        for (int n = 0; n < 2; ++n) { sg[n] *= (1.0f / 127.0f); su[n] *= (1.0f / 127.0f); }
        if constexpr (FIRST) {
#pragma unroll
            for (int ai = 0; ai < 2; ++ai)
#pragma unroll
                for (int m = 0; m < 4; ++m) { float h[8]; row8(h, acc[ai][0][m][0], acc[ai][0][m][1], acc[ai][1][m][0], acc[ai][1][m][1], sg, su, sa[ai][m], lane);
                    float ss = (h[0] * h[0] + h[1] * h[1]) + (h[2] * h[2] + h[3] * h[3]) + (h[4] * h[4] + h[5] * h[5]) + (h[6] * h[6] + h[7] * h[7]);
                    ss += xlane(ss, 16, lane); ss += xlane(ss, 32, lane);
                    if (fq == 0) xl[(ai * HALF + wr * 64 + m * 16 + fr) * 4 + wc] = ss; }
            asm volatile("s_waitcnt lgkmcnt(0)" ::: "memory"); __builtin_amdgcn_s_barrier();
#pragma unroll
            for (int ai = 0; ai < 2; ++ai)
#pragma unroll
                for (int m = 0; m < 4; ++m) { const f32x4 t = *(const LAS f32x4*)(xl + (ai * HALF + wr * 64 + m * 16 + fr) * 4);
                    const float sc = Q2_CLIP * (1.0f / 127.0f) * sqrtf(((t[0] + t[1]) + (t[2] + t[3])) * (1.0f / 128.0f));
                    inv[ai][m] = sc; if (wc == 0 && fq == 0) S2[row0 + ai * HALF + m * 16] = sc; }
        }
#pragma unroll
        for (int ai = 0; ai < 2; ++ai)
#pragma unroll
            for (int m = 0; m < 4; ++m) { float h[8]; row8(h, acc[ai][0][m][0], acc[ai][0][m][1], acc[ai][1][m][0], acc[ai][1][m][1], sg, su, sa[ai][m], lane);
                const float iv = inv[ai][m] > 0.f ? __builtin_amdgcn_rcpf(inv[ai][m]) : 0.f;
                u32x2 w; w.x = q8c_pack(h[0], h[1], h[2], h[3], iv); w.y = q8c_pack(h[4], h[5], h[6], h[7], iv);
                *(u32x2*)(O8 + (size_t)(row0 + ai * HALF + m * 16) * DFF + col0) = w; }
    }
};
struct EpiBf16S {
    static constexpr bool SKIP_AI1 = false;
    bf16* O; const float* S2; const unsigned* AMD;
    __device__ __forceinline__ void operator()(const i32x4 (&acc)[2][2][4][2], const Unit& u, int wr, int wc, int fr, int fq) const {
        const int row0 = u.pm * BM + wr * 64 + fr, col0 = u.pn * BM + wc * 32 + 8 * fq;
        f32x4 sw[2][2]; float sr[2][4];
#pragma unroll
        for (int bj = 0; bj < 2; ++bj)
#pragma unroll
            for (int n = 0; n < 2; ++n) sw[bj][n] = __builtin_bit_cast(f32x4, *(const u32x4*)(AMD + col0 + bj * HALF + 4 * n));
#pragma unroll
        for (int ai = 0; ai < 2; ++ai)
#pragma unroll
            for (int m = 0; m < 4; ++m) sr[ai][m] = S2[row0 + ai * HALF + m * 16];
#pragma unroll
        for (int bj = 0; bj < 2; ++bj)
#pragma unroll
            for (int n = 0; n < 2; ++n) sw[bj][n] *= (1.0f / (127.0f * 32.0f));
#pragma unroll
        for (int ai = 0; ai < 2; ++ai)
#pragma unroll
            for (int m = 0; m < 4; ++m) { bf16* rowp = O + (size_t)(row0 + ai * HALF + m * 16) * DM + col0; const float s = sr[ai][m];
#pragma unroll
                for (int bj = 0; bj < 2; ++bj) { const f32x4 v0 = __builtin_convertvector(acc[ai][bj][m][0], f32x4) * (sw[bj][0] * s), v1 = __builtin_convertvector(acc[ai][bj][m][1], f32x4) * (sw[bj][1] * s);
                    u32x4 w; w.x = cvt_pk_bf16(v0[0], v0[1]); w.y = cvt_pk_bf16(v0[2], v0[3]); w.z = cvt_pk_bf16(v1[0], v1[1]); w.w = cvt_pk_bf16(v1[2], v1[3]);
                    *(u32x4*)(rowp + bj * HALF) = w; } }
    }
};
struct EpiRope {
    static constexpr bool SKIP_AI1 = false;
    static constexpr bool HOOK = false;
    bf16* Q; bf16* KB; const float* COS; const float* SIN; bf16* U;
    __device__ __forceinline__ void operator()(const f32x4 (&acc)[2][2][4][2], const Unit& u, int wr, int wc, int fr, int fq) const {
        if (u.pn >= 5) {
            const int row0u = u.pm * BM + wr * 64 + fr, col0 = (u.pn - 5) * BM + wc * 32 + 8 * fq;
#pragma unroll
            for (int ai = 0; ai < 2; ++ai)
#pragma unroll
                for (int m = 0; m < 4; ++m) { bf16* rowp = U + (size_t)(row0u + ai * HALF + m * 16) * 1024 + col0;
#pragma unroll
                    for (int bj = 0; bj < 2; ++bj) { const f32x4 v0 = acc[ai][bj][m][0], v1 = acc[ai][bj][m][1];
                        u32x4 w; w.x = cvt_pk_bf16(v0[0], v0[1]); w.y = cvt_pk_bf16(v0[2], v0[3]); w.z = cvt_pk_bf16(v1[0], v1[1]); w.w = cvt_pk_bf16(v1[2], v1[3]);
                        *(u32x4*)(rowp + bj * HALF) = w; } }
            return;
        }
        const int row0 = u.pm * BM + wr * 64 + fr, hsel = wc >> 1, d0 = 32 * (wc & 1) + 8 * fq;
        const bool isq = u.pn < 4; const float sc = isq ? QSCALE : 1.0f;
        bf16* base = isq ? Q + (2 * u.pn + hsel) * 128 + d0 : KB + hsel * 128 + d0; const size_t ld = isq ? NQ : NKV;
#pragma unroll
        for (int ai = 0; ai < 2; ++ai) {
            f32x4 c0[4], c1[4], s0[4], s1[4];
#pragma unroll
            for (int m = 0; m < 4; ++m) { const int pos = (row0 + ai * HALF + m * 16) & (SEQ - 1);
                c0[m] = *(const f32x4*)(COS + pos * 64 + d0); c1[m] = *(const f32x4*)(COS + pos * 64 + d0 + 4); s0[m] = *(const f32x4*)(SIN + pos * 64 + d0); s1[m] = *(const f32x4*)(SIN + pos * 64 + d0 + 4); }
            u32x4 w1[4], w2[4];
#pragma unroll
            for (int m = 0; m < 4; ++m) {
                const f32x4 a0 = acc[ai][0][m][0], a1 = acc[ai][0][m][1], b0 = acc[ai][1][m][0], b1 = acc[ai][1][m][1];
                const f32x4 o10 = (a0 * c0[m] - b0 * s0[m]) * sc, o11 = (a1 * c1[m] - b1 * s1[m]) * sc, o20 = (a0 * s0[m] + b0 * c0[m]) * sc, o21 = (a1 * s1[m] + b1 * c1[m]) * sc;
                w1[m].x = cvt_pk_bf16(o10[0], o10[1]); w1[m].y = cvt_pk_bf16(o10[2], o10[3]); w1[m].z = cvt_pk_bf16(o11[0], o11[1]); w1[m].w = cvt_pk_bf16(o11[2], o11[3]);
                w2[m].x = cvt_pk_bf16(o20[0], o20[1]); w2[m].y = cvt_pk_bf16(o20[2], o20[3]); w2[m].z = cvt_pk_bf16(o21[0], o21[1]); w2[m].w = cvt_pk_bf16(o21[2], o21[3]); }
#pragma unroll
            for (int m = 0; m < 4; ++m) { bf16* rp = base + (size_t)(row0 + ai * HALF + m * 16) * ld; *(u32x4*)rp = w1[m]; *(u32x4*)(rp + 64) = w2[m]; }
        }
    }
};
struct EpiTwiddle {
    static constexpr bool SKIP_AI1 = false;
    bf16* Y2;
    __device__ __forceinline__ void operator()(const f32x4 (&acc)[2][2][4][2], const Unit& u, int wr, int wc, int fr, int fq) const {
        if (wr != 0) return;
        int zz = 0; asm volatile("" : "+v"(zz));
        const int ep = u.pn & 63, g = (u.pn >> 6) & 7, b = u.pn >> 9, s20 = wc * 32 + 8 * fq + zz;
#pragma unroll
        for (int m = 0; m < 4; ++m) { const int k1 = 16 * m + fr;
#pragma unroll
            for (int bj = 0; bj < 2; ++bj) { const int e = 2 * ep + bj; bf16* rp = Y2 + ((size_t)((b * 64 + k1) * 8 + g) * 128 + e) * 256 + s20;
                float re[8], im[8];
#pragma unroll
                for (int n = 0; n < 2; ++n)
#pragma unroll
                    for (int i = 0; i < 4; ++i) { const int s2 = s20 + 4 * n + i; const float fr_ = (float)((k1 * s2) & 8191) * (1.0f / 8192.0f);
                        const float ct = __builtin_amdgcn_cosf(fr_), st = __builtin_amdgcn_sinf(fr_); const float yr = acc[0][bj][m][n][i], yi = acc[1][bj][m][n][i];
                        re[4 * n + i] = yr * ct + yi * st; im[4 * n + i] = yi * ct - yr * st; }
                u32x4 w1, w2; w1.x = cvt_pk_bf16(re[0], re[1]); w1.y = cvt_pk_bf16(re[2], re[3]); w1.z = cvt_pk_bf16(re[4], re[5]); w1.w = cvt_pk_bf16(re[6], re[7]);
                w2.x = cvt_pk_bf16(im[0], im[1]); w2.y = cvt_pk_bf16(im[2], im[3]); w2.z = cvt_pk_bf16(im[4], im[5]); w2.w = cvt_pk_bf16(im[6], im[7]);
                *(u32x4*)rp = w1; *(u32x4*)(rp + 128) = w2; } }
    }
};
struct EpiDftOut {
    static constexpr bool SKIP_AI1 = true;
    bf16* MIX;
    __device__ __forceinline__ void operator()(const f32x4 (&acc)[2][2][4][2], const Unit& u, int wr, int wc, int fr, int fq) const {
        const int gp = u.pn & 3, k1 = (u.pn >> 2) & 63, b = u.pn >> 8;
#pragma unroll
        for (int m = 0; m < 4; ++m) { const int k2 = 64 * wr + 16 * m + fr; bf16* rp = MIX + (size_t)(b * SEQ + k1 + 64 * k2) * DM + 1024 + gp * 256 + wc * 32 + 8 * fq;
#pragma unroll
            for (int bj = 0; bj < 2; ++bj) { const f32x4 v0 = acc[0][bj][m][0], v1 = acc[0][bj][m][1];
                u32x4 w; w.x = cvt_pk_bf16(v0[0], v0[1]); w.y = cvt_pk_bf16(v0[2], v0[3]); w.z = cvt_pk_bf16(v1[0], v1[1]); w.w = cvt_pk_bf16(v1[2], v1[3]);
                *(u32x4*)(rp + bj * 128) = w; } }
    }
};
}

#define XB_TMO      128
#define XB_XCNT(j)  (256  + 64 * (j))
#define XB_XSUB(j)  (1280 + 64 * (j))
#define XB_XGEN(j)  (2304 + 64 * (j))
#define XB_TOP      3328
#define XB_TOPGEN   3392
#define XCD_BAR_WORDS 3456
#define XB_SPIN_CAP (1u << 18)
__device__ __forceinline__ unsigned xb_ld(unsigned* p)              { return __hip_atomic_load(p, __ATOMIC_RELAXED, __HIP_MEMORY_SCOPE_AGENT); }
__device__ __forceinline__ unsigned xb_add(unsigned* p, unsigned v) { return __hip_atomic_fetch_add(p, v, __ATOMIC_RELAXED, __HIP_MEMORY_SCOPE_AGENT); }
__device__ __forceinline__ unsigned xb_xcc_id() { return (unsigned)__builtin_amdgcn_s_getreg((3 << 11) | 20) & 0xFu; }
#define XB_SPIN(cond, bar) do { unsigned _sp = 0; while (cond) { __builtin_amdgcn_s_sleep(1); \
    if ((++_sp & 255u) == 0u) { if (xb_ld(&(bar)[XB_TMO])) break; if (_sp > XB_SPIN_CAP) { atomicAdd(&(bar)[XB_TMO], 1u); break; } } } } while (0)
struct XcdBarrier { unsigned* bar; unsigned x; volatile LAS unsigned* st; };
__device__ __forceinline__ XcdBarrier xcd_barrier_post(unsigned* bar, volatile LAS unsigned* st) {
    XcdBarrier b; b.bar = bar; b.x = xb_xcc_id(); b.st = st;
    if (threadIdx.x == 0) (void)xb_add(&bar[XB_XCNT(b.x)], 1u);
    return b;
}
__device__ __forceinline__ void xcd_barrier_complete(unsigned* bar, unsigned x, unsigned& nloc, unsigned& nx) {
    const unsigned G = gridDim.x * gridDim.y * gridDim.z;
    unsigned sum, cnt, mine, sp = 0u;
    for (;;) {
        sum = 0u; cnt = 0u; mine = 0u;
#pragma unroll
        for (unsigned j = 0; j < 16; ++j) { const unsigned c = xb_ld(&bar[XB_XCNT(j)]); sum += c; cnt += (c > 0u) ? 1u : 0u; mine = (j == x) ? c : mine; }
        if (sum == G) break;
        __builtin_amdgcn_s_sleep(1);
        if ((++sp & 255u) == 0u) { if (xb_ld(&bar[XB_TMO])) break; if (sp > XB_SPIN_CAP) { atomicAdd(&bar[XB_TMO], 1u); break; } }
    }
    nloc = mine > 0u ? mine : 1u; nx = cnt > 0u ? cnt : 1u;
}
__device__ __forceinline__ void xcd_barrier(const XcdBarrier& b, const bool leader) {
    asm volatile("s_waitcnt vmcnt(0)" ::: "memory");
    __syncthreads();
    if (leader) {
        unsigned* bar = b.bar;
        __builtin_amdgcn_s_waitcnt(0);
        unsigned nloc = b.st[0], nx = b.st[1];
        if (nloc == 0u) { xcd_barrier_complete(bar, b.x, nloc, nx); b.st[0] = nloc; b.st[1] = nx; }
        const unsigned old = xb_add(&bar[XB_XSUB(b.x)], 1u);
        const unsigned gen = old / nloc;
        if (old + 1u == (gen + 1u) * nloc) {
            __builtin_amdgcn_fence(__ATOMIC_RELEASE, "agent");
            asm volatile("s_waitcnt vmcnt(0)" ::: "memory");
            const unsigned og = xb_add(&bar[XB_TOP], 1u);
            const unsigned tg = og / nx;
            if (og + 1u == (tg + 1u) * nx) xb_add(&bar[XB_TOPGEN], 1u);
            else XB_SPIN(xb_ld(&bar[XB_TOPGEN]) == tg, bar);
            __builtin_amdgcn_fence(__ATOMIC_ACQUIRE, "agent");
            xb_add(&bar[XB_XGEN(b.x)], 1u);
            asm volatile("s_waitcnt vmcnt(0)" ::: "memory");
        } else {
            XB_SPIN(xb_ld(&bar[XB_XGEN(b.x)]) == gen, bar);
            __builtin_amdgcn_fence(__ATOMIC_ACQUIRE, "agent");
            asm volatile("s_waitcnt vmcnt(0)" ::: "memory");
        }
    }
    __syncthreads();
}

struct Args { const float* in[16]; float* out; unsigned char* ws; };
struct Frame {
    LAS unsigned char* lds; int tid, lane, wave, G, bid;
    const float *x_prompt, *x_sample, *c_prompt, *c_sample, *w_mod, *b_mod, *pre_g, *post_g, *w_gate, *w_up, *w_down, *w_in, *sink, *four_w, *branch_g, *w_out;
    bf16* XB; bf16* HB; float* OUT; unsigned char* ws;
};
__device__ __forceinline__ float shfl_xor_l(float v, int mask, int lane) { return __builtin_bit_cast(float, __builtin_amdgcn_ds_bpermute((lane ^ mask) << 2, __builtin_bit_cast(int, v))); }
__device__ __forceinline__ float wave_sum(float v, int lane) {
#pragma unroll
    for (int o = 1; o < 64; o <<= 1) v += shfl_xor_l(v, o, lane);
    return v;
}

__device__ __forceinline__ float wave_max(float v, int lane) {
#pragma unroll
    for (int o = 1; o < 64; o <<= 1) v = fmaxf(v, shfl_xor_l(v, o, lane));
    return v;
}
__device__ __forceinline__ unsigned q8_pack(float a, float b, float c, float d, float inv) {
    const unsigned ua = __float_as_uint(fmaf(a, inv, 12582912.0f)), ub = __float_as_uint(fmaf(b, inv, 12582912.0f)), uc = __float_as_uint(fmaf(c, inv, 12582912.0f)), ud = __float_as_uint(fmaf(d, inv, 12582912.0f));
    return __builtin_amdgcn_perm(__builtin_amdgcn_perm(ud, uc, 0x0c0c0400u), __builtin_amdgcn_perm(ub, ua, 0x0c0c0400u), 0x05040100u);
}

__device__ __forceinline__ void transpose_item(const float* W, size_t ldw, int K, bf16* WT, int dest_row0, int k0, int n0, LAS float* scr, int lane, unsigned* AMD = nullptr) {
#pragma unroll 8
    for (int i = 0; i < 32; ++i) { const int kk = 2 * i + (lane >> 5); scr[kk * 33 + (lane & 31)] = W[(size_t)(k0 + kk) * ldw + n0 + (lane & 31)]; }
    LDS_WAIT(); asm volatile("" ::: "memory");
    if (AMD) {
        LAS float* t = scr + (32 * (lane >> 5)) * 33 + (lane & 31);
        float v[32];
#pragma unroll
        for (int j = 0; j < 32; ++j) v[j] = t[j * 33];
#pragma unroll
        for (int st = 1; st < 32; st <<= 1)
#pragma unroll
            for (int j = 0; j < 32; ++j) if ((j & st) == 0) { const float a = v[j], b = v[j | st]; v[j] = a + b; v[j | st] = a - b; }
        float mx = 0.f;
#pragma unroll
        for (int j = 0; j < 32; ++j) { t[j * 33] = v[j]; mx = fmaxf(mx, fabsf(v[j])); }
        mx = fmaxf(mx, shfl_xor_l(mx, 32, lane));
        if (lane < 32) atomicMax(AMD + dest_row0 + lane, __float_as_uint(mx));
        LDS_WAIT(); asm volatile("" ::: "memory");
    }
    const int c = lane & 7;
#pragma unroll
    for (int j = 0; j < 4; ++j) { const int n = (lane >> 3) + 8 * j; const LAS float* s = scr + (8 * c) * 33 + n;
        u32x4 o; o.x = pk2(s[0 * 33], s[1 * 33]); o.y = pk2(s[2 * 33], s[3 * 33]); o.z = pk2(s[4 * 33], s[5 * 33]); o.w = pk2(s[6 * 33], s[7 * 33]);
        *(GAS u32x4*)(WT + (size_t)(dest_row0 + n) * K + k0 + 8 * c) = o; }
    LDS_WAIT(); asm volatile("" ::: "memory");
}
__device__ __forceinline__ void quant_item(const float* W, const unsigned* AM, unsigned char* W8T, int dest_row0, int k0, int n0, LAS float* scr, int lane) {
#pragma unroll 8
    for (int i = 0; i < 32; ++i) { const int kk = 2 * i + (lane >> 5); scr[kk * 33 + (lane & 31)] = W[(size_t)(k0 + kk) * DFF + n0 + (lane & 31)]; }
    const int n = lane >> 1, hf = lane & 1;
    const float am = __uint_as_float(AM[dest_row0 + n]), inv = am > 0.f ? 127.0f / am : 0.f;
    LDS_WAIT(); asm volatile("" ::: "memory");
    const LAS float* t = scr + (32 * hf) * 33 + n;
    u32x4 o0, o1;
    o0.x = q8_pack(t[0 * 33], t[1 * 33], t[2 * 33], t[3 * 33], inv);     o0.y = q8_pack(t[4 * 33], t[5 * 33], t[6 * 33], t[7 * 33], inv);
    o0.z = q8_pack(t[8 * 33], t[9 * 33], t[10 * 33], t[11 * 33], inv);   o0.w = q8_pack(t[12 * 33], t[13 * 33], t[14 * 33], t[15 * 33], inv);
    o1.x = q8_pack(t[16 * 33], t[17 * 33], t[18 * 33], t[19 * 33], inv); o1.y = q8_pack(t[20 * 33], t[21 * 33], t[22 * 33], t[23 * 33], inv);
    o1.z = q8_pack(t[24 * 33], t[25 * 33], t[26 * 33], t[27 * 33], inv); o1.w = q8_pack(t[28 * 33], t[29 * 33], t[30 * 33], t[31 * 33], inv);
    GAS unsigned char* dst = (GAS unsigned char*)(W8T + (size_t)(dest_row0 + n) * DM + k0 + 32 * hf);
    *(GAS u32x4*)dst = o0; *(GAS u32x4*)(dst + 16) = o1;
    LDS_WAIT(); asm volatile("" ::: "memory");
}
__device__ __forceinline__ bf16* wptr(Frame& F, int l, size_t off) { return (bf16*)(F.ws + WS_W + (size_t)l * W_LAYER + off); }

__device__ __forceinline__ void p0a(Frame& F) {
    {
        LAS float* sc = (LAS float*)F.lds;
        LAS float* red = (LAS float*)(F.lds + 40960);
        bool have_c = false;
        for (int it = F.bid; it < 144; it += F.G) {
            if (!have_c) {
                for (int i = F.tid; i < 5 * 2048; i += NTHREADS) { const int b = i >> 11, k = i & 2047; const float c = (b == 0) ? F.c_prompt[k] : F.c_sample[(b - 1) * 2048 + k]; sc[i] = c / (1.0f + __expf(-c)); }
                __syncthreads(); have_c = true;
            }
            const int l = it / 72, chunk = it % 72, col = chunk * 256 + 4 * F.lane;
            const float* wp = F.w_mod + (size_t)l * DM * NMOD + col;
            f32x4 a[5];
#pragma unroll
            for (int b = 0; b < 5; ++b) a[b] = (f32x4){0.f, 0.f, 0.f, 0.f};
            const int kbeg = F.wave * 256;
#pragma unroll 8
            for (int k = kbeg; k < kbeg + 256; ++k) { const f32x4 w = *(const f32x4*)(wp + (size_t)k * NMOD);
#pragma unroll
                for (int b = 0; b < 5; ++b) a[b] += w * sc[b * 2048 + k]; }
#pragma unroll
            for (int b = 0; b < 5; ++b) *(LAS f32x4*)(red + (F.wave * 5 + b) * 256 + 4 * F.lane) = a[b];
            __syncthreads();
            for (int o = F.tid; o < 5 * 256; o += NTHREADS) { const int b = o >> 8, cc = o & 255; float v = 0.f;
#pragma unroll
                for (int w = 0; w < 8; ++w) v += red[(w * 5 + b) * 256 + cc];
                const int jg = chunk * 256 + cc; v += F.b_mod[l * NMOD + jg];
                const int jj = jg / 6144, t = (jg % 6144) / 2048, cl = jg & 2047;
                float r;
                if (t == 0) r = v; else if (t == 1) r = F.pre_g[(l * 3 + jj) * DM + cl] * (1.0f + v); else r = ((jj == 1) ? 1.0f : 0.5f) * (1.0f + v) * F.post_g[(l * 3 + jj) * DM + cl];
                ((float*)(F.ws + WS_COEF))[((size_t)((l * 3 + jj) * 3 + t) * 5 + b) * DM + cl] = r; }
            __syncthreads();
        }
        __syncthreads();
    }
    {
        LAS float* red = (LAS float*)F.lds;
        unsigned* AM = (unsigned*)(F.ws + WS_AMAX);
        for (int it = (F.bid + F.G - 144 % F.G) % F.G; it < 704; it += F.G) {
            const int mat = it / 88, q = it % 88, chunk = q >> 2, kq = q & 3, up = mat & 1, lf = mat >> 1;
            const float* wp = (up ? F.w_up : F.w_gate) + (size_t)lf * DM * DFF + (size_t)(kq * 512 + F.wave * 64) * DFF + chunk * 256 + 4 * F.lane;
            f32x4 mx = (f32x4){0.f, 0.f, 0.f, 0.f};
#pragma unroll 8
            for (int k = 0; k < 64; ++k) { const f32x4 w = *(const f32x4*)(wp + (size_t)k * DFF);
                mx[0] = fmaxf(mx[0], fabsf(w[0])); mx[1] = fmaxf(mx[1], fabsf(w[1])); mx[2] = fmaxf(mx[2], fabsf(w[2])); mx[3] = fmaxf(mx[3], fabsf(w[3])); }
            *(LAS f32x4*)(red + F.wave * 256 + 4 * F.lane) = mx;
            __syncthreads();
            if (F.tid < 256) { float v = red[F.tid];
#pragma unroll
                for (int w = 1; w < 8; ++w) v = fmaxf(v, red[w * 256 + F.tid]);
                const int n = chunk * 256 + F.tid;
                atomicMax(AM + (size_t)lf * 11264 + 256 * (n >> 7) + (up ? 128 : 0) + (n & 127), __float_as_uint(v)); }
            __syncthreads();
        }
    }
    const int gt = F.bid * NTHREADS + F.tid, NGT = F.G * NTHREADS;
    for (int i = gt; i < SEQ * 64; i += NGT) { const int pos = i >> 6, k = i & 63; const float inv = (float)pow(10000.0, -(double)(2 * k) / 128.0); const float ang = (float)pos * inv;
        double sd, cd; sincos((double)ang, &sd, &cd); ((float*)(F.ws + WS_ROPE))[i] = (float)cd; ((float*)(F.ws + WS_ROPE + 2 * MiB))[i] = (float)sd; }
    for (int i = gt; i < 256 * 128; i += NGT) { const int R = i >> 7, c = i & 127, pp = R >> 7, kk = R & 127, part = c >> 6, s1 = c & 63; float v = 0.f;
        if (kk < 64) { const float fr = (float)((kk * s1) & 63) * (2.0f / 64.0f); const float cv = cospif(fr), sv = sinpif(fr); v = (pp == part) ? cv : (pp == 0 ? sv : -sv); v *= 0.125f; }
        ((bf16*)(F.ws + WS_D1))[i] = (bf16)f2bf(v); }
    for (int i = gt; i < 256 * 256; i += NGT) { const int R = i >> 8, c = i & 255, pp = c >> 7, s2 = c & 127; float v = 0.f;
        if (R < 128) { const float fr = (float)((R * s2) & 127) * (2.0f / 128.0f); v = (pp == 0 ? cospif(fr) : sinpif(fr)) * 0.08838834764831845f; }
        ((bf16*)(F.ws + WS_D2))[i] = (bf16)f2bf(v); }
    {
        LAS float* tab = (LAS float*)F.lds;
        if (F.tid < 128) { const float fr = (float)F.tid * (2.0f / 128.0f); tab[F.tid] = cospif(fr); tab[128 + F.tid] = sinpif(fr); }
        __syncthreads();
        for (int i = gt; i < 2 * 8 * 128 * 256; i += NGT) { const int e2 = i & 255, c = (i >> 8) & 127, lg = i >> 15; const int e = e2 & 127; const bool im = e2 >= 128;
            const float* wl = F.four_w + (size_t)lg * 128 * 128 + e; float s = 0.f;
#pragma unroll 8
            for (int m = 0; m < 128; ++m) s += tab[(im ? 128 : 0) + ((m * c) & 127)] * wl[m * 128];
            ((bf16*)(F.ws + WS_WCS))[((size_t)lg * 256 + e2) * 128 + c] = (bf16)f2bf((im ? -s : s) * 0.08838834764831845f); }
        __syncthreads();
    }
    {
        LAS float* scr = (LAS float*)(F.lds + F.wave * 16384);
        const int gw = F.bid * NWAVES + F.wave, NGW = F.G * NWAVES;
        constexpr int I_D = 2 * 88 * 64, I_QK = 32 * 72, I_V = 32 * 8, I_O = 32 * 64;
        constexpr int I_L = I_D + I_QK + I_V + I_O;
        for (int it = gw; it < 2 * I_L; it += NGW) {
            const int l = it / I_L; int r = it % I_L;
            if (r < I_D) { const int fi = r / (88 * 64), q = r % (88 * 64), kb = q / 64, nb = q % 64;
                transpose_item(F.w_down + (size_t)(l * 2 + fi) * DFF * DM, DM, DFF, wptr(F, l, W_D) + (size_t)fi * 2048 * 5632, nb * 32, kb * 64, nb * 32, scr, F.lane,
                               ((Q2_MASK >> (2 * l + fi)) & 1u) ? (unsigned*)(F.ws + WS_AMAXD) + (2 * l + fi) * 2048 : nullptr); continue; }
            r -= I_D;
            if (r < I_QK) { const int kb = r / 72, nb = r % 72; int n0 = nb * 32; int dest;
                if (nb >= 40) { dest = n0; n0 += 256; }
                else if (n0 < 1024) { const int head = n0 >> 7, half = (n0 >> 6) & 1, x = n0 & 63; dest = 256 * (head >> 1) + 128 * half + 64 * (head & 1) + x; }
                else { const int q = n0 - 1024, hs = q >> 7, half = (q >> 6) & 1, x = q & 63; dest = 1024 + 128 * half + 64 * hs + x; }
                transpose_item(F.w_in + (size_t)l * DM * NIN, NIN, DM, wptr(F, l, W_QK), dest, kb * 64, n0, scr, F.lane); continue; }
            r -= I_QK;
            if (r < I_V) { const int kb = r / 8, nb = r % 8;
                transpose_item(F.w_in + (size_t)l * DM * NIN, NIN, DM, wptr(F, l, W_V), nb * 32, kb * 64, 1280 + nb * 32, scr, F.lane); continue; }
            r -= I_V;
            { const int kb = r / 64, nb = r % 64;
                transpose_item(F.w_out + (size_t)l * DM * DM, DM, DM, wptr(F, l, W_O), nb * 32, kb * 64, nb * 32, scr, F.lane); }
        }
    }
}

__device__ __forceinline__ void p0b_quant(Frame& F) {
    LAS float* scr = (LAS float*)(F.lds + 65536 + F.wave * 8704);
    const int gw = F.bid * NWAVES + F.wave, NGW = F.G * NWAVES;
    constexpr int I_M = 32 * 176;
    for (int it = gw; it < 8 * I_M; it += NGW) {
        const int mat = it / I_M, q = it % I_M, kb = q / 176, nb = q % 176, n0 = nb * 32, up = mat & 1, lf = mat >> 1, l = lf >> 1, fi = lf & 1;
        quant_item((up ? F.w_up : F.w_gate) + (size_t)lf * DM * DFF, (const unsigned*)(F.ws + WS_AMAX) + (size_t)lf * 11264,
                   (unsigned char*)wptr(F, l, W_GU) + (size_t)fi * 11264 * 2048, 256 * (n0 >> 7) + (up ? 128 : 0) + (n0 & 127), kb * 64, n0, scr, F.lane);
    }
    for (int it = gw; it < 4 * 2048; it += NGW) {
        const int lf = it >> 11; if (!((Q2_MASK >> lf) & 1u)) continue;
        const unsigned char* src = (const unsigned char*)wptr(F, lf >> 1, W_D) + (size_t)(it & 4095) * 5632 * 2;
        unsigned char* dst = (unsigned char*)wptr(F, lf >> 1, W_D8) + (size_t)(it & 4095) * 5632;
        const float am = __uint_as_float(((const unsigned*)(F.ws + WS_AMAXD))[it]), inv = am > 0.f ? 127.0f / am : 0.f;
        u32x4 v[11];
#pragma unroll
        for (int j = 0; j < 11; ++j) v[j] = *(const u32x4*)(src + (size_t)(j * 64 + F.lane) * 16);
#pragma unroll
        for (int j = 0; j < 11; ++j) { u32x2 w; w.x = pg8::q8c_pack(bflo(v[j].x), bfhi(v[j].x), bflo(v[j].y), bfhi(v[j].y), inv); w.y = pg8::q8c_pack(bflo(v[j].z), bfhi(v[j].z), bflo(v[j].w), bfhi(v[j].w), inv);
            *(u32x2*)(dst + (size_t)(j * 64 + F.lane) * 8) = w; }
    }
}

struct NormRow { f32x4 x[8]; u32x2 y[8]; };
__device__ __forceinline__ void norm_load(Frame& F, NormRow& R, int row, bool first, bool do_post) {
    if (first) { const float* xr = ((row >> 13) == 0 ? F.x_prompt + (size_t)row * DM : F.x_sample + (size_t)(row - SEQ) * DM);
#pragma unroll
        for (int j = 0; j < 8; ++j) R.x[j] = *(const f32x4*)(xr + 4 * F.lane + 256 * j);
    } else { const bf16* xr = F.XB + (size_t)row * DM + 4 * F.lane;
#pragma unroll
        for (int j = 0; j < 8; ++j) { const u32x2 v = *(const u32x2*)(xr + 256 * j); R.x[j] = (f32x4){bflo(v.x), bfhi(v.x), bflo(v.y), bfhi(v.y)}; } }
    if (do_post) { const bf16* yr = (const bf16*)(F.ws + WS_Y) + (size_t)row * DM + 4 * F.lane;
#pragma unroll
        for (int j = 0; j < 8; ++j) R.y[j] = *(const u32x2*)(yr + 256 * j); }
}
__device__ __forceinline__ void norm_row(Frame& F, NormRow& R, int row, bool first, bool do_post, bool do_pre, bool q8, const LAS float* cf) {
    if (do_post) {
        float ss = 0.f;
#pragma unroll
        for (int j = 0; j < 8; ++j) { const float a = bflo(R.y[j].x), bb = bfhi(R.y[j].x), c = bflo(R.y[j].y), d = bfhi(R.y[j].y); ss += (a * a + bb * bb) + (c * c + d * d); }
        const float r = 1.0f / sqrtf(wave_sum(ss, F.lane) * (1.0f / DM) + RMS_EPS);
#pragma unroll
        for (int j = 0; j < 8; ++j) { const f32x4 y = (f32x4){bflo(R.y[j].x), bfhi(R.y[j].x), bflo(R.y[j].y), bfhi(R.y[j].y)}; R.x[j] += *(const LAS f32x4*)(cf + 4 * F.lane + 256 * j) * (y * r); }
    }
    if (!do_pre) {
        float* xo = F.OUT + (size_t)row * DM + 4 * F.lane;
#pragma unroll
        for (int j = 0; j < 8; ++j) *(f32x4*)(xo + 256 * j) = R.x[j];
    } else {
        bf16* xo = F.XB + (size_t)row * DM + 4 * F.lane;
#pragma unroll
        for (int j = 0; j < 8; ++j) { u32x2 w; w.x = pk2(R.x[j][0], R.x[j][1]); w.y = pk2(R.x[j][2], R.x[j][3]); *(u32x2*)(xo + 256 * j) = w; }
    }
    if (do_pre) {
        float ss = 0.f;
#pragma unroll
        for (int j = 0; j < 8; ++j) ss += (R.x[j][0] * R.x[j][0] + R.x[j][1] * R.x[j][1]) + (R.x[j][2] * R.x[j][2] + R.x[j][3] * R.x[j][3]);
        const float r = 1.0f / sqrtf(wave_sum(ss, F.lane) * (1.0f / DM) + RMS_EPS);
        if (!q8) {
            bf16* ho = F.HB + (size_t)row * DM + 4 * F.lane;
#pragma unroll
            for (int j = 0; j < 8; ++j) { const f32x4 hv = R.x[j] * r * *(const LAS f32x4*)(cf + 2048 + 4 * F.lane + 256 * j) + *(const LAS f32x4*)(cf + 4096 + 4 * F.lane + 256 * j);
                u32x2 w; w.x = pk2(hv[0], hv[1]); w.y = pk2(hv[2], hv[3]); *(u32x2*)(ho + 256 * j) = w; }
        } else {
            float mx = 0.f;
#pragma unroll
            for (int j = 0; j < 8; ++j) { const f32x4 hv = R.x[j] * r * *(const LAS f32x4*)(cf + 2048 + 4 * F.lane + 256 * j) + *(const LAS f32x4*)(cf + 4096 + 4 * F.lane + 256 * j);
                R.x[j] = hv; mx = fmaxf(fmaxf(mx, fmaxf(fabsf(hv[0]), fabsf(hv[1]))), fmaxf(fabsf(hv[2]), fabsf(hv[3]))); }
            mx = fmaxf(wave_max(mx, F.lane), 1e-30f);
            const float inv = 127.0f / mx;
            unsigned char* ho = (unsigned char*)F.HB + (size_t)row * DM + 4 * F.lane;
#pragma unroll
            for (int j = 0; j < 8; ++j) *(unsigned*)(ho + 256 * j) = q8_pack(R.x[j][0], R.x[j][1], R.x[j][2], R.x[j][3], inv);
            if (F.lane == 0) ((float*)(F.ws + WS_SA))[row] = mx * (1.0f / 127.0f);
        }
    }
}
__device__ __forceinline__ void norm_phase(Frame& F, bool first, bool do_post, int cpost, bool do_pre, int cpre, bool q8) {
    F.lane = lane_fresh(); F.tid = F.wave * 64 + F.lane;
    const int NGW = F.G * NWAVES, per = (M + NGW - 1) / NGW;
    const int blk0 = F.bid * NWAVES * per, rbeg = blk0 + F.wave * per, rend = (rbeg + per < M) ? rbeg + per : M;
    const int b_lo = (blk0 >> 13) > 4 ? 4 : (blk0 >> 13);
    LAS float* cfl = (LAS float*)F.lds;
    {
        const float* COEF = (const float*)(F.ws + WS_COEF);
        for (int i = F.tid; i < 2 * 3 * 2048 / 4; i += NTHREADS) { const int e = 4 * i, set = e / 6144, v = (e % 6144) >> 11, col = e & 2047; const int b = (b_lo + set > 4) ? 4 : b_lo + set;
            const int ci = (v == 0) ? (cpost * 3 + 2) : (v == 1 ? cpre * 3 + 1 : cpre * 3 + 0);
            *(LAS f32x4*)(cfl + e) = *(const f32x4*)(COEF + ((size_t)ci * 5 + b) * DM + col); }
        LDS_WAIT(); __syncthreads();
    }
    if (rbeg < rend) {
        NormRow Ra, Rb;
        norm_load(F, Ra, rbeg, first, do_post);
        for (int row = rbeg; row < rend; row += 2) {
            const bool has_b = row + 1 < rend;
            if (has_b) norm_load(F, Rb, row + 1, first, do_post);
            norm_row(F, Ra, row, first, do_post, do_pre, q8, cfl + (((row >> 13) - b_lo) & 1) * 6144);
            if (has_b) {
                if (row + 2 < rend) norm_load(F, Ra, row + 2, first, do_post);
                norm_row(F, Rb, row + 1, first, do_post, do_pre, q8, cfl + ((((row + 1) >> 13) - b_lo) & 1) * 6144);
            }
        }
    }
    __syncthreads();
}
__device__ __forceinline__ void mixnorm_phase(Frame& F, int l) {
    F.lane = lane_fresh(); F.tid = F.wave * 64 + F.lane;
    const int gw = F.bid * NWAVES + F.wave, NGW = F.G * NWAVES, per = (M + NGW - 1) / NGW, rbeg = gw * per, rend = (rbeg + per < M) ? rbeg + per : M;
    const float* gf = F.branch_g + (size_t)(l * 2 + 1) * 1024 + 8 * F.lane;
    f32x4 g[2][2];
#pragma unroll
    for (int j = 0; j < 2; ++j) { g[j][0] = *(const f32x4*)(gf + 512 * j); g[j][1] = *(const f32x4*)(gf + 512 * j + 4); }
    for (int row0 = rbeg; row0 < rend; row0 += 4) {
        u32x4 v[4][2];
#pragma unroll
        for (int r = 0; r < 4; ++r) { const int row = (row0 + r < rend) ? row0 + r : rend - 1; const bf16* p = F.HB + (size_t)row * DM + 1024 + 8 * F.lane;
#pragma unroll
            for (int j = 0; j < 2; ++j) v[r][j] = *(const u32x4*)(p + 512 * j); }
#pragma unroll
        for (int r = 0; r < 4; ++r) {
            float f[2][8]; float ss = 0.f;
#pragma unroll
            for (int j = 0; j < 2; ++j) { f[j][0] = bflo(v[r][j].x); f[j][1] = bfhi(v[r][j].x); f[j][2] = bflo(v[r][j].y); f[j][3] = bfhi(v[r][j].y); f[j][4] = bflo(v[r][j].z); f[j][5] = bfhi(v[r][j].z); f[j][6] = bflo(v[r][j].w); f[j][7] = bfhi(v[r][j].w);
#pragma unroll
                for (int i = 0; i < 8; ++i) ss += f[j][i] * f[j][i]; }
            const float rr = 1.0f / sqrtf(wave_sum(ss, F.lane) * (1.0f / 1024.0f) + RMS_EPS);
            if (row0 + r < rend) { bf16* p = F.HB + (size_t)(row0 + r) * DM + 1024 + 8 * F.lane;
#pragma unroll
                for (int j = 0; j < 2; ++j) { u32x4 w; w.x = pk2(f[j][0] * rr * g[j][0][0], f[j][1] * rr * g[j][0][1]); w.y = pk2(f[j][2] * rr * g[j][0][2], f[j][3] * rr * g[j][0][3]);
                    w.z = pk2(f[j][4] * rr * g[j][1][0], f[j][5] * rr * g[j][1][1]); w.w = pk2(f[j][6] * rr * g[j][1][2], f[j][7] * rr * g[j][1][3]); *(u32x4*)(p + 512 * j) = w; } }
        }
    }
}

constexpr int ATT_IMG = 147456;
__device__ __forceinline__ void attn_phase(Frame& F, int l) {
    F.lane = lane_fresh(); F.tid = F.wave * 64 + F.lane;
    const bf16* Q = (const bf16*)(F.ws + WS_Q); const bf16* KB = (const bf16*)(F.ws + WS_KB); const bf16* VT = (const bf16*)(F.ws + WS_VT); bf16* MIX = F.HB;
    const bf16* ZERO = (const bf16*)(F.ws + WS_CTL + 512 * 1024);
    LAS float* ssq = (LAS float*)(F.lds + SSQ_OFF);
    const int h = F.wave, hk = h >> 2;
    const float sinkl = F.sink[l * 8 + h] * LOG2E;
    for (int unit = F.bid; unit < NSEQ * 256; unit += F.G) {
        const int b = unit >> 8, q0 = (unit & 255) * 32, k0 = q0 - 128;
        const size_t tok0 = (size_t)b * SEQ;
        { const int ln = lane_fresh();
#pragma unroll 2
        for (int j = F.wave; j < 144; j += 8) {
            const int p = 64 * j + ln, hkk = p >= 4608 ? 1 : 0, pr = p - hkk * 4608, row = pr >> 4, slot = pr & 15;
            const int chunk = slot ^ ((((row >> 3) & 3) << 2) | (row & 3)); const int key = k0 + row; const bool ok = key >= 0 && key < SEQ;
            const bf16* src = ok ? KB + (tok0 + key) * NKV + hkk * 128 + chunk * 8 : ZERO;
            __builtin_amdgcn_global_load_lds((const unsigned*)src, (LAS unsigned*)(F.lds + 1024 * j), 16, 0, 0);
        } }
        bf16x8 qfs[2][4];
        { const int ln = lane_fresh(), c = ln & 15, q = ln >> 4;
#pragma unroll
          for (int qt = 0; qt < 2; ++qt)
#pragma unroll
            for (int ks = 0; ks < 4; ++ks) qfs[qt][ks] = *(const bf16x8*)(Q + (tok0 + q0 + 16 * qt + c) * NQ + h * 128 + 32 * ks + 8 * q); }
        VM_WAIT(); __syncthreads();
        bf16x8 pf[2][9]; float inv[2];
#pragma unroll
        for (int qt = 0; qt < 2; ++qt) {
            const int ln = lane_fresh(), c = ln & 15, q = ln >> 4;
            const LAS unsigned char* Kl = F.lds + hk * 73728 + (8 * (c >> 2) + (c & 3)) * 256;
            int xoff[4];
#pragma unroll
            for (int ks = 0; ks < 4; ++ks) xoff[ks] = ((4 * ks + q) ^ c) << 4;
            bf16x8 qf[4];
#pragma unroll
            for (int ks = 0; ks < 4; ++ks) qf[ks] = qfs[qt][ks];
            f32x4 s[9][2];
            bf16x8 kfa[4], kfb[4];
#define ATT_LDK(dst, T) do { _Pragma("unroll") for (int ks = 0; ks < 4; ++ks) dst[ks] = *(const LAS bf16x8*)(Kl + (32 * ((T) >> 1) + 4 * ((T) & 1)) * 256 + xoff[ks]); } while (0)
#define ATT_MMK(src, T) do { f32x4 a0 = (f32x4){0.f, 0.f, 0.f, 0.f}; _Pragma("unroll") for (int ks = 0; ks < 4; ++ks) a0 = __builtin_amdgcn_mfma_f32_16x16x32_bf16(src[ks], qf[ks], a0, 0, 0, 0); s[(T) >> 1][(T) & 1] = a0; } while (0)
            ATT_LDK(kfa, 0);
#pragma unroll
            for (int T = 0; T < 18; T += 2) {
                ATT_LDK(kfb, T + 1);
                __builtin_amdgcn_sched_barrier(0);
                ATT_MMK(kfa, T);
                if (T + 2 < 18) ATT_LDK(kfa, T + 2);
                __builtin_amdgcn_sched_barrier(0);
                ATT_MMK(kfb, T + 1);
            }
#undef ATT_LDK
#undef ATT_MMK
            const int qpos = q0 + 16 * qt + c; float mx = -1e30f;
            const bool edge = (k0 < 0) || (k0 + 288 > SEQ);
#pragma unroll
            for (int G = 0; G < 9; ++G) {
                if (G == 0 || G == 8 || edge) {
#pragma unroll
                    for (int tt = 0; tt < 2; ++tt)
#pragma unroll
                        for (int r = 0; r < 4; ++r) { const int kpos = k0 + 32 * G + 8 * q + 4 * tt + r; const int d = qpos - kpos;
                            const bool ok = (d <= 128) && (d >= -128) && (kpos >= 0) && (kpos < SEQ); const float v = ok ? s[G][tt][r] : -1e30f; s[G][tt][r] = v; mx = fmaxf(mx, v); }
                } else {
#pragma unroll
                    for (int tt = 0; tt < 2; ++tt)
#pragma unroll
                        for (int r = 0; r < 4; ++r) mx = fmaxf(mx, s[G][tt][r]);
                }
            }
            mx = fmaxf(mx, shfl_xor_l(mx, 16, ln)); mx = fmaxf(mx, shfl_xor_l(mx, 32, ln)); mx = fmaxf(mx, sinkl);
            float lsum = 0.f;
#pragma unroll
            for (int G = 0; G < 9; ++G) { float p[8];
#pragma unroll
                for (int tt = 0; tt < 2; ++tt)
#pragma unroll
                    for (int r = 0; r < 4; ++r) { p[4 * tt + r] = __builtin_amdgcn_exp2f(s[G][tt][r] - mx); lsum += p[4 * tt + r]; }
                u32x4 pw; pw.x = cvt_pk_bf16(p[0], p[1]); pw.y = cvt_pk_bf16(p[2], p[3]); pw.z = cvt_pk_bf16(p[4], p[5]); pw.w = cvt_pk_bf16(p[6], p[7]);
                pf[qt][G] = __builtin_bit_cast(bf16x8, pw); }
            lsum += shfl_xor_l(lsum, 16, ln); lsum += shfl_xor_l(lsum, 32, ln); lsum += __builtin_amdgcn_exp2f(sinkl - mx);
            inv[qt] = 1.0f / lsum;
        }
        __syncthreads();
        { const int ln = lane_fresh();
#pragma unroll 2
        for (int j = F.wave; j < 144; j += 8) {
            const int p = 64 * j + ln, hkk = p >= 4608 ? 1 : 0, pr = p - hkk * 4608, d = pr / 36, c1 = pr - d * 36;
            const int ch = c1 ^ ((d >> 2) & 3); const int tok = k0 + 8 * ch; const bool ok = tok >= 0 && tok < SEQ;
            const bf16* src = ok ? VT + (size_t)(hkk * 128 + d) * M + tok0 + tok : ZERO;
            __builtin_amdgcn_global_load_lds((const unsigned*)src, (LAS unsigned*)(F.lds + 1024 * j), 16, 0, 0);
        } }
        VM_WAIT(); __syncthreads();
        f32x4 o0[8], o1[8];
#pragma unroll
        for (int dt = 0; dt < 8; ++dt) { o0[dt] = (f32x4){0.f, 0.f, 0.f, 0.f}; o1[dt] = (f32x4){0.f, 0.f, 0.f, 0.f}; }
        {
            const int ln = lane_fresh(), c = ln & 15, q = ln >> 4;
            const LAS unsigned char* Vl = F.lds + hk * 73728 + c * 576 + ((q ^ (c >> 2)) << 4);
            bf16x8 vfa[4], vfb[4];
#define ATT_LDV(dst, H) do { _Pragma("unroll") for (int dd = 0; dd < 4; ++dd) dst[dd] = *(const LAS bf16x8*)(Vl + (4 * ((H) & 1) + dd) * 9216 + ((H) >> 1) * 64); } while (0)
#define ATT_MMV(src, H) do { _Pragma("unroll") for (int dd = 0; dd < 4; ++dd) { o0[4 * ((H) & 1) + dd] = __builtin_amdgcn_mfma_f32_16x16x32_bf16(src[dd], pf[0][(H) >> 1], o0[4 * ((H) & 1) + dd], 0, 0, 0); \
        o1[4 * ((H) & 1) + dd] = __builtin_amdgcn_mfma_f32_16x16x32_bf16(src[dd], pf[1][(H) >> 1], o1[4 * ((H) & 1) + dd], 0, 0, 0); } } while (0)
            ATT_LDV(vfa, 0);
#pragma unroll
            for (int H = 0; H < 18; H += 2) {
                ATT_LDV(vfb, H + 1);
                __builtin_amdgcn_sched_barrier(0);
                ATT_MMV(vfa, H);
                if (H + 2 < 18) ATT_LDV(vfa, H + 2);
                __builtin_amdgcn_sched_barrier(0);
                ATT_MMV(vfb, H + 1);
            }
#undef ATT_LDV
#undef ATT_MMV
        }
        const int ln = lane_fresh(), c = ln & 15, q = ln >> 4;
        const float* ga = F.branch_g + (size_t)(l * 2) * 1024 + h * 128 + 4 * q;
        float ss0 = 0.f, ss1 = 0.f;
#pragma unroll
        for (int dt = 0; dt < 8; ++dt) { o0[dt] = o0[dt] * inv[0]; o1[dt] = o1[dt] * inv[1];
            ss0 += (o0[dt][0] * o0[dt][0] + o0[dt][1] * o0[dt][1]) + (o0[dt][2] * o0[dt][2] + o0[dt][3] * o0[dt][3]);
            ss1 += (o1[dt][0] * o1[dt][0] + o1[dt][1] * o1[dt][1]) + (o1[dt][2] * o1[dt][2] + o1[dt][3] * o1[dt][3]); }
        ss0 += shfl_xor_l(ss0, 16, ln); ss0 += shfl_xor_l(ss0, 32, ln); ss1 += shfl_xor_l(ss1, 16, ln); ss1 += shfl_xor_l(ss1, 32, ln);
        if (q == 0) { ssq[h * 32 + c] = ss0; ssq[h * 32 + 16 + c] = ss1; }
        f32x4 gv[8];
#pragma unroll
        for (int dt = 0; dt < 8; ++dt) gv[dt] = *(const f32x4*)(ga + 16 * dt);
        LDS_WAIT(); __syncthreads();
        float t0 = 0.f, t1 = 0.f;
#pragma unroll
        for (int w = 0; w < 8; ++w) { t0 += ssq[w * 32 + c]; t1 += ssq[w * 32 + 16 + c]; }
        const float r0 = 1.0f / sqrtf(t0 * (1.0f / 1024.0f) + RMS_EPS), r1 = 1.0f / sqrtf(t1 * (1.0f / 1024.0f) + RMS_EPS);
        bf16* op = MIX + (tok0 + q0 + c) * DM + h * 128 + 4 * q;
#pragma unroll
        for (int dt = 0; dt < 8; ++dt) { const f32x4 g = gv[dt]; const f32x4 v0 = o0[dt] * r0 * g, v1 = o1[dt] * r1 * g;
            u32x2 w0, w1; w0.x = pk2(v0[0], v0[1]); w0.y = pk2(v0[2], v0[3]); w1.x = pk2(v1[0], v1[1]); w1.y = pk2(v1[2], v1[3]);
            *(u32x2*)(op + 16 * dt) = w0; *(u32x2*)(op + (size_t)16 * DM + 16 * dt) = w1; }
        LDS_WAIT();
    }
    VM_WAIT(); __syncthreads();
}

__global__ void __launch_bounds__(NTHREADS, 2) fwd_kernel(Args args) {
    extern __shared__ __attribute__((aligned(16))) unsigned char lds_raw[];
    Frame F;
    F.lds = (LAS unsigned char*)lds_raw;
    F.tid = threadIdx.x; F.lane = F.tid & 63; F.wave = __builtin_amdgcn_readfirstlane(F.tid >> 6); F.G = gridDim.x; F.bid = blockIdx.x;
    F.x_prompt = args.in[0]; F.x_sample = args.in[1]; F.c_prompt = args.in[2]; F.c_sample = args.in[3]; F.w_mod = args.in[4]; F.b_mod = args.in[5]; F.pre_g = args.in[6]; F.post_g = args.in[7];
    F.w_gate = args.in[8]; F.w_up = args.in[9]; F.w_down = args.in[10]; F.w_in = args.in[11]; F.sink = args.in[12]; F.four_w = args.in[13]; F.branch_g = args.in[14]; F.w_out = args.in[15];
    F.OUT = args.out; F.HB = (bf16*)args.out; F.ws = args.ws; F.XB = (bf16*)(args.ws + WS_X);
    volatile LAS unsigned* MISC = (volatile LAS unsigned*)(F.lds + MISC_OFF);
    for (int u = F.tid; u < (LDS_BYTES - LDSCTL_OFF) / 4; u += NTHREADS) ((LAS unsigned*)(F.lds + LDSCTL_OFF))[u] = 0u;
    __syncthreads();
    (void)xcd_barrier_post((unsigned*)(F.ws + WS_CTL) + 4096, MISC + 8);
#define GRID_BAR() do { XcdBarrier b2_; b2_.bar = (unsigned*)(args.ws + opaque_zero()) + 4096; b2_.x = xb_xcc_id(); b2_.st = (volatile LAS unsigned*)(F.lds + MISC_OFF) + 8; xcd_barrier(b2_, F.wave == 0 && lane_fresh() == 0); } while (0)

    p0a(F);
    GRID_BAR();
    p0b_quant(F);
    norm_phase(F, true, false, 0, true, 0, true);
    GRID_BAR();

    for (int hs = 0; hs < 2 * DEPTH; ++hs) {
        const int l = hs >> 1, fi = hs & 1;
        F.ws = args.ws + opaque_zero(); { int b_ = blockIdx.x, g_ = gridDim.x; asm volatile("" : "+s"(b_), "+s"(g_)); F.bid = b_; F.G = g_; }
        if (!((Q2_MASK >> hs) & 1u)) {
        {
            pg8::GeoPlain geo{(const char*)F.HB, (const char*)wptr(F, l, W_GU) + (size_t)fi * 11264 * 2048, DM / 2};
            pg8::StaticOrder S; S.init(M, 11264, F.G, F.bid);
            pg8::EpiSwiGLU8 E{(bf16*)(F.ws + WS_BIG), (const float*)(F.ws + WS_SA), (const unsigned*)(F.ws + WS_AMAX) + (size_t)(l * 2 + fi) * 11264};
            pg8::gemm_phase(F.lds, F.wave, geo, S, E);
        }
        GRID_BAR();
        {
            pg8::GeoPlain geo{(const char*)(F.ws + WS_BIG), (const char*)(wptr(F, l, W_D) + (size_t)fi * 2048 * 5632), DFF};
            pg8::StaticOrder S; S.init(M, DM, F.G, F.bid);
            pg8::EpiBf16 E{(bf16*)(F.ws + WS_Y), (size_t)DM};
            pg8::gemm_phase(F.lds, F.wave, geo, S, E);
        }
        GRID_BAR();
        } else {
        {
            pg8::GeoPlain geo{(const char*)F.HB, (const char*)wptr(F, l, W_GU) + (size_t)fi * 11264 * 2048, DM / 2};
            pg8::Col0Order S{F.G, F.bid};
            pg8::EpiSwiGLU8Q<true> E{F.ws + WS_BIG, (const float*)(F.ws + WS_SA), (const unsigned*)(F.ws + WS_AMAX) + (size_t)(l * 2 + fi) * 11264, (float*)(F.ws + WS_S2), (LAS float*)(F.lds + RING_BYTES)};
            pg8::gemm_phase(F.lds, F.wave, geo, S, E);
        }
        GRID_BAR();
        {
            pg8::GeoPlain geo{(const char*)F.HB, (const char*)wptr(F, l, W_GU) + (size_t)fi * 11264 * 2048, DM / 2};
            pg8::ShiftOrder S; S.S.init(M, 11264 - 256, F.G, F.bid);
            pg8::EpiSwiGLU8Q<false> E{F.ws + WS_BIG, (const float*)(F.ws + WS_SA), (const unsigned*)(F.ws + WS_AMAX) + (size_t)(l * 2 + fi) * 11264, (float*)(F.ws + WS_S2), (LAS float*)(F.lds + RING_BYTES)};
            pg8::gemm_phase(F.lds, F.wave, geo, S, E);
        }
        GRID_BAR();
        {
            pg8::GeoPlain geo{(const char*)(F.ws + WS_BIG), (const char*)wptr(F, l, W_D8) + (size_t)fi * 2048 * 5632, DFF / 2};
            pg8::StaticOrder S; S.init(M, DM, F.G, F.bid);
            pg8::EpiBf16S E{(bf16*)(F.ws + WS_Y), (const float*)(F.ws + WS_S2), (const unsigned*)(F.ws + WS_AMAXD) + hs * 2048};
            pg8::gemm_phase(F.lds, F.wave, geo, S, E);
        }
        GRID_BAR();
        }
        if (fi == 0) {
            norm_phase(F, false, true, l * 3 + 0, true, l * 3 + 1, false);
            GRID_BAR();
            {
                pg8::GeoPlain geo{(const char*)F.HB, (const char*)wptr(F, l, W_QK), DM};
                pg8::StaticOrder S; S.init(M, 2304, F.G, F.bid);
                pg8::EpiRope E{(bf16*)(F.ws + WS_Q), (bf16*)(F.ws + WS_KB), (const float*)(F.ws + WS_ROPE), (const float*)(F.ws + WS_ROPE + 2 * MiB), (bf16*)(F.ws + WS_U)};
                pg8::gemm_phase(F.lds, F.wave, geo, S, E);
            }
            {
                pg8::GeoPlain geo{(const char*)wptr(F, l, W_V), (const char*)F.HB, DM};
                pg8::StaticOrder S; S.init(256, M, F.G, (F.bid + 96) % F.G);
                pg8::EpiBf16 E{(bf16*)(F.ws + WS_VT), (size_t)M};
                pg8::gemm_phase(F.lds, F.wave, geo, S, E);
            }
            GRID_BAR();
            attn_phase(F, l);
            {
                pg8::GeoP1 geo{(const char*)(F.ws + WS_WCS) + (size_t)l * 8 * 256 * 128 * 2, (const char*)(F.ws + WS_U)};
                pg8::StaticOrder S; S.init(2048, M, F.G, F.bid);
                pg8::EpiBf16 E{(bf16*)(F.ws + WS_Z1), (size_t)M};
                pg8::gemm_phase(F.lds, F.wave, geo, S, E);
            }
            GRID_BAR();
            {
                pg8::GeoP2 geo{(const char*)(F.ws + WS_D1), (const char*)(F.ws + WS_Z1)};
                pg8::StaticOrder S; S.init(256, 2560 * 256, F.G, F.bid);
                pg8::EpiTwiddle E{(bf16*)(F.ws + WS_Y2)};
                pg8::gemm_phase(F.lds, F.wave, geo, S, E);
            }
            GRID_BAR();
            {
                pg8::GeoPlain geo{(const char*)(F.ws + WS_D2), (const char*)(F.ws + WS_Y2), 256};
                pg8::StaticOrder S; S.init(256, 1280 * 256, F.G, F.bid);
                pg8::EpiDftOut E{F.HB};
                pg8::gemm_phase(F.lds, F.wave, geo, S, E);
            }
            GRID_BAR();
            mixnorm_phase(F, l);
            GRID_BAR();
            {
                pg8::GeoPlain geo{(const char*)F.HB, (const char*)wptr(F, l, W_O), DM};
                pg8::StaticOrder S; S.init(M, DM, F.G, F.bid);
                pg8::EpiBf16 E{(bf16*)(F.ws + WS_Y), (size_t)DM};
                pg8::gemm_phase(F.lds, F.wave, geo, S, E);
            }
            GRID_BAR();
            norm_phase(F, false, true, l * 3 + 1, true, l * 3 + 2, true);
            GRID_BAR();
        } else {
            const bool lastl = (hs == 2 * DEPTH - 1);
            norm_phase(F, false, true, l * 3 + 2, !lastl, (l + 1) * 3 + 0, true);
            if (!lastl) GRID_BAR();
        }
    }
}

extern "C" void kernel_launch(void* const* d_in, const int* in_sizes, int n_in, void* d_out, int out_size, void* d_ws, size_t ws_size, hipStream_t stream) {
    static int grid = 0;
    if (grid == 0) {
        if (n_in != 16 || out_size != M * DM || ws_size < WS_END) { fprintf(stderr, "kernel_launch: unexpected problem (n_in %d, out %d, ws %zu < %zu)\n", n_in, out_size, ws_size, (size_t)WS_END); grid = -1; return; }
        int dev = 0, cus = 0, per_cu = 0;
        if (hipGetDevice(&dev) != hipSuccess || hipDeviceGetAttribute(&cus, hipDeviceAttributeMultiprocessorCount, dev) != hipSuccess) { grid = -1; return; }
        if (hipFuncSetAttribute((const void*)fwd_kernel, hipFuncAttributeMaxDynamicSharedMemorySize, LDS_BYTES) != hipSuccess) { fprintf(stderr, "kernel_launch: hipFuncSetAttribute failed\n"); grid = -1; return; }
        if (hipOccupancyMaxActiveBlocksPerMultiprocessor(&per_cu, (const void*)fwd_kernel, NTHREADS, LDS_BYTES) != hipSuccess || per_cu < 1) { fprintf(stderr, "kernel_launch: occupancy query reports %d\n", per_cu); }
        (void)hipGetLastError();
        grid = cus;
    }
    if (grid < 0) return;
    if (hipMemsetAsync((char*)d_ws + WS_CTL, 0, CTL_ZERO_BYTES, stream) != hipSuccess) return;
    Args a{};
    for (int i = 0; i < 16; ++i) a.in[i] = (const float*)d_in[i];
    a.out = (float*)d_out; a.ws = (unsigned char*)d_ws;
    hipLaunchKernelGGL(fwd_kernel, dim3(grid), dim3(NTHREADS), LDS_BYTES, stream, a);
}
```

```cpp
#include <hip/hip_runtime.h>
#include <cstdio>
#include <cstdint>

#define LAS __attribute__((address_space(3)))
#define GAS __attribute__((address_space(1)))
typedef unsigned short bf16;
typedef short bf16x8 __attribute__((ext_vector_type(8)));
typedef float f32x4 __attribute__((ext_vector_type(4)));
typedef float f32x2 __attribute__((ext_vector_type(2)));
typedef unsigned u32x4 __attribute__((ext_vector_type(4)));
typedef int i32x4 __attribute__((ext_vector_type(4)));
typedef unsigned u32x2 __attribute__((ext_vector_type(2)));
typedef GAS unsigned gu32;

constexpr int DM = 2048, SEQ = 8192, NSEQ = 5, M = NSEQ * SEQ, DFF = 5632, DEPTH = 2;
constexpr int NQ = 1024, NKV = 256, NIN = 2560, NMOD = 18432;
constexpr float RMS_EPS = 1e-6f;
constexpr float QSCALE = 0.08838834764831845f * 1.4426950408889634f;
constexpr float LOG2E = 1.4426950408889634f;
constexpr int NWAVES = 8, NTHREADS = 512;

constexpr size_t MiB = 1u << 20;
constexpr size_t WS_CTL = 0, CTL_ZERO_BYTES = 1 * MiB;
constexpr size_t WS_AMAX = 262144;
constexpr size_t WS_AMAXD = 458752;
constexpr unsigned Q2_MASK = 0xFu;
constexpr size_t WS_COEF = 1 * MiB;
constexpr size_t WS_SA = WS_COEF + 768 * 1024;
constexpr size_t WS_ROPE = 2 * MiB;
constexpr size_t WS_D1 = 6 * MiB;
constexpr size_t WS_D2 = 6 * MiB + 65536;
constexpr size_t WS_S2 = 6 * MiB + 262144;
constexpr size_t WS_WCS = 7 * MiB;
constexpr size_t WS_W = 9 * MiB;
constexpr size_t W_GU = 0;
constexpr size_t W_D8 = W_GU + (size_t)2 * 11264 * 2048;
constexpr size_t W_D = W_GU + (size_t)2 * 11264 * 2048 * 2;
constexpr size_t W_QK = W_D + (size_t)2 * 2048 * 5632 * 2;
constexpr size_t W_V = W_QK + (size_t)2304 * 2048 * 2;
constexpr size_t W_Z = W_V + (size_t)256 * 2048 * 2;
constexpr size_t W_O = W_Z + (size_t)1024 * 2048 * 2;
constexpr size_t W_LAYER = W_O + (size_t)2048 * 2048 * 2;
static_assert(W_LAYER == 154 * MiB, "weights per layer");
constexpr size_t WS_X = WS_W + 2 * W_LAYER;
constexpr size_t WS_Y = WS_X + 160 * MiB;
constexpr size_t WS_BIG = WS_Y + 160 * MiB;
constexpr size_t WS_Q = WS_BIG, WS_KB = WS_BIG + 80 * MiB, WS_VT = WS_BIG + 100 * MiB, WS_Z1 = WS_BIG + 120 * MiB, WS_Y2 = WS_BIG + 280 * MiB, WS_U = WS_Y2;
constexpr size_t WS_END = WS_BIG + 440 * MiB;
static_assert((size_t)M * DFF * 2 == 440 * MiB && (size_t)M * DM * 2 == 160 * MiB, "sizes");

constexpr int RING_BYTES = 131072;
constexpr int LDSCTL_OFF = 147456, MISC_OFF = LDSCTL_OFF + 320, SSQ_OFF = LDSCTL_OFF + 512;
constexpr int LDS_BYTES = 147456 + 2048;

#define LDS_WAIT() asm volatile("s_waitcnt lgkmcnt(0)" ::: "memory")
#define VM_WAIT() asm volatile("s_waitcnt vmcnt(0)" ::: "memory")
__device__ __forceinline__ unsigned f2bf(float f) { unsigned u = __builtin_bit_cast(unsigned, f); return (u + 0x7fffu + ((u >> 16) & 1u)) >> 16; }
__device__ __forceinline__ unsigned pk2(float lo, float hi) { return f2bf(lo) | (f2bf(hi) << 16); }
__device__ __forceinline__ float bflo(unsigned w) { return __builtin_bit_cast(float, w << 16); }
__device__ __forceinline__ float bfhi(unsigned w) { return __builtin_bit_cast(float, w & 0xffff0000u); }
__device__ __forceinline__ unsigned cvt_pk_bf16(float lo, float hi) { unsigned r; asm volatile("v_cvt_pk_bf16_f32 %0, %1, %2" : "=v"(r) : "v"(lo), "v"(hi)); return r; }

__device__ __forceinline__ int lane_fresh() { int l; asm volatile("v_mbcnt_lo_u32_b32 %0, -1, 0\n\tv_mbcnt_hi_u32_b32 %0, -1, %0" : "=v"(l)); return l; }
__device__ __forceinline__ size_t opaque_zero() { size_t z = 0; asm volatile("" : "+s"(z)); return z; }
namespace pg8 {
constexpr int BM = 256, BK = 64, HALF = 128, HTB = HALF * BK * 2, STAGE_BYTES = 8 * HTB, NXCD = 8, WGM = 4;
__host__ __device__ __forceinline__ int lds_byte(int r, int c) { const int st = (r >> 4) * 2 + (c >> 5), rr = r & 15, cc = c & 31, ob = rr * 64 + cc * 2; return st * 1024 + (ob ^ (((ob >> 9) & 1) << 5)); }
__host__ __device__ __forceinline__ void stage_rc(int b, int& R, int& C) { const int st = b / 1024, sb = b % 1024, swz = sb ^ (((sb >> 9) & 1) << 5); R = (st >> 1) * 16 + swz / 64; C = (st & 1) * 32 + (swz % 64) / 2; }
__host__ __device__ __forceinline__ int perm32(int rho) { const int n = rho >> 4, i = rho & 15; return 8 * (i >> 2) + 4 * n + (i & 3); }

struct Unit { int pm, pn; };
struct StaticOrder {
    int nM, nN, nwg, G, c;
    __device__ void init(int Mr, int Nc, int G_, int c_) { nM = Mr / BM; nN = Nc / BM; nwg = nM * nN; G = G_; c = c_; }
    __device__ bool next(int i, Unit& u) const {
        const long L = (long)i * G + c; if (L >= nwg) return false;
        int wgid = (int)L; { const int q = nwg / NXCD, r = nwg % NXCD, xcd = wgid % NXCD, off = wgid / NXCD; wgid = (xcd < r ? xcd * (q + 1) : r * (q + 1) + (xcd - r) * q) + off; }
        const int nig = WGM * nN, gid = wgid / nig, fm = gid * WGM, gsz = (nM - fm) < WGM ? (nM - fm) : WGM;
        u.pm = fm + ((wgid % nig) % gsz); u.pn = (wgid % nig) / gsz; return true;
    }
};

struct Col0Order {
    int G, c;
    __device__ bool next(int i, Unit& u) const { const long L = (long)i * G + c; if (L >= 160) return false; u.pm = (int)L; u.pn = 0; return true; }
};
struct ShiftOrder {
    StaticOrder S;
    __device__ bool next(int i, Unit& u) const { if (!S.next(i, u)) return false; u.pn += 1; return true; }
};

struct GeoPlain {
    const char* A; const char* B; int K;
    __device__ __forceinline__ int nt() const { return K / BK; }
    __device__ __forceinline__ const char* a_base(const Unit& u) const { return A + (size_t)u.pm * BM * K * 2; }
    __device__ __forceinline__ const char* b_base(const Unit& u) const { return B + (size_t)u.pn * BM * K * 2; }
    __device__ __forceinline__ unsigned a_off(int R, int C) const { return (unsigned)(R * K + C) * 2u; }
    __device__ __forceinline__ unsigned b_off(int R, int C) const { return (unsigned)(R * K + C) * 2u; }
    __device__ __forceinline__ size_t a_hstep() const { return (size_t)HALF * K * 2; }
    __device__ __forceinline__ size_t b_hstep() const { return (size_t)HALF * K * 2; }
    __device__ __forceinline__ size_t a_kstep() const { return BK * 2; }
    __device__ __forceinline__ size_t b_kstep() const { return BK * 2; }
};
struct GeoP1 {
    const char* A; const char* B;
    __device__ __forceinline__ int nt() const { return 2; }
    __device__ __forceinline__ const char* a_base(const Unit& u) const { return A + (size_t)u.pm * 256 * 128 * 2; }
    __device__ __forceinline__ const char* b_base(const Unit& u) const { return B + ((size_t)(u.pn >> 5) * SEQ + 4 * (u.pn & 31)) * 1024 * 2 + (size_t)u.pm * 128 * 2; }
    __device__ __forceinline__ unsigned a_off(int R, int C) const { return (unsigned)(R * 128 + C) * 2u; }
    __device__ __forceinline__ unsigned b_off(int R, int C) const { return (unsigned)((128 * (R & 63) + (R >> 6)) * 1024 + C) * 2u; }
    __device__ __forceinline__ size_t a_hstep() const { return (size_t)HALF * 128 * 2; }
    __device__ __forceinline__ size_t b_hstep() const { return (size_t)2 * 1024 * 2; }
    __device__ __forceinline__ size_t a_kstep() const { return BK * 2; }
    __device__ __forceinline__ size_t b_kstep() const { return BK * 2; }
};
struct GeoP2 {
    const char* A; const char* B;
    __device__ __forceinline__ int nt() const { return 2; }
    __device__ __forceinline__ const char* a_base(const Unit&) const { return A + opaque_zero(); }
    __device__ __forceinline__ const char* b_base(const Unit& u) const { const int ep = u.pn & 63, g = (u.pn >> 6) & 7, b = u.pn >> 9; return B + ((size_t)(g * 256 + 2 * ep) * M + (size_t)b * SEQ) * 2; }
    __device__ __forceinline__ unsigned a_off(int R, int C) const { return (unsigned)(R * 128 + C) * 2u; }
    __device__ __forceinline__ unsigned b_off(int R, int C) const { return (unsigned)(R * 64 + C) * 2u; }
    __device__ __forceinline__ size_t a_hstep() const { return (size_t)HALF * 128 * 2; }
    __device__ __forceinline__ size_t b_hstep() const { return (size_t)M * 2; }
    __device__ __forceinline__ size_t a_kstep() const { return BK * 2; }
    __device__ __forceinline__ size_t b_kstep() const { return (size_t)128 * M * 2; }
};

struct EpiSwiGLU8; template <bool FIRST> struct EpiSwiGLU8Q; struct EpiBf16S;
template <class E> struct AccT { using T = f32x4; static constexpr bool I8 = false; };
template <> struct AccT<EpiSwiGLU8> { using T = i32x4; static constexpr bool I8 = true; };
template <> struct AccT<EpiSwiGLU8Q<true>> { using T = i32x4; static constexpr bool I8 = true; };
template <> struct AccT<EpiSwiGLU8Q<false>> { using T = i32x4; static constexpr bool I8 = true; };
template <> struct AccT<EpiBf16S> { using T = i32x4; static constexpr bool I8 = true; };
template <class Epi, class Geo, class Ord>
__device__ __forceinline__ void gemm_phase(LAS unsigned char* lds, const int wid_in, const Geo geo, const Ord& S, const Epi& E) {
    int wid = wid_in; asm volatile("" : "+s"(wid));
    const int lane = lane_fresh(), tid = wid * 64 + lane, wr = wid >> 2, wc = wid & 3, fr = lane & 15, fq = lane >> 4;
    const int nt = geo.nt();
    unsigned voffA[2], voffB[2];
#pragma unroll
    for (int i = 0; i < 2; ++i) { int R, C; stage_rc(tid * 16 + i * 8192, R, C); const int Rb = (R & ~31) + perm32(R & 31);
        voffA[i] = geo.a_off(R, C); voffB[i] = geo.b_off(Rb, C); }
    const size_t kstepA = geo.a_kstep(), kstepB = geo.b_kstep(), hstepA = geo.a_hstep(), hstepB = geo.b_hstep();
    const unsigned ldsw = (unsigned)wid * 1024u;
    const int aoff = lds_byte(wr * 64 + fr, fq * 8), boff = lds_byte(wc * 32 + fr, fq * 8);
#define PG8_SA(b, h) (((b) * 2 + (h)) * HTB)
#define PG8_SB(b, h) ((4 + (b) * 2 + (h)) * HTB)
#define PG8_STAGE(bufoff, gbase, voff) do { _Pragma("unroll") for (int _i = 0; _i < 2; ++_i) \
        __builtin_amdgcn_global_load_lds((const unsigned*)((const char*)(gbase) + (voff)[_i]), (LAS unsigned*)(lds + (bufoff) + ldsw + _i * 8192), 16, 0, 0); } while (0)
#define PG8_LDA(dst, b, h) do { _Pragma("unroll") for (int m = 0; m < 4; ++m) _Pragma("unroll") for (int k = 0; k < 2; ++k) dst[m][k] = *(const LAS bf16x8*)(lds + PG8_SA(b, h) + aoff + m * 2048 + k * 1024); } while (0)
#define PG8_LDB(dst, b, h) do { _Pragma("unroll") for (int n = 0; n < 2; ++n) _Pragma("unroll") for (int k = 0; k < 2; ++k) dst[n][k] = *(const LAS bf16x8*)(lds + PG8_SB(b, h) + boff + n * 2048 + k * 1024); } while (0)
#define PG8_MMA(ai, bj, At, Bt) do { if constexpr ((ai) == 1 && Epi::SKIP_AI1) break; __builtin_amdgcn_s_setprio(1); _Pragma("unroll") for (int m = 0; m < 4; ++m) _Pragma("unroll") for (int n = 0; n < 2; ++n) _Pragma("unroll") for (int k = 0; k < 2; ++k) \
        { if constexpr (AccT<Epi>::I8) acc[ai][bj][m][n] = __builtin_amdgcn_mfma_i32_16x16x64_i8(__builtin_bit_cast(i32x4, Bt[n][k]), __builtin_bit_cast(i32x4, At[m][k]), acc[ai][bj][m][n], 0, 0, 0); \
          else acc[ai][bj][m][n] = __builtin_amdgcn_mfma_f32_16x16x32_bf16(Bt[n][k], At[m][k], acc[ai][bj][m][n], 0, 0, 0); } __builtin_amdgcn_s_setprio(0); } while (0)
#define PG8_WAIT_V(n) asm volatile("s_waitcnt vmcnt(" #n ")" ::: "memory")
#define PG8_WAIT_L(n) asm volatile("s_waitcnt lgkmcnt(" #n ")" ::: "memory")
#define PG8_BAR __builtin_amdgcn_s_barrier()
#define PG8_SCHED __builtin_amdgcn_sched_barrier(0)
    Unit cur, nxt; int ui = 0;
    if (!S.next(0, cur)) return;
    typedef typename AccT<Epi>::T acc_t;
    acc_t acc[2][2][4][2];
#pragma unroll
    for (int a = 0; a < 2; ++a)
#pragma unroll
        for (int b = 0; b < 2; ++b)
#pragma unroll
            for (int m = 0; m < 4; ++m)
#pragma unroll
                for (int n = 0; n < 2; ++n) acc[a][b][m][n] = (acc_t){0, 0, 0, 0};
    bf16x8 At[4][2], B0[2][2], B1[2][2];
    const char* cA = geo.a_base(cur); const char* cB = geo.b_base(cur);
    PG8_STAGE(PG8_SB(0, 0), cB, voffB); PG8_STAGE(PG8_SB(0, 1), cB + hstepB, voffB); PG8_STAGE(PG8_SA(0, 0), cA, voffA); PG8_STAGE(PG8_SA(0, 1), cA + hstepA, voffA);
    if (wr == 1) PG8_BAR;
    PG8_WAIT_V(2); PG8_BAR;
    PG8_STAGE(PG8_SB(1, 0), cB + kstepB, voffB); PG8_STAGE(PG8_SA(1, 0), cA + kstepA, voffA); PG8_STAGE(PG8_SB(1, 1), cB + hstepB + kstepB, voffB);
    PG8_WAIT_V(6); PG8_BAR;
    for (;;) {
        const bool has_next = S.next(ui + 1, nxt);
        const char* nA = has_next ? geo.a_base(nxt) : cA; const char* nB = has_next ? geo.b_base(nxt) : cB;
        for (int t = 0; t < nt; t += 2) {
            const bool last = (t == nt - 2);
            const char* a1 = cA + (size_t)(t + 1) * kstepA;
            const char* a2 = last ? nA : cA + (size_t)(t + 2) * kstepA; const char* b2 = last ? nB : cB + (size_t)(t + 2) * kstepB;
            const char* a3 = a2 + kstepA; const char* b3 = b2 + kstepB;
            PG8_LDB(B0, 0, 0); PG8_LDB(B1, 0, 1); PG8_SCHED; PG8_LDA(At, 0, 0); PG8_STAGE(PG8_SA(1, 1), a1 + hstepA, voffA);
            PG8_WAIT_V(8); PG8_WAIT_L(0); PG8_BAR; PG8_MMA(0, 0, At, B0); PG8_MMA(0, 1, At, B1); PG8_BAR; PG8_SCHED;
            PG8_LDA(At, 0, 1); PG8_STAGE(PG8_SB(0, 0), b2, voffB); PG8_STAGE(PG8_SB(0, 1), b2 + hstepB, voffB); PG8_STAGE(PG8_SA(0, 0), a2, voffA);
            PG8_WAIT_V(8); PG8_WAIT_L(0); PG8_BAR; PG8_MMA(1, 0, At, B0); PG8_MMA(1, 1, At, B1); PG8_BAR; PG8_SCHED;
            PG8_LDB(B0, 1, 0); PG8_LDB(B1, 1, 1); PG8_SCHED; PG8_LDA(At, 1, 0); PG8_STAGE(PG8_SA(0, 1), a2 + hstepA, voffA);
            PG8_WAIT_V(8); PG8_WAIT_L(0); PG8_BAR; PG8_MMA(0, 0, At, B0); PG8_MMA(0, 1, At, B1); PG8_BAR; PG8_SCHED;
            PG8_LDA(At, 1, 1); PG8_STAGE(PG8_SB(1, 0), b3, voffB); PG8_STAGE(PG8_SB(1, 1), b3 + hstepB, voffB); PG8_STAGE(PG8_SA(1, 0), a3, voffA);
            PG8_WAIT_V(8); PG8_WAIT_L(0); PG8_BAR; PG8_MMA(1, 0, At, B0); PG8_MMA(1, 1, At, B1); PG8_BAR; PG8_SCHED;
        }
        if (wr == 0) PG8_BAR;
        { const int le = lane_fresh(); E(acc, cur, wr, wc, le & 15, le >> 4); }
        if (!has_next) break;
#pragma unroll
        for (int a = 0; a < 2; ++a)
#pragma unroll
            for (int b = 0; b < 2; ++b)
#pragma unroll
                for (int m = 0; m < 4; ++m)
#pragma unroll
                    for (int n = 0; n < 2; ++n) acc[a][b][m][n] = (acc_t){0, 0, 0, 0};
        cur = nxt; cA = nA; cB = nB; ++ui;
        if (wr == 1) PG8_BAR;
    }
    PG8_WAIT_V(0);
    PG8_BAR;
#undef PG8_SA
#undef PG8_SB
#undef PG8_STAGE
#undef PG8_LDA
#undef PG8_LDB
#undef PG8_MMA
#undef PG8_WAIT_V
#undef PG8_WAIT_L
#undef PG8_BAR
#undef PG8_SCHED
}

struct EpiBf16 {
    static constexpr bool SKIP_AI1 = false;
    bf16* O; size_t ldc;
    __device__ __forceinline__ void operator()(const f32x4 (&acc)[2][2][4][2], const Unit& u, int wr, int wc, int fr, int fq) const {
        const int row0 = u.pm * BM + wr * 64 + fr, col0 = u.pn * BM + wc * 32 + 8 * fq;
#pragma unroll
        for (int ai = 0; ai < 2; ++ai)
#pragma unroll
            for (int m = 0; m < 4; ++m) { bf16* rowp = O + (size_t)(row0 + ai * HALF + m * 16) * ldc + col0;
#pragma unroll
                for (int bj = 0; bj < 2; ++bj) { const f32x4 v0 = acc[ai][bj][m][0], v1 = acc[ai][bj][m][1];
                    u32x4 w; w.x = cvt_pk_bf16(v0[0], v0[1]); w.y = cvt_pk_bf16(v0[2], v0[3]); w.z = cvt_pk_bf16(v1[0], v1[1]); w.w = cvt_pk_bf16(v1[2], v1[3]);
                    *(u32x4*)(rowp + bj * HALF) = w; } }
    }
};
__device__ __forceinline__ float silu_mul(float g, float u) { return g * u * __builtin_amdgcn_rcpf(1.0f + __expf(-g)); }
struct EpiSwiGLU {
    static constexpr bool SKIP_AI1 = false;
    bf16* O;
    __device__ __forceinline__ void operator()(const f32x4 (&acc)[2][2][4][2], const Unit& u, int wr, int wc, int fr, int fq) const {
        const int row0 = u.pm * BM + wr * 64 + fr, col0 = u.pn * HALF + wc * 32 + 8 * fq;
#pragma unroll
        for (int ai = 0; ai < 2; ++ai)
#pragma unroll
            for (int m = 0; m < 4; ++m) { bf16* rowp = O + (size_t)(row0 + ai * HALF + m * 16) * DFF + col0;
                const f32x4 g0 = acc[ai][0][m][0], g1 = acc[ai][0][m][1], u0 = acc[ai][1][m][0], u1 = acc[ai][1][m][1];
                u32x4 w; w.x = cvt_pk_bf16(silu_mul(g0[0], u0[0]), silu_mul(g0[1], u0[1])); w.y = cvt_pk_bf16(silu_mul(g0[2], u0[2]), silu_mul(g0[3], u0[3]));
                w.z = cvt_pk_bf16(silu_mul(g1[0], u1[0]), silu_mul(g1[1], u1[1])); w.w = cvt_pk_bf16(silu_mul(g1[2], u1[2]), silu_mul(g1[3], u1[3]));
                *(u32x4*)rowp = w; }
    }
};
struct EpiSwiGLU8 {
    static constexpr bool SKIP_AI1 = false;
    bf16* O; const float* SA; const unsigned* AM;
    __device__ __forceinline__ void operator()(const i32x4 (&acc)[2][2][4][2], const Unit& u, int wr, int wc, int fr, int fq) const {
        const int row0 = u.pm * BM + wr * 64 + fr, col0 = u.pn * HALF + wc * 32 + 8 * fq, cw = u.pn * BM + wc * 32 + 8 * fq;
        f32x4 sg[2], su[2]; float sa[2][4];
#pragma unroll
        for (int n = 0; n < 2; ++n) { sg[n] = __builtin_bit_cast(f32x4, *(const u32x4*)(AM + cw + 4 * n)); su[n] = __builtin_bit_cast(f32x4, *(const u32x4*)(AM + cw + HALF + 4 * n)); }
#pragma unroll
        for (int ai = 0; ai < 2; ++ai)
#pragma unroll
            for (int m = 0; m < 4; ++m) sa[ai][m] = SA[row0 + ai * HALF + m * 16];
#pragma unroll
        for (int n = 0; n < 2; ++n) { sg[n] *= (1.0f / 127.0f); su[n] *= (1.0f / 127.0f); }
#pragma unroll
        for (int ai = 0; ai < 2; ++ai)
#pragma unroll
            for (int m = 0; m < 4; ++m) { bf16* rowp = O + (size_t)(row0 + ai * HALF + m * 16) * DFF + col0; const float s = sa[ai][m];
                const f32x4 g0 = __builtin_convertvector(acc[ai][0][m][0], f32x4) * (sg[0] * s), g1 = __builtin_convertvector(acc[ai][0][m][1], f32x4) * (sg[1] * s);
                const f32x4 u0 = __builtin_convertvector(acc[ai][1][m][0], f32x4) * (su[0] * s), u1 = __builtin_convertvector(acc[ai][1][m][1], f32x4) * (su[1] * s);
                u32x4 w; w.x = cvt_pk_bf16(silu_mul(g0[0], u0[0]), silu_mul(g0[1], u0[1])); w.y = cvt_pk_bf16(silu_mul(g0[2], u0[2]), silu_mul(g0[3], u0[3]));
                w.z = cvt_pk_bf16(silu_mul(g1[0], u1[0]), silu_mul(g1[1], u1[1])); w.w = cvt_pk_bf16(silu_mul(g1[2], u1[2]), silu_mul(g1[3], u1[3]));
                *(u32x4*)rowp = w; }
    }
};
__device__ __forceinline__ float xlane(float v, int mask, int lane) { return __builtin_bit_cast(float, __builtin_amdgcn_ds_bpermute((lane ^ mask) << 2, __builtin_bit_cast(int, v))); }
__device__ __forceinline__ unsigned q8c_pack(float a, float b, float c, float d, float inv) {
    const unsigned ua = __float_as_uint(__builtin_amdgcn_fmed3f(a * inv, -127.0f, 127.0f) + 12582912.0f), ub = __float_as_uint(__builtin_amdgcn_fmed3f(b * inv, -127.0f, 127.0f) + 12582912.0f);
    const unsigned uc = __float_as_uint(__builtin_amdgcn_fmed3f(c * inv, -127.0f, 127.0f) + 12582912.0f), ud = __float_as_uint(__builtin_amdgcn_fmed3f(d * inv, -127.0f, 127.0f) + 12582912.0f);
    return __builtin_amdgcn_perm(__builtin_amdgcn_perm(ud, uc, 0x0c0c0400u), __builtin_amdgcn_perm(ub, ua, 0x0c0c0400u), 0x05040100u);
}
constexpr float Q2_CLIP = 6.0f;
template <bool FIRST>
struct EpiSwiGLU8Q {
    static constexpr bool SKIP_AI1 = false;
    unsigned char* O8; const float* SA; const unsigned* AM; float* S2; LAS float* xl;
    __device__ __forceinline__ void row8(float (&h)[8], const i32x4& ag0, const i32x4& ag1, const i32x4& au0, const i32x4& au1, const f32x4 (&sg)[2], const f32x4 (&su)[2], float s, int lane) const {
        const f32x4 g0 = __builtin_convertvector(ag0, f32x4) * (sg[0] * s), g1 = __builtin_convertvector(ag1, f32x4) * (sg[1] * s);
        const f32x4 u0 = __builtin_convertvector(au0, f32x4) * (su[0] * s), u1 = __builtin_convertvector(au1, f32x4) * (su[1] * s);
        h[0] = silu_mul(g0[0], u0[0]); h[1] = silu_mul(g0[1], u0[1]); h[2] = silu_mul(g0[2], u0[2]); h[3] = silu_mul(g0[3], u0[3]);
        h[4] = silu_mul(g1[0], u1[0]); h[5] = silu_mul(g1[1], u1[1]); h[6] = silu_mul(g1[2], u1[2]); h[7] = silu_mul(g1[3], u1[3]);
#pragma unroll
        for (int st = 1; st < 8; st <<= 1)
#pragma unroll
            for (int j = 0; j < 8; ++j) if ((j & st) == 0) { const float a = h[j], b = h[j | st]; h[j] = a + b; h[j | st] = a - b; }
#pragma unroll
        for (int j = 0; j < 8; j += 2) {
            const auto r = __builtin_amdgcn_permlane16_swap(__float_as_uint(h[j]), __float_as_uint(h[j + 1]), false, false);
            const float a = __uint_as_float(r[0]), b = __uint_as_float(r[1]);
            const auto q = __builtin_amdgcn_permlane16_swap(__float_as_uint(a + b), __float_as_uint(a - b), false, false);
            h[j] = __uint_as_float(q[0]); h[j + 1] = __uint_as_float(q[1]); }
#pragma unroll
        for (int j = 0; j < 8; j += 2) {
            const auto r = __builtin_amdgcn_permlane32_swap(__float_as_uint(h[j]), __float_as_uint(h[j + 1]), false, false);
            const float a = __uint_as_float(r[0]), b = __uint_as_float(r[1]);
            const auto q = __builtin_amdgcn_permlane32_swap(__float_as_uint(a + b), __float_as_uint(a - b), false, false);
            h[j] = __uint_as_float(q[0]); h[j + 1] = __uint_as_float(q[1]); }
    }
    __device__ __forceinline__ void operator()(const i32x4 (&acc)[2][2][4][2], const Unit& u, int wr, int wc, int fr, int fq) const {
        const int lane = fr + 16 * fq;
        const int row0 = u.pm * BM + wr * 64 + fr, col0 = u.pn * HALF + wc * 32 + 8 * fq, cw = u.pn * BM + wc * 32 + 8 * fq;
        f32x4 sg[2], su[2]; float sa[2][4], inv[2][4];
#pragma unroll
        for (int n = 0; n < 2; ++n) { sg[n] = __builtin_bit_cast(f32x4, *(const u32x4*)(AM + cw + 4 * n)); su[n] = __builtin_bit_cast(f32x4, *(const u32x4*)(AM + cw + HALF + 4 * n)); }
#pragma unroll
        for (int ai = 0; ai < 2; ++ai)
#pragma unroll
            for (int m = 0; m < 4; ++m) { sa[ai][m] = SA[row0 + ai * HALF + m * 16]; if constexpr (!FIRST) inv[ai][m] = S2[row0 + ai * HALF + m * 16]; }
#pragma unroll
        for (int n = 0; n < 2; ++n) { sg[n] *= (1.0f / 127.0f); su[n] *= (1.0f / 127.0f); }
        if constexpr (FIRST) {
#pragma unroll
            for (int ai = 0; ai < 2; ++ai)
#pragma unroll
                for (int m = 0; m < 4; ++m) { float h[8]; row8(h, acc[ai][0][m][0], acc[ai][0][m][1], acc[ai][1][m][0], acc[ai][1][m][1], sg, su, sa[ai][m], lane);
                    float ss = (h[0] * h[0] + h[1] * h[1]) + (h[2] * h[2] + h[3] * h[3]) + (h[4] * h[4] + h[5] * h[5]) + (h[6] * h[6] + h[7] * h[7]);
                    ss += xlane(ss, 16, lane); ss += xlane(ss, 32, lane);
                    if (fq == 0) xl[(ai * HALF + wr * 64 + m * 16 + fr) * 4 + wc] = ss; }
            asm volatile("s_waitcnt lgkmcnt(0)" ::: "memory"); __builtin_amdgcn_s_barrier();
#pragma unroll
            for (int ai = 0; ai < 2; ++ai)
#pragma unroll
                for (int m = 0; m < 4; ++m) { const f32x4 t = *(const LAS f32x4*)(xl + (ai * HALF + wr * 64 + m * 16 + fr) * 4);
                    const float sc = Q2_CLIP * (1.0f / 127.0f) * sqrtf(((t[0] + t[1]) + (t[2] + t[3])) * (1.0f / 128.0f));
                    inv[ai][m] = sc; if (wc == 0 && fq == 0) S2[row0 + ai * HALF + m * 16] = sc; }
        }
#pragma unroll
        for (int ai = 0; ai < 2; ++ai)
#pragma unroll
            for (int m = 0; m < 4; ++m) { float h[8]; row8(h, acc[ai][0][m][0], acc[ai][0][m][1], acc[ai][1][m][0], acc[ai][1][m][1], sg, su, sa[ai][m], lane);
                const float iv = inv[ai][m] > 0.f ? __builtin_amdgcn_rcpf(inv[ai][m]) : 0.f;
                u32x2 w; w.x = q8c_pack(h[0], h[1], h[2], h[3], iv); w.y = q8c_pack(h[4], h[5], h[6], h[7], iv);
                *(u32x2*)(O8 + (size_t)(row0 + ai * HALF + m * 16) * DFF + col0) = w; }
    }
};
struct EpiBf16S {
    static constexpr bool SKIP_AI1 = false;
    bf16* O; const float* S2; const unsigned* AMD;
    __device__ __forceinline__ void operator()(const i32x4 (&acc)[2][2][4][2], const Unit& u, int wr, int wc, int fr, int fq) const {
        const int row0 = u.pm * BM + wr * 64 + fr, col0 = u.pn * BM + wc * 32 + 8 * fq;
        f32x4 sw[2][2]; float sr[2][4];
#pragma unroll
        for (int bj = 0; bj < 2; ++bj)
#pragma unroll
            for (int n = 0; n < 2; ++n) sw[bj][n] = __builtin_bit_cast(f32x4, *(const u32x4*)(AMD + col0 + bj * HALF + 4 * n));
#pragma unroll
        for (int ai = 0; ai < 2; ++ai)
#pragma unroll
            for (int m = 0; m < 4; ++m) sr[ai][m] = S2[row0 + ai * HALF + m * 16];
#pragma unroll
        for (int bj = 0; bj < 2; ++bj)
#pragma unroll
            for (int n = 0; n < 2; ++n) sw[bj][n] *= (1.0f / (127.0f * 32.0f));
#pragma unroll
        for (int ai = 0; ai < 2; ++ai)
#pragma unroll
            for (int m = 0; m < 4; ++m) { bf16* rowp = O + (size_t)(row0 + ai * HALF + m * 16) * DM + col0; const float s = sr[ai][m];
#pragma unroll
                for (int bj = 0; bj < 2; ++bj) { const f32x4 v0 = __builtin_convertvector(acc[ai][bj][m][0], f32x4) * (sw[bj][0] * s), v1 = __builtin_convertvector(acc[ai][bj][m][1], f32x4) * (sw[bj][1] * s);
                    u32x4 w; w.x = cvt_pk_bf16(v0[0], v0[1]); w.y = cvt_pk_bf16(v0[2], v0[3]); w.z = cvt_pk_bf16(v1[0], v1[1]); w.w = cvt_pk_bf16(v1[2], v1[3]);
                    *(u32x4*)(rowp + bj * HALF) = w; } }
    }
};
struct EpiRope {
    static constexpr bool SKIP_AI1 = false;
    static constexpr bool HOOK = false;
    bf16* Q; bf16* KB; const float* COS; const float* SIN; bf16* U;
    __device__ __forceinline__ void operator()(const f32x4 (&acc)[2][2][4][2], const Unit& u, int wr, int wc, int fr, int fq) const {
        if (u.pn >= 5) {
            const int row0u = u.pm * BM + wr * 64 + fr, col0 = (u.pn - 5) * BM + wc * 32 + 8 * fq;
#pragma unroll
            for (int ai = 0; ai < 2; ++ai)
#pragma unroll
                for (int m = 0; m < 4; ++m) { bf16* rowp = U + (size_t)(row0u + ai * HALF + m * 16) * 1024 + col0;
#pragma unroll
                    for (int bj = 0; bj < 2; ++bj) { const f32x4 v0 = acc[ai][bj][m][0], v1 = acc[ai][bj][m][1];
                        u32x4 w; w.x = cvt_pk_bf16(v0[0], v0[1]); w.y = cvt_pk_bf16(v0[2], v0[3]); w.z = cvt_pk_bf16(v1[0], v1[1]); w.w = cvt_pk_bf16(v1[2], v1[3]);
                        *(u32x4*)(rowp + bj * HALF) = w; } }
            return;
        }
        const int row0 = u.pm * BM + wr * 64 + fr, hsel = wc >> 1, d0 = 32 * (wc & 1) + 8 * fq;
        const bool isq = u.pn < 4; const float sc = isq ? QSCALE : 1.0f;
        bf16* base = isq ? Q + (2 * u.pn + hsel) * 128 + d0 : KB + hsel * 128 + d0; const size_t ld = isq ? NQ : NKV;
#pragma unroll
        for (int ai = 0; ai < 2; ++ai) {
            f32x4 c0[4], c1[4], s0[4], s1[4];
#pragma unroll
            for (int m = 0; m < 4; ++m) { const int pos = (row0 + ai * HALF + m * 16) & (SEQ - 1);
                c0[m] = *(const f32x4*)(COS + pos * 64 + d0); c1[m] = *(const f32x4*)(COS + pos * 64 + d0 + 4); s0[m] = *(const f32x4*)(SIN + pos * 64 + d0); s1[m] = *(const f32x4*)(SIN + pos * 64 + d0 + 4); }
            u32x4 w1[4], w2[4];
#pragma unroll
            for (int m = 0; m < 4; ++m) {
                const f32x4 a0 = acc[ai][0][m][0], a1 = acc[ai][0][m][1], b0 = acc[ai][1][m][0], b1 = acc[ai][1][m][1];
                const f32x4 o10 = (a0 * c0[m] - b0 * s0[m]) * sc, o11 = (a1 * c1[m] - b1 * s1[m]) * sc, o20 = (a0 * s0[m] + b0 * c0[m]) * sc, o21 = (a1 * s1[m] + b1 * c1[m]) * sc;
                w1[m].x = cvt_pk_bf16(o10[0], o10[1]); w1[m].y = cvt_pk_bf16(o10[2], o10[3]); w1[m].z = cvt_pk_bf16(o11[0], o11[1]); w1[m].w = cvt_pk_bf16(o11[2], o11[3]);
                w2[m].x = cvt_pk_bf16(o20[0], o20[1]); w2[m].y = cvt_pk_bf16(o20[2], o20[3]); w2[m].z = cvt_pk_bf16(o21[0], o21[1]); w2[m].w = cvt_pk_bf16(o21[2], o21[3]); }
#pragma unroll
            for (int m = 0; m < 4; ++m) { bf16* rp = base + (size_t)(row0 + ai * HALF + m * 16) * ld; *(u32x4*)rp = w1[m]; *(u32x4*)(rp + 64) = w2[m]; }
        }
    }
};
struct EpiTwiddle {
    static constexpr bool SKIP_AI1 = false;
    bf16* Y2;
    __device__ __forceinline__ void operator()(const f32x4 (&acc)[2][2][4][2], const Unit& u, int wr, int wc, int fr, int fq) const {
        if (wr != 0) return;
        int zz = 0; asm volatile("" : "+v"(zz));
        const int ep = u.pn & 63, g = (u.pn >> 6) & 7, b = u.pn >> 9, s20 = wc * 32 + 8 * fq + zz;
#pragma unroll
        for (int m = 0; m < 4; ++m) { const int k1 = 16 * m + fr;
#pragma unroll
            for (int bj = 0; bj < 2; ++bj) { const int e = 2 * ep + bj; bf16* rp = Y2 + ((size_t)((b * 64 + k1) * 8 + g) * 128 + e) * 256 + s20;
                float re[8], im[8];
#pragma unroll
                for (int n = 0; n < 2; ++n)
#pragma unroll
                    for (int i = 0; i < 4; ++i) { const int s2 = s20 + 4 * n + i; const float fr_ = (float)((k1 * s2) & 8191) * (1.0f / 8192.0f);
                        const float ct = __builtin_amdgcn_cosf(fr_), st = __builtin_amdgcn_sinf(fr_); const float yr = acc[0][bj][m][n][i], yi = acc[1][bj][m][n][i];
                        re[4 * n + i] = yr * ct + yi * st; im[4 * n + i] = yi * ct - yr * st; }
                u32x4 w1, w2; w1.x = cvt_pk_bf16(re[0], re[1]); w1.y = cvt_pk_bf16(re[2], re[3]); w1.z = cvt_pk_bf16(re[4], re[5]); w1.w = cvt_pk_bf16(re[6], re[7]);
                w2.x = cvt_pk_bf16(im[0], im[1]); w2.y = cvt_pk_bf16(im[2], im[3]); w2.z = cvt_pk_bf16(im[4], im[5]); w2.w = cvt_pk_bf16(im[6], im[7]);
                *(u32x4*)rp = w1; *(u32x4*)(rp + 128) = w2; } }
    }
};
struct EpiDftOut {
    static constexpr bool SKIP_AI1 = true;
    bf16* MIX;
    __device__ __forceinline__ void operator()(const f32x4 (&acc)[2][2][4][2], const Unit& u, int wr, int wc, int fr, int fq) const {
        const int gp = u.pn & 3, k1 = (u.pn >> 2) & 63, b = u.pn >> 8;
#pragma unroll
        for (int m = 0; m < 4; ++m) { const int k2 = 64 * wr + 16 * m + fr; bf16* rp = MIX + (size_t)(b * SEQ + k1 + 64 * k2) * DM + 1024 + gp * 256 + wc * 32 + 8 * fq;
#pragma unroll
            for (int bj = 0; bj < 2; ++bj) { const f32x4 v0 = acc[0][bj][m][0], v1 = acc[0][bj][m][1];
                u32x4 w; w.x = cvt_pk_bf16(v0[0], v0[1]); w.y = cvt_pk_bf16(v0[2], v0[3]); w.z = cvt_pk_bf16(v1[0], v1[1]); w.w = cvt_pk_bf16(v1[2], v1[3]);
                *(u32x4*)(rp + bj * 128) = w; } }
    }
};
}

#define XB_TMO      128
#define XB_XCNT(j)  (256  + 64 * (j))
#define XB_XSUB(j)  (1280 + 64 * (j))
#define XB_XGEN(j)  (2304 + 64 * (j))
#define XB_TOP      3328
#define XB_TOPGEN   3392
#define XCD_BAR_WORDS 3456
#define XB_SPIN_CAP (1u << 18)
__device__ __forceinline__ unsigned xb_ld(unsigned* p)              { return __hip_atomic_load(p, __ATOMIC_RELAXED, __HIP_MEMORY_SCOPE_AGENT); }
__device__ __forceinline__ unsigned xb_add(unsigned* p, unsigned v) { return __hip_atomic_fetch_add(p, v, __ATOMIC_RELAXED, __HIP_MEMORY_SCOPE_AGENT); }
__device__ __forceinline__ unsigned xb_xcc_id() { return (unsigned)__builtin_amdgcn_s_getreg((3 << 11) | 20) & 0xFu; }
#define XB_SPIN(cond, bar) do { unsigned _sp = 0; while (cond) { __builtin_amdgcn_s_sleep(1); \
    if ((++_sp & 255u) == 0u) { if (xb_ld(&(bar)[XB_TMO])) break; if (_sp > XB_SPIN_CAP) { atomicAdd(&(bar)[XB_TMO], 1u); break; } } } } while (0)
struct XcdBarrier { unsigned* bar; unsigned x; volatile LAS unsigned* st; };
__device__ __forceinline__ XcdBarrier xcd_barrier_post(unsigned* bar, volatile LAS unsigned* st) {
    XcdBarrier b; b.bar = bar; b.x = xb_xcc_id(); b.st = st;
    if (threadIdx.x == 0) (void)xb_add(&bar[XB_XCNT(b.x)], 1u);
    return b;
}
__device__ __forceinline__ void xcd_barrier_complete(unsigned* bar, unsigned x, unsigned& nloc, unsigned& nx) {
    const unsigned G = gridDim.x * gridDim.y * gridDim.z;
    unsigned sum, cnt, mine, sp = 0u;
    for (;;) {
        sum = 0u; cnt = 0u; mine = 0u;
#pragma unroll
        for (unsigned j = 0; j < 16; ++j) { const unsigned c = xb_ld(&bar[XB_XCNT(j)]); sum += c; cnt += (c > 0u) ? 1u : 0u; mine = (j == x) ? c : mine; }
        if (sum == G) break;
        __builtin_amdgcn_s_sleep(1);
        if ((++sp & 255u) == 0u) { if (xb_ld(&bar[XB_TMO])) break; if (sp > XB_SPIN_CAP) { atomicAdd(&bar[XB_TMO], 1u); break; } }
    }
    nloc = mine > 0u ? mine : 1u; nx = cnt > 0u ? cnt : 1u;
}
__device__ __forceinline__ void xcd_barrier(const XcdBarrier& b, const bool leader) {
    asm volatile("s_waitcnt vmcnt(0)" ::: "memory");
    __syncthreads();
    if (leader) {
        unsigned* bar = b.bar;
        __builtin_amdgcn_s_waitcnt(0);
        unsigned nloc = b.st[0], nx = b.st[1];
        if (nloc == 0u) { xcd_barrier_complete(bar, b.x, nloc, nx); b.st[0] = nloc; b.st[1] = nx; }
        const unsigned old = xb_add(&bar[XB_XSUB(b.x)], 1u);
        const unsigned gen = old / nloc;
        if (old + 1u == (gen + 1u) * nloc) {
            __builtin_amdgcn_fence(__ATOMIC_RELEASE, "agent");
            asm volatile("s_waitcnt vmcnt(0)" ::: "memory");
            const unsigned og = xb_add(&bar[XB_TOP], 1u);
            const unsigned tg = og / nx;
            if (og + 1u == (tg + 1u) * nx) xb_add(&bar[XB_TOPGEN], 1u);
            else XB_SPIN(xb_ld(&bar[XB_TOPGEN]) == tg, bar);
            __builtin_amdgcn_fence(__ATOMIC_ACQUIRE, "agent");
            xb_add(&bar[XB_XGEN(b.x)], 1u);
            asm volatile("s_waitcnt vmcnt(0)" ::: "memory");
        } else {
            XB_SPIN(xb_ld(&bar[XB_XGEN(b.x)]) == gen, bar);
            __builtin_amdgcn_fence(__ATOMIC_ACQUIRE, "agent");
            asm volatile("s_waitcnt vmcnt(0)" ::: "memory");
        }
    }
    __syncthreads();
}

struct Args { const float* in[16]; float* out; unsigned char* ws; };
struct Frame {
    LAS unsigned char* lds; int tid, lane, wave, G, bid;
    const float *x_prompt, *x_sample, *c_prompt, *c_sample, *w_mod, *b_mod, *pre_g, *post_g, *w_gate, *w_up, *w_down, *w_in, *sink, *four_w, *branch_g, *w_out;
    bf16* XB; bf16* HB; float* OUT; unsigned char* ws;
};
__device__ __forceinline__ float shfl_xor_l(float v, int mask, int lane) { return __builtin_bit_cast(float, __builtin_amdgcn_ds_bpermute((lane ^ mask) << 2, __builtin_bit_cast(int, v))); }
__device__ __forceinline__ float wave_sum(float v, int lane) {
#pragma unroll
    for (int o = 1; o < 64; o <<= 1) v += shfl_xor_l(v, o, lane);
    return v;
}

__device__ __forceinline__ float wave_max(float v, int lane) {
#pragma unroll
    for (int o = 1; o < 64; o <<= 1) v = fmaxf(v, shfl_xor_l(v, o, lane));
    return v;
}
__device__ __forceinline__ unsigned q8_pack(float a, float b, float c, float d, float inv) {
    const unsigned ua = __float_as_uint(fmaf(a, inv, 12582912.0f)), ub = __float_as_uint(fmaf(b, inv, 12582912.0f)), uc = __float_as_uint(fmaf(c, inv, 12582912.0f)), ud = __float_as_uint(fmaf(d, inv, 12582912.0f));
    return __builtin_amdgcn_perm(__builtin_amdgcn_perm(ud, uc, 0x0c0c0400u), __builtin_amdgcn_perm(ub, ua, 0x0c0c0400u), 0x05040100u);
}

__device__ __forceinline__ void transpose_item(const float* W, size_t ldw, int K, bf16* WT, int dest_row0, int k0, int n0, LAS float* scr, int lane, unsigned* AMD = nullptr) {
#pragma unroll 8
    for (int i = 0; i < 32; ++i) { const int kk = 2 * i + (lane >> 5); scr[kk * 33 + (lane & 31)] = W[(size_t)(k0 + kk) * ldw + n0 + (lane & 31)]; }
    LDS_WAIT(); asm volatile("" ::: "memory");
    if (AMD) {
        LAS float* t = scr + (32 * (lane >> 5)) * 33 + (lane & 31);
        float v[32];
#pragma unroll
        for (int j = 0; j < 32; ++j) v[j] = t[j * 33];
#pragma unroll
        for (int st = 1; st < 32; st <<= 1)
#pragma unroll
            for (int j = 0; j < 32; ++j) if ((j & st) == 0) { const float a = v[j], b = v[j | st]; v[j] = a + b; v[j | st] = a - b; }
        float mx = 0.f;
#pragma unroll
        for (int j = 0; j < 32; ++j) { t[j * 33] = v[j]; mx = fmaxf(mx, fabsf(v[j])); }
        mx = fmaxf(mx, shfl_xor_l(mx, 32, lane));
        if (lane < 32) atomicMax(AMD + dest_row0 + lane, __float_as_uint(mx));
        LDS_WAIT(); asm volatile("" ::: "memory");
    }
    const int c = lane & 7;
#pragma unroll
    for (int j = 0; j < 4; ++j) { const int n = (lane >> 3) + 8 * j; const LAS float* s = scr + (8 * c) * 33 + n;
        u32x4 o; o.x = pk2(s[0 * 33], s[1 * 33]); o.y = pk2(s[2 * 33], s[3 * 33]); o.z = pk2(s[4 * 33], s[5 * 33]); o.w = pk2(s[6 * 33], s[7 * 33]);
        *(GAS u32x4*)(WT + (size_t)(dest_row0 + n) * K + k0 + 8 * c) = o; }
    LDS_WAIT(); asm volatile("" ::: "memory");
}
__device__ __forceinline__ void quant_item(const float* W, const unsigned* AM, unsigned char* W8T, int dest_row0, int k0, int n0, LAS float* scr, int lane) {
#pragma unroll 8
    for (int i = 0; i < 32; ++i) { const int kk = 2 * i + (lane >> 5); scr[kk * 33 + (lane & 31)] = W[(size_t)(k0 + kk) * DFF + n0 + (lane & 31)]; }
    const int n = lane >> 1, hf = lane & 1;
    const float am = __uint_as_float(AM[dest_row0 + n]), inv = am > 0.f ? 127.0f / am : 0.f;
    LDS_WAIT(); asm volatile("" ::: "memory");
    const LAS float* t = scr + (32 * hf) * 33 + n;
    u32x4 o0, o1;
    o0.x = q8_pack(t[0 * 33], t[1 * 33], t[2 * 33], t[3 * 33], inv);     o0.y = q8_pack(t[4 * 33], t[5 * 33], t[6 * 33], t[7 * 33], inv);
    o0.z = q8_pack(t[8 * 33], t[9 * 33], t[10 * 33], t[11 * 33], inv);   o0.w = q8_pack(t[12 * 33], t[13 * 33], t[14 * 33], t[15 * 33], inv);
    o1.x = q8_pack(t[16 * 33], t[17 * 33], t[18 * 33], t[19 * 33], inv); o1.y = q8_pack(t[20 * 33], t[21 * 33], t[22 * 33], t[23 * 33], inv);
    o1.z = q8_pack(t[24 * 33], t[25 * 33], t[26 * 33], t[27 * 33], inv); o1.w = q8_pack(t[28 * 33], t[29 * 33], t[30 * 33], t[31 * 33], inv);
    GAS unsigned char* dst = (GAS unsigned char*)(W8T + (size_t)(dest_row0 + n) * DM + k0 + 32 * hf);
    *(GAS u32x4*)dst = o0; *(GAS u32x4*)(dst + 16) = o1;
    LDS_WAIT(); asm volatile("" ::: "memory");
}
__device__ __forceinline__ bf16* wptr(Frame& F, int l, size_t off) { return (bf16*)(F.ws + WS_W + (size_t)l * W_LAYER + off); }

__device__ __forceinline__ void p0a(Frame& F) {
    {
        LAS float* sc = (LAS float*)F.lds;
        LAS float* red = (LAS float*)(F.lds + 40960);
        bool have_c = false;
        for (int it = F.bid; it < 144; it += F.G) {
            if (!have_c) {
                for (int i = F.tid; i < 5 * 2048; i += NTHREADS) { const int b = i >> 11, k = i & 2047; const float c = (b == 0) ? F.c_prompt[k] : F.c_sample[(b - 1) * 2048 + k]; sc[i] = c / (1.0f + __expf(-c)); }
                __syncthreads(); have_c = true;
            }
            const int l = it / 72, chunk = it % 72, col = chunk * 256 + 4 * F.lane;
            const float* wp = F.w_mod + (size_t)l * DM * NMOD + col;
            f32x4 a[5];
#pragma unroll
            for (int b = 0; b < 5; ++b) a[b] = (f32x4){0.f, 0.f, 0.f, 0.f};
            const int kbeg = F.wave * 256;
#pragma unroll 8
            for (int k = kbeg; k < kbeg + 256; ++k) { const f32x4 w = *(const f32x4*)(wp + (size_t)k * NMOD);
#pragma unroll
                for (int b = 0; b < 5; ++b) a[b] += w * sc[b * 2048 + k]; }
#pragma unroll
            for (int b = 0; b < 5; ++b) *(LAS f32x4*)(red + (F.wave * 5 + b) * 256 + 4 * F.lane) = a[b];
            __syncthreads();
            for (int o = F.tid; o < 5 * 256; o += NTHREADS) { const int b = o >> 8, cc = o & 255; float v = 0.f;
#pragma unroll
                for (int w = 0; w < 8; ++w) v += red[(w * 5 + b) * 256 + cc];
                const int jg = chunk * 256 + cc; v += F.b_mod[l * NMOD + jg];
                const int jj = jg / 6144, t = (jg % 6144) / 2048, cl = jg & 2047;
                float r;
                if (t == 0) r = v; else if (t == 1) r = F.pre_g[(l * 3 + jj) * DM + cl] * (1.0f + v); else r = ((jj == 1) ? 1.0f : 0.5f) * (1.0f + v) * F.post_g[(l * 3 + jj) * DM + cl];
                ((float*)(F.ws + WS_COEF))[((size_t)((l * 3 + jj) * 3 + t) * 5 + b) * DM + cl] = r; }
            __syncthreads();
        }
        __syncthreads();
    }
    {
        LAS float* red = (LAS float*)F.lds;
        unsigned* AM = (unsigned*)(F.ws + WS_AMAX);
        for (int it = (F.bid + F.G - 144 % F.G) % F.G; it < 704; it += F.G) {
            const int mat = it / 88, q = it % 88, chunk = q >> 2, kq = q & 3, up = mat & 1, lf = mat >> 1;
            const float* wp = (up ? F.w_up : F.w_gate) + (size_t)lf * DM * DFF + (size_t)(kq * 512 + F.wave * 64) * DFF + chunk * 256 + 4 * F.lane;
            f32x4 mx = (f32x4){0.f, 0.f, 0.f, 0.f};
#pragma unroll 8
            for (int k = 0; k < 64; ++k) { const f32x4 w = *(const f32x4*)(wp + (size_t)k * DFF);
                mx[0] = fmaxf(mx[0], fabsf(w[0])); mx[1] = fmaxf(mx[1], fabsf(w[1])); mx[2] = fmaxf(mx[2], fabsf(w[2])); mx[3] = fmaxf(mx[3], fabsf(w[3])); }
            *(LAS f32x4*)(red + F.wave * 256 + 4 * F.lane) = mx;
            __syncthreads();
            if (F.tid < 256) { float v = red[F.tid];
#pragma unroll
                for (int w = 1; w < 8; ++w) v = fmaxf(v, red[w * 256 + F.tid]);
                const int n = chunk * 256 + F.tid;
                atomicMax(AM + (size_t)lf * 11264 + 256 * (n >> 7) + (up ? 128 : 0) + (n & 127), __float_as_uint(v)); }
            __syncthreads();
        }
    }
    const int gt = F.bid * NTHREADS + F.tid, NGT = F.G * NTHREADS;
    for (int i = gt; i < SEQ * 64; i += NGT) { const int pos = i >> 6, k = i & 63; const float inv = (float)pow(10000.0, -(double)(2 * k) / 128.0); const float ang = (float)pos * inv;
        double sd, cd; sincos((double)ang, &sd, &cd); ((float*)(F.ws + WS_ROPE))[i] = (float)cd; ((float*)(F.ws + WS_ROPE + 2 * MiB))[i] = (float)sd; }
    for (int i = gt; i < 256 * 128; i += NGT) { const int R = i >> 7, c = i & 127, pp = R >> 7, kk = R & 127, part = c >> 6, s1 = c & 63; float v = 0.f;
        if (kk < 64) { const float fr = (float)((kk * s1) & 63) * (2.0f / 64.0f); const float cv = cospif(fr), sv = sinpif(fr); v = (pp == part) ? cv : (pp == 0 ? sv : -sv); v *= 0.125f; }
        ((bf16*)(F.ws + WS_D1))[i] = (bf16)f2bf(v); }
    for (int i = gt; i < 256 * 256; i += NGT) { const int R = i >> 8, c = i & 255, pp = c >> 7, s2 = c & 127; float v = 0.f;
        if (R < 128) { const float fr = (float)((R * s2) & 127) * (2.0f / 128.0f); v = (pp == 0 ? cospif(fr) : sinpif(fr)) * 0.08838834764831845f; }
        ((bf16*)(F.ws + WS_D2))[i] = (bf16)f2bf(v); }
    {
        LAS float* tab = (LAS float*)F.lds;
        if (F.tid < 128) { const float fr = (float)F.tid * (2.0f / 128.0f); tab[F.tid] = cospif(fr); tab[128 + F.tid] = sinpif(fr); }
        __syncthreads();
        for (int i = gt; i < 2 * 8 * 128 * 256; i += NGT) { const int e2 = i & 255, c = (i >> 8) & 127, lg = i >> 15; const int e = e2 & 127; const bool im = e2 >= 128;
            const float* wl = F.four_w + (size_t)lg * 128 * 128 + e; float s = 0.f;
#pragma unroll 8
            for (int m = 0; m < 128; ++m) s += tab[(im ? 128 : 0) + ((m * c) & 127)] * wl[m * 128];
            ((bf16*)(F.ws + WS_WCS))[((size_t)lg * 256 + e2) * 128 + c] = (bf16)f2bf((im ? -s : s) * 0.08838834764831845f); }
        __syncthreads();
    }
    {
        LAS float* scr = (LAS float*)(F.lds + F.wave * 16384);
        const int gw = F.bid * NWAVES + F.wave, NGW = F.G * NWAVES;
        constexpr int I_D = 2 * 88 * 64, I_QK = 32 * 72, I_V = 32 * 8, I_O = 32 * 64;
        constexpr int I_L = I_D + I_QK + I_V + I_O;
        for (int it = gw; it < 2 * I_L; it += NGW) {
            const int l = it / I_L; int r = it % I_L;
            if (r < I_D) { const int fi = r / (88 * 64), q = r % (88 * 64), kb = q / 64, nb = q % 64;
                transpose_item(F.w_down + (size_t)(l * 2 + fi) * DFF * DM, DM, DFF, wptr(F, l, W_D) + (size_t)fi * 2048 * 5632, nb * 32, kb * 64, nb * 32, scr, F.lane,
                               ((Q2_MASK >> (2 * l + fi)) & 1u) ? (unsigned*)(F.ws + WS_AMAXD) + (2 * l + fi) * 2048 : nullptr); continue; }
            r -= I_D;
            if (r < I_QK) { const int kb = r / 72, nb = r % 72; int n0 = nb * 32; int dest;
                if (nb >= 40) { dest = n0; n0 += 256; }
                else if (n0 < 1024) { const int head = n0 >> 7, half = (n0 >> 6) & 1, x = n0 & 63; dest = 256 * (head >> 1) + 128 * half + 64 * (head & 1) + x; }
                else { const int q = n0 - 1024, hs = q >> 7, half = (q >> 6) & 1, x = q & 63; dest = 1024 + 128 * half + 64 * hs + x; }
                transpose_item(F.w_in + (size_t)l * DM * NIN, NIN, DM, wptr(F, l, W_QK), dest, kb * 64, n0, scr, F.lane); continue; }
            r -= I_QK;
            if (r < I_V) { const int kb = r / 8, nb = r % 8;
                transpose_item(F.w_in + (size_t)l * DM * NIN, NIN, DM, wptr(F, l, W_V), nb * 32, kb * 64, 1280 + nb * 32, scr, F.lane); continue; }
            r -= I_V;
            { const int kb = r / 64, nb = r % 64;
                transpose_item(F.w_out + (size_t)l * DM * DM, DM, DM, wptr(F, l, W_O), nb * 32, kb * 64, nb * 32, scr, F.lane); }
        }
    }
}

__device__ __forceinline__ void p0b_quant(Frame& F) {
    LAS float* scr = (LAS float*)(F.lds + 65536 + F.wave * 8704);
    const int gw = F.bid * NWAVES + F.wave, NGW = F.G * NWAVES;
    constexpr int I_M = 32 * 176;
    for (int it = gw; it < 8 * I_M; it += NGW) {
        const int mat = it / I_M, q = it % I_M, kb = q / 176, nb = q % 176, n0 = nb * 32, up = mat & 1, lf = mat >> 1, l = lf >> 1, fi = lf & 1;
        quant_item((up ? F.w_up : F.w_gate) + (size_t)lf * DM * DFF, (const unsigned*)(F.ws + WS_AMAX) + (size_t)lf * 11264,
                   (unsigned char*)wptr(F, l, W_GU) + (size_t)fi * 11264 * 2048, 256 * (n0 >> 7) + (up ? 128 : 0) + (n0 & 127), kb * 64, n0, scr, F.lane);
    }
    for (int it = gw; it < 4 * 2048; it += NGW) {
        const int lf = it >> 11; if (!((Q2_MASK >> lf) & 1u)) continue;
        const unsigned char* src = (const unsigned char*)wptr(F, lf >> 1, W_D) + (size_t)(it & 4095) * 5632 * 2;
        unsigned char* dst = (unsigned char*)wptr(F, lf >> 1, W_D8) + (size_t)(it & 4095) * 5632;
        const float am = __uint_as_float(((const unsigned*)(F.ws + WS_AMAXD))[it]), inv = am > 0.f ? 127.0f / am : 0.f;
        u32x4 v[11];
#pragma unroll
        for (int j = 0; j < 11; ++j) v[j] = *(const u32x4*)(src + (size_t)(j * 64 + F.lane) * 16);
#pragma unroll
        for (int j = 0; j < 11; ++j) { u32x2 w; w.x = pg8::q8c_pack(bflo(v[j].x), bfhi(v[j].x), bflo(v[j].y), bfhi(v[j].y), inv); w.y = pg8::q8c_pack(bflo(v[j].z), bfhi(v[j].z), bflo(v[j].w), bfhi(v[j].w), inv);
            *(u32x2*)(dst + (size_t)(j * 64 + F.lane) * 8) = w; }
    }
}

struct NormRow { f32x4 x[8]; u32x2 y[8]; };
__device__ __forceinline__ void norm_load(Frame& F, NormRow& R, int row, bool first, bool do_post) {
    if (first) { const float* xr = ((row >> 13) == 0 ? F.x_prompt + (size_t)row * DM : F.x_sample + (size_t)(row - SEQ) * DM);
#pragma unroll
        for (int j = 0; j < 8; ++j) R.x[j] = *(const f32x4*)(xr + 4 * F.lane + 256 * j);
    } else { const bf16* xr = F.XB + (size_t)row * DM + 4 * F.lane;
#pragma unroll
        for (int j = 0; j < 8; ++j) { const u32x2 v = *(const u32x2*)(xr + 256 * j); R.x[j] = (f32x4){bflo(v.x), bfhi(v.x), bflo(v.y), bfhi(v.y)}; } }
    if (do_post) { const bf16* yr = (const bf16*)(F.ws + WS_Y) + (size_t)row * DM + 4 * F.lane;
#pragma unroll
        for (int j = 0; j < 8; ++j) R.y[j] = *(const u32x2*)(yr + 256 * j); }
}
__device__ __forceinline__ void norm_row(Frame& F, NormRow& R, int row, bool first, bool do_post, bool do_pre, bool q8, const LAS float* cf) {
    if (do_post) {
        float ss = 0.f;
#pragma unroll
        for (int j = 0; j < 8; ++j) { const float a = bflo(R.y[j].x), bb = bfhi(R.y[j].x), c = bflo(R.y[j].y), d = bfhi(R.y[j].y); ss += (a * a + bb * bb) + (c * c + d * d); }
        const float r = 1.0f / sqrtf(wave_sum(ss, F.lane) * (1.0f / DM) + RMS_EPS);
#pragma unroll
        for (int j = 0; j < 8; ++j) { const f32x4 y = (f32x4){bflo(R.y[j].x), bfhi(R.y[j].x), bflo(R.y[j].y), bfhi(R.y[j].y)}; R.x[j] += *(const LAS f32x4*)(cf + 4 * F.lane + 256 * j) * (y * r); }
    }
    if (!do_pre) {
        float* xo = F.OUT + (size_t)row * DM + 4 * F.lane;
#pragma unroll
        for (int j = 0; j < 8; ++j) *(f32x4*)(xo + 256 * j) = R.x[j];
    } else {
        bf16* xo = F.XB + (size_t)row * DM + 4 * F.lane;
#pragma unroll
        for (int j = 0; j < 8; ++j) { u32x2 w; w.x = pk2(R.x[j][0], R.x[j][1]); w.y = pk2(R.x[j][2], R.x[j][3]); *(u32x2*)(xo + 256 * j) = w; }
    }
    if (do_pre) {
        float ss = 0.f;
#pragma unroll
        for (int j = 0; j < 8; ++j) ss += (R.x[j][0] * R.x[j][0] + R.x[j][1] * R.x[j][1]) + (R.x[j][2] * R.x[j][2] + R.x[j][3] * R.x[j][3]);
        const float r = 1.0f / sqrtf(wave_sum(ss, F.lane) * (1.0f / DM) + RMS_EPS);
        if (!q8) {
            bf16* ho = F.HB + (size_t)row * DM + 4 * F.lane;
#pragma unroll
            for (int j = 0; j < 8; ++j) { const f32x4 hv = R.x[j] * r * *(const LAS f32x4*)(cf + 2048 + 4 * F.lane + 256 * j) + *(const LAS f32x4*)(cf + 4096 + 4 * F.lane + 256 * j);
                u32x2 w; w.x = pk2(hv[0], hv[1]); w.y = pk2(hv[2], hv[3]); *(u32x2*)(ho + 256 * j) = w; }
        } else {
            float mx = 0.f;
#pragma unroll
            for (int j = 0; j < 8; ++j) { const f32x4 hv = R.x[j] * r * *(const LAS f32x4*)(cf + 2048 + 4 * F.lane + 256 * j) + *(const LAS f32x4*)(cf + 4096 + 4 * F.lane + 256 * j);
                R.x[j] = hv; mx = fmaxf(fmaxf(mx, fmaxf(fabsf(hv[0]), fabsf(hv[1]))), fmaxf(fabsf(hv[2]), fabsf(hv[3]))); }
            mx = fmaxf(wave_max(mx, F.lane), 1e-30f);
            const float inv = 127.0f / mx;
            unsigned char* ho = (unsigned char*)F.HB + (size_t)row * DM + 4 * F.lane;
#pragma unroll
            for (int j = 0; j < 8; ++j) *(unsigned*)(ho + 256 * j) = q8_pack(R.x[j][0], R.x[j][1], R.x[j][2], R.x[j][3], inv);
            if (F.lane == 0) ((float*)(F.ws + WS_SA))[row] = mx * (1.0f / 127.0f);
        }
    }
}
__device__ __forceinline__ void norm_phase(Frame& F, bool first, bool do_post, int cpost, bool do_pre, int cpre, bool q8) {
    F.lane = lane_fresh(); F.tid = F.wave * 64 + F.lane;
    const int NGW = F.G * NWAVES, per = (M + NGW - 1) / NGW;
    const int blk0 = F.bid * NWAVES * per, rbeg = blk0 + F.wave * per, rend = (rbeg + per < M) ? rbeg + per : M;
    const int b_lo = (blk0 >> 13) > 4 ? 4 : (blk0 >> 13);
    LAS float* cfl = (LAS float*)F.lds;
    {
        const float* COEF = (const float*)(F.ws + WS_COEF);
        for (int i = F.tid; i < 2 * 3 * 2048 / 4; i += NTHREADS) { const int e = 4 * i, set = e / 6144, v = (e % 6144) >> 11, col = e & 2047; const int b = (b_lo + set > 4) ? 4 : b_lo + set;
            const int ci = (v == 0) ? (cpost * 3 + 2) : (v == 1 ? cpre * 3 + 1 : cpre * 3 + 0);
            *(LAS f32x4*)(cfl + e) = *(const f32x4*)(COEF + ((size_t)ci * 5 + b) * DM + col); }
        LDS_WAIT(); __syncthreads();
    }
    if (rbeg < rend) {
        NormRow Ra, Rb;
        norm_load(F, Ra, rbeg, first, do_post);
        for (int row = rbeg; row < rend; row += 2) {
            const bool has_b = row + 1 < rend;
            if (has_b) norm_load(F, Rb, row + 1, first, do_post);
            norm_row(F, Ra, row, first, do_post, do_pre, q8, cfl + (((row >> 13) - b_lo) & 1) * 6144);
            if (has_b) {
                if (row + 2 < rend) norm_load(F, Ra, row + 2, first, do_post);
                norm_row(F, Rb, row + 1, first, do_post, do_pre, q8, cfl + ((((row + 1) >> 13) - b_lo) & 1) * 6144);
            }
        }
    }
    __syncthreads();
}
__device__ __forceinline__ void mixnorm_phase(Frame& F, int l) {
    F.lane = lane_fresh(); F.tid = F.wave * 64 + F.lane;
    const int gw = F.bid * NWAVES + F.wave, NGW = F.G * NWAVES, per = (M + NGW - 1) / NGW, rbeg = gw * per, rend = (rbeg + per < M) ? rbeg + per : M;
    const float* gf = F.branch_g + (size_t)(l * 2 + 1) * 1024 + 8 * F.lane;
    f32x4 g[2][2];
#pragma unroll
    for (int j = 0; j < 2; ++j) { g[j][0] = *(const f32x4*)(gf + 512 * j); g[j][1] = *(const f32x4*)(gf + 512 * j + 4); }
    for (int row0 = rbeg; row0 < rend; row0 += 4) {
        u32x4 v[4][2];
#pragma unroll
        for (int r = 0; r < 4; ++r) { const int row = (row0 + r < rend) ? row0 + r : rend - 1; const bf16* p = F.HB + (size_t)row * DM + 1024 + 8 * F.lane;
#pragma unroll
            for (int j = 0; j < 2; ++j) v[r][j] = *(const u32x4*)(p + 512 * j); }
#pragma unroll
        for (int r = 0; r < 4; ++r) {
            float f[2][8]; float ss = 0.f;
#pragma unroll
            for (int j = 0; j < 2; ++j) { f[j][0] = bflo(v[r][j].x); f[j][1] = bfhi(v[r][j].x); f[j][2] = bflo(v[r][j].y); f[j][3] = bfhi(v[r][j].y); f[j][4] = bflo(v[r][j].z); f[j][5] = bfhi(v[r][j].z); f[j][6] = bflo(v[r][j].w); f[j][7] = bfhi(v[r][j].w);
#pragma unroll
                for (int i = 0; i < 8; ++i) ss += f[j][i] * f[j][i]; }
            const float rr = 1.0f / sqrtf(wave_sum(ss, F.lane) * (1.0f / 1024.0f) + RMS_EPS);
            if (row0 + r < rend) { bf16* p = F.HB + (size_t)(row0 + r) * DM + 1024 + 8 * F.lane;
#pragma unroll
                for (int j = 0; j < 2; ++j) { u32x4 w; w.x = pk2(f[j][0] * rr * g[j][0][0], f[j][1] * rr * g[j][0][1]); w.y = pk2(f[j][2] * rr * g[j][0][2], f[j][3] * rr * g[j][0][3]);
                    w.z = pk2(f[j][4] * rr * g[j][1][0], f[j][5] * rr * g[j][1][1]); w.w = pk2(f[j][6] * rr * g[j][1][2], f[j][7] * rr * g[j][1][3]); *(u32x4*)(p + 512 * j) = w; } }
        }
    }
}

constexpr int ATT_IMG = 147456;
__device__ __forceinline__ void attn_phase(Frame& F, int l) {
    F.lane = lane_fresh(); F.tid = F.wave * 64 + F.lane;
    const bf16* Q = (const bf16*)(F.ws + WS_Q); const bf16* KB = (const bf16*)(F.ws + WS_KB); const bf16* VT = (const bf16*)(F.ws + WS_VT); bf16* MIX = F.HB;
    const bf16* ZERO = (const bf16*)(F.ws + WS_CTL + 512 * 1024);
    LAS float* ssq = (LAS float*)(F.lds + SSQ_OFF);
    const int h = F.wave, hk = h >> 2;
    const float sinkl = F.sink[l * 8 + h] * LOG2E;
    for (int unit = F.bid; unit < NSEQ * 256; unit += F.G) {
        const int b = unit >> 8, q0 = (unit & 255) * 32, k0 = q0 - 128;
        const size_t tok0 = (size_t)b * SEQ;
        { const int ln = lane_fresh();
#pragma unroll 2
        for (int j = F.wave; j < 144; j += 8) {
            const int p = 64 * j + ln, hkk = p >= 4608 ? 1 : 0, pr = p - hkk * 4608, row = pr >> 4, slot = pr & 15;
            const int chunk = slot ^ ((((row >> 3) & 3) << 2) | (row & 3)); const int key = k0 + row; const bool ok = key >= 0 && key < SEQ;
            const bf16* src = ok ? KB + (tok0 + key) * NKV + hkk * 128 + chunk * 8 : ZERO;
            __builtin_amdgcn_global_load_lds((const unsigned*)src, (LAS unsigned*)(F.lds + 1024 * j), 16, 0, 0);
        } }
        bf16x8 qfs[2][4];
        { const int ln = lane_fresh(), c = ln & 15, q = ln >> 4;
#pragma unroll
          for (int qt = 0; qt < 2; ++qt)
#pragma unroll
            for (int ks = 0; ks < 4; ++ks) qfs[qt][ks] = *(const bf16x8*)(Q + (tok0 + q0 + 16 * qt + c) * NQ + h * 128 + 32 * ks + 8 * q); }
        VM_WAIT(); __syncthreads();
        bf16x8 pf[2][9]; float inv[2];
#pragma unroll
        for (int qt = 0; qt < 2; ++qt) {
            const int ln = lane_fresh(), c = ln & 15, q = ln >> 4;
            const LAS unsigned char* Kl = F.lds + hk * 73728 + (8 * (c >> 2) + (c & 3)) * 256;
            int xoff[4];
#pragma unroll
            for (int ks = 0; ks < 4; ++ks) xoff[ks] = ((4 * ks + q) ^ c) << 4;
            bf16x8 qf[4];
#pragma unroll
            for (int ks = 0; ks < 4; ++ks) qf[ks] = qfs[qt][ks];
            f32x4 s[9][2];
            bf16x8 kfa[4], kfb[4];
#define ATT_LDK(dst, T) do { _Pragma("unroll") for (int ks = 0; ks < 4; ++ks) dst[ks] = *(const LAS bf16x8*)(Kl + (32 * ((T) >> 1) + 4 * ((T) & 1)) * 256 + xoff[ks]); } while (0)
#define ATT_MMK(src, T) do { f32x4 a0 = (f32x4){0.f, 0.f, 0.f, 0.f}; _Pragma("unroll") for (int ks = 0; ks < 4; ++ks) a0 = __builtin_amdgcn_mfma_f32_16x16x32_bf16(src[ks], qf[ks], a0, 0, 0, 0); s[(T) >> 1][(T) & 1] = a0; } while (0)
            ATT_LDK(kfa, 0);
#pragma unroll
            for (int T = 0; T < 18; T += 2) {
                ATT_LDK(kfb, T + 1);
                __builtin_amdgcn_sched_barrier(0);
                ATT_MMK(kfa, T);
                if (T + 2 < 18) ATT_LDK(kfa, T + 2);
                __builtin_amdgcn_sched_barrier(0);
                ATT_MMK(kfb, T + 1);
            }
#undef ATT_LDK
#undef ATT_MMK
            const int qpos = q0 + 16 * qt + c; float mx = -1e30f;
            const bool edge = (k0 < 0) || (k0 + 288 > SEQ);
#pragma unroll
            for (int G = 0; G < 9; ++G) {
                if (G == 0 || G == 8 || edge) {
#pragma unroll
                    for (int tt = 0; tt < 2; ++tt)
#pragma unroll
                        for (int r = 0; r < 4; ++r) { const int kpos = k0 + 32 * G + 8 * q + 4 * tt + r; const int d = qpos - kpos;
                            const bool ok = (d <= 128) && (d >= -128) && (kpos >= 0) && (kpos < SEQ); const float v = ok ? s[G][tt][r] : -1e30f; s[G][tt][r] = v; mx = fmaxf(mx, v); }
                } else {
#pragma unroll
                    for (int tt = 0; tt < 2; ++tt)
#pragma unroll
                        for (int r = 0; r < 4; ++r) mx = fmaxf(mx, s[G][tt][r]);
                }
            }
            mx = fmaxf(mx, shfl_xor_l(mx, 16, ln)); mx = fmaxf(mx, shfl_xor_l(mx, 32, ln)); mx = fmaxf(mx, sinkl);
            float lsum = 0.f;
#pragma unroll
            for (int G = 0; G < 9; ++G) { float p[8];
#pragma unroll
                for (int tt = 0; tt < 2; ++tt)
#pragma unroll
                    for (int r = 0; r < 4; ++r) { p[4 * tt + r] = __builtin_amdgcn_exp2f(s[G][tt][r] - mx); lsum += p[4 * tt + r]; }
                u32x4 pw; pw.x = cvt_pk_bf16(p[0], p[1]); pw.y = cvt_pk_bf16(p[2], p[3]); pw.z = cvt_pk_bf16(p[4], p[5]); pw.w = cvt_pk_bf16(p[6], p[7]);
                pf[qt][G] = __builtin_bit_cast(bf16x8, pw); }
            lsum += shfl_xor_l(lsum, 16, ln); lsum += shfl_xor_l(lsum, 32, ln); lsum += __builtin_amdgcn_exp2f(sinkl - mx);
            inv[qt] = 1.0f / lsum;
        }
        __syncthreads();
        { const int ln = lane_fresh();
#pragma unroll 2
        for (int j = F.wave; j < 144; j += 8) {
            const int p = 64 * j + ln, hkk = p >= 4608 ? 1 : 0, pr = p - hkk * 4608, d = pr / 36, c1 = pr - d * 36;
            const int ch = c1 ^ ((d >> 2) & 3); const int tok = k0 + 8 * ch; const bool ok = tok >= 0 && tok < SEQ;
            const bf16* src = ok ? VT + (size_t)(hkk * 128 + d) * M + tok0 + tok : ZERO;
            __builtin_amdgcn_global_load_lds((const unsigned*)src, (LAS unsigned*)(F.lds + 1024 * j), 16, 0, 0);
        } }
        VM_WAIT(); __syncthreads();
        f32x4 o0[8], o1[8];
#pragma unroll
        for (int dt = 0; dt < 8; ++dt) { o0[dt] = (f32x4){0.f, 0.f, 0.f, 0.f}; o1[dt] = (f32x4){0.f, 0.f, 0.f, 0.f}; }
        {
            const int ln = lane_fresh(), c = ln & 15, q = ln >> 4;
            const LAS unsigned char* Vl = F.lds + hk * 73728 + c * 576 + ((q ^ (c >> 2)) << 4);
            bf16x8 vfa[4], vfb[4];
#define ATT_LDV(dst, H) do { _Pragma("unroll") for (int dd = 0; dd < 4; ++dd) dst[dd] = *(const LAS bf16x8*)(Vl + (4 * ((H) & 1) + dd) * 9216 + ((H) >> 1) * 64); } while (0)
#define ATT_MMV(src, H) do { _Pragma("unroll") for (int dd = 0; dd < 4; ++dd) { o0[4 * ((H) & 1) + dd] = __builtin_amdgcn_mfma_f32_16x16x32_bf16(src[dd], pf[0][(H) >> 1], o0[4 * ((H) & 1) + dd], 0, 0, 0); \
        o1[4 * ((H) & 1) + dd] = __builtin_amdgcn_mfma_f32_16x16x32_bf16(src[dd], pf[1][(H) >> 1], o1[4 * ((H) & 1) + dd], 0, 0, 0); } } while (0)
            ATT_LDV(vfa, 0);
#pragma unroll
            for (int H = 0; H < 18; H += 2) {
                ATT_LDV(vfb, H + 1);
                __builtin_amdgcn_sched_barrier(0);
                ATT_MMV(vfa, H);
                if (H + 2 < 18) ATT_LDV(vfa, H + 2);
                __builtin_amdgcn_sched_barrier(0);
                ATT_MMV(vfb, H + 1);
            }
#undef ATT_LDV
#undef ATT_MMV
        }
        const int ln = lane_fresh(), c = ln & 15, q = ln >> 4;
        const float* ga = F.branch_g + (size_t)(l * 2) * 1024 + h * 128 + 4 * q;
        float ss0 = 0.f, ss1 = 0.f;
#pragma unroll
        for (int dt = 0; dt < 8; ++dt) { o0[dt] = o0[dt] * inv[0]; o1[dt] = o1[dt] * inv[1];
            ss0 += (o0[dt][0] * o0[dt][0] + o0[dt][1] * o0[dt][1]) + (o0[dt][2] * o0[dt][2] + o0[dt][3] * o0[dt][3]);
            ss1 += (o1[dt][0] * o1[dt][0] + o1[dt][1] * o1[dt][1]) + (o1[dt][2] * o1[dt][2] + o1[dt][3] * o1[dt][3]); }
        ss0 += shfl_xor_l(ss0, 16, ln); ss0 += shfl_xor_l(ss0, 32, ln); ss1 += shfl_xor_l(ss1, 16, ln); ss1 += shfl_xor_l(ss1, 32, ln);
        if (q == 0) { ssq[h * 32 + c] = ss0; ssq[h * 32 + 16 + c] = ss1; }
        f32x4 gv[8];
#pragma unroll
        for (int dt = 0; dt < 8; ++dt) gv[dt] = *(const f32x4*)(ga + 16 * dt);
        LDS_WAIT(); __syncthreads();
        float t0 = 0.f, t1 = 0.f;
#pragma unroll
        for (int w = 0; w < 8; ++w) { t0 += ssq[w * 32 + c]; t1 += ssq[w * 32 + 16 + c]; }
        const float r0 = 1.0f / sqrtf(t0 * (1.0f / 1024.0f) + RMS_EPS), r1 = 1.0f / sqrtf(t1 * (1.0f / 1024.0f) + RMS_EPS);
        bf16* op = MIX + (tok0 + q0 + c) * DM + h * 128 + 4 * q;
#pragma unroll
        for (int dt = 0; dt < 8; ++dt) { const f32x4 g = gv[dt]; const f32x4 v0 = o0[dt] * r0 * g, v1 = o1[dt] * r1 * g;
            u32x2 w0, w1; w0.x = pk2(v0[0], v0[1]); w0.y = pk2(v0[2], v0[3]); w1.x = pk2(v1[0], v1[1]); w1.y = pk2(v1[2], v1[3]);
            *(u32x2*)(op + 16 * dt) = w0; *(u32x2*)(op + (size_t)16 * DM + 16 * dt) = w1; }
        LDS_WAIT();
    }
    VM_WAIT(); __syncthreads();
}

__global__ void __launch_bounds__(NTHREADS, 2) fwd_kernel(Args args) {
    extern __shared__ __attribute__((aligned(16))) unsigned char lds_raw[];
    Frame F;
    F.lds = (LAS unsigned char*)lds_raw;
    F.tid = threadIdx.x; F.lane = F.tid & 63; F.wave = __builtin_amdgcn_readfirstlane(F.tid >> 6); F.G = gridDim.x; F.bid = blockIdx.x;
    F.x_prompt = args.in[0]; F.x_sample = args.in[1]; F.c_prompt = args.in[2]; F.c_sample = args.in[3]; F.w_mod = args.in[4]; F.b_mod = args.in[5]; F.pre_g = args.in[6]; F.post_g = args.in[7];
    F.w_gate = args.in[8]; F.w_up = args.in[9]; F.w_down = args.in[10]; F.w_in = args.in[11]; F.sink = args.in[12]; F.four_w = args.in[13]; F.branch_g = args.in[14]; F.w_out = args.in[15];
    F.OUT = args.out; F.HB = (bf16*)args.out; F.ws = args.ws; F.XB = (bf16*)(args.ws + WS_X);
    volatile LAS unsigned* MISC = (volatile LAS unsigned*)(F.lds + MISC_OFF);
    for (int u = F.tid; u < (LDS_BYTES - LDSCTL_OFF) / 4; u += NTHREADS) ((LAS unsigned*)(F.lds + LDSCTL_OFF))[u] = 0u;
    __syncthreads();
    (void)xcd_barrier_post((unsigned*)(F.ws + WS_CTL) + 4096, MISC + 8);
#define GRID_BAR() do { XcdBarrier b2_; b2_.bar = (unsigned*)(args.ws + opaque_zero()) + 4096; b2_.x = xb_xcc_id(); b2_.st = (volatile LAS unsigned*)(F.lds + MISC_OFF) + 8; xcd_barrier(b2_, F.wave == 0 && lane_fresh() == 0); } while (0)

    p0a(F);
    GRID_BAR();
    p0b_quant(F);
    norm_phase(F, true, false, 0, true, 0, true);
    GRID_BAR();

    for (int hs = 0; hs < 2 * DEPTH; ++hs) {
        const int l = hs >> 1, fi = hs & 1;
        F.ws = args.ws + opaque_zero(); { int b_ = blockIdx.x, g_ = gridDim.x; asm volatile("" : "+s"(b_), "+s"(g_)); F.bid = b_; F.G = g_; }
        if (!((Q2_MASK >> hs) & 1u)) {
        {
            pg8::GeoPlain geo{(const char*)F.HB, (const char*)wptr(F, l, W_GU) + (size_t)fi * 11264 * 2048, DM / 2};
            pg8::StaticOrder S; S.init(M, 11264, F.G, F.bid);
            pg8::EpiSwiGLU8 E{(bf16*)(F.ws + WS_BIG), (const float*)(F.ws + WS_SA), (const unsigned*)(F.ws + WS_AMAX) + (size_t)(l * 2 + fi) * 11264};
            pg8::gemm_phase(F.lds, F.wave, geo, S, E);
        }
        GRID_BAR();
        {
            pg8::GeoPlain geo{(const char*)(F.ws + WS_BIG), (const char*)(wptr(F, l, W_D) + (size_t)fi * 2048 * 5632), DFF};
            pg8::StaticOrder S; S.init(M, DM, F.G, F.bid);
            pg8::EpiBf16 E{(bf16*)(F.ws + WS_Y), (size_t)DM};
            pg8::gemm_phase(F.lds, F.wave, geo, S, E);
        }
        GRID_BAR();
        } else {
        {
            pg8::GeoPlain geo{(const char*)F.HB, (const char*)wptr(F, l, W_GU) + (size_t)fi * 11264 * 2048, DM / 2};
            pg8::Col0Order S{F.G, F.bid};
            pg8::EpiSwiGLU8Q<true> E{F.ws + WS_BIG, (const float*)(F.ws + WS_SA), (const unsigned*)(F.ws + WS_AMAX) + (size_t)(l * 2 + fi) * 11264, (float*)(F.ws + WS_S2), (LAS float*)(F.lds + RING_BYTES)};
            pg8::gemm_phase(F.lds, F.wave, geo, S, E);
        }
        GRID_BAR();
        {
            pg8::GeoPlain geo{(const char*)F.HB, (const char*)wptr(F, l, W_GU) + (size_t)fi * 11264 * 2048, DM / 2};
            pg8::ShiftOrder S; S.S.init(M, 11264 - 256, F.G, F.bid);
            pg8::EpiSwiGLU8Q<false> E{F.ws + WS_BIG, (const float*)(F.ws + WS_SA), (const unsigned*)(F.ws + WS_AMAX) + (size_t)(l * 2 + fi) * 11264, (float*)(F.ws + WS_S2), (LAS float*)(F.lds + RING_BYTES)};
            pg8::gemm_phase(F.lds, F.wave, geo, S, E);
        }
        GRID_BAR();
        {
            pg8::GeoPlain geo{(const char*)(F.ws + WS_BIG), (const char*)wptr(F, l, W_D8) + (size_t)fi * 2048 * 5632, DFF / 2};
            pg8::StaticOrder S; S.init(M, DM, F.G, F.bid);
            pg8::EpiBf16S E{(bf16*)(F.ws + WS_Y), (const float*)(F.ws + WS_S2), (const unsigned*)(F.ws + WS_AMAXD) + hs * 2048};
            pg8::gemm_phase(F.lds, F.wave, geo, S, E);
        }
        GRID_BAR();
        }
        if (fi == 0) {
            norm_phase(F, false, true, l * 3 + 0, true, l * 3 + 1, false);
            GRID_BAR();
            {
                pg8::GeoPlain geo{(const char*)F.HB, (const char*)wptr(F, l, W_QK), DM};
                pg8::StaticOrder S; S.init(M, 2304, F.G, F.bid);
                pg8::EpiRope E{(bf16*)(F.ws + WS_Q), (bf16*)(F.ws + WS_KB), (const float*)(F.ws + WS_ROPE), (const float*)(F.ws + WS_ROPE + 2 * MiB), (bf16*)(F.ws + WS_U)};
                pg8::gemm_phase(F.lds, F.wave, geo, S, E);
            }
            {
                pg8::GeoPlain geo{(const char*)wptr(F, l, W_V), (const char*)F.HB, DM};
                pg8::StaticOrder S; S.init(256, M, F.G, (F.bid + 96) % F.G);
                pg8::EpiBf16 E{(bf16*)(F.ws + WS_VT), (size_t)M};
                pg8::gemm_phase(F.lds, F.wave, geo, S, E);
            }
            GRID_BAR();
            attn_phase(F, l);
            {
                pg8::GeoP1 geo{(const char*)(F.ws + WS_WCS) + (size_t)l * 8 * 256 * 128 * 2, (const char*)(F.ws + WS_U)};
                pg8::StaticOrder S; S.init(2048, M, F.G, F.bid);
                pg8::EpiBf16 E{(bf16*)(F.ws + WS_Z1), (size_t)M};
                pg8::gemm_phase(F.lds, F.wave, geo, S, E);
            }
            GRID_BAR();
            {
                pg8::GeoP2 geo{(const char*)(F.ws + WS_D1), (const char*)(F.ws + WS_Z1)};
                pg8::StaticOrder S; S.init(256, 2560 * 256, F.G, F.bid);
                pg8::EpiTwiddle E{(bf16*)(F.ws + WS_Y2)};
                pg8::gemm_phase(F.lds, F.wave, geo, S, E);
            }
            GRID_BAR();
            {
                pg8::GeoPlain geo{(const char*)(F.ws + WS_D2), (const char*)(F.ws + WS_Y2), 256};
                pg8::StaticOrder S; S.init(256, 1280 * 256, F.G, F.bid);
                pg8::EpiDftOut E{F.HB};
                pg8::gemm_phase(F.lds, F.wave, geo, S, E);
            }
            GRID_BAR();
            mixnorm_phase(F, l);
            GRID_BAR();
            {
                pg8::GeoPlain geo{(const char*)F.HB, (const char*)wptr(F, l, W_O), DM};
                pg8::StaticOrder S; S.init(M, DM, F.G, F.bid);
                pg8::EpiBf16 E{(bf16*)(F.ws + WS_Y), (size_t)DM};
                pg8::gemm_phase(F.lds, F.wave, geo, S, E);
            }
            GRID_BAR();
            norm_phase(F, false, true, l * 3 + 1, true, l * 3 + 2, true);
            GRID_BAR();
        } else {
            const bool lastl = (hs == 2 * DEPTH - 1);
            norm_phase(F, false, true, l * 3 + 2, !lastl, (l + 1) * 3 + 0, true);
            if (!lastl) GRID_BAR();
        }
    }
}

extern "C" void kernel_launch(void* const* d_in, const int* in_sizes, int n_in, void* d_out, int out_size, void* d_ws, size_t ws_size, hipStream_t stream) {
    static int grid = 0;
    if (grid == 0) {
        if (n_in != 16 || out_size != M * DM || ws_size < WS_END) { fprintf(stderr, "kernel_launch: unexpected problem (n_in %d, out %d, ws %zu < %zu)\n", n_in, out_size, ws_size, (size_t)WS_END); grid = -1; return; }
        int dev = 0, cus = 0, per_cu = 0;
        if (hipGetDevice(&dev) != hipSuccess || hipDeviceGetAttribute(&cus, hipDeviceAttributeMultiprocessorCount, dev) != hipSuccess) { grid = -1; return; }
        if (hipFuncSetAttribute((const void*)fwd_kernel, hipFuncAttributeMaxDynamicSharedMemorySize, LDS_BYTES) != hipSuccess) { fprintf(stderr, "kernel_launch: hipFuncSetAttribute failed\n"); grid = -1; return; }
        if (hipOccupancyMaxActiveBlocksPerMultiprocessor(&per_cu, (const void*)fwd_kernel, NTHREADS, LDS_BYTES) != hipSuccess || per_cu < 1) { fprintf(stderr, "kernel_launch: occupancy query reports %d\n", per_cu); }
        (void)hipGetLastError();
        grid = cus;
    }
    if (grid < 0) return;
    if (hipMemsetAsync((char*)d_ws + WS_CTL, 0, CTL_ZERO_BYTES, stream) != hipSuccess) return;
    Args a{};
    for (int i = 0; i < 16; ++i) a.in[i] = (const float*)d_in[i];
    a.out = (float*)d_out; a.ws = (unsigned char*)d_ws;
    hipLaunchKernelGGL(fwd_kernel, dim3(grid), dim3(NTHREADS), LDS_BYTES, stream, a);
}
```
